# Optimizing an MI355X kernel written in HIP

```python
import math
import jax, jax.numpy as jnp
from jax import lax
import numpy as np

D_MODEL = 1024
BATCH = 16
SEQ = 4096
DEPTH = 1

HEAD_DIM = 64
HALF_DIM = HEAD_DIM // 2
A_HEADS = 8
A_WIDTH = A_HEADS * HEAD_DIM
DILATED_PATTERNS = ((128, 1), (512, 4), (2048, 16))
B_HEADS = 4
B_QK_WIDTH = B_HEADS * 2 * HEAD_DIM
B_V_WIDTH = B_HEADS * 2 * HEAD_DIM
IN_WIDTHS = (A_WIDTH, A_WIDTH, A_WIDTH, B_QK_WIDTH, B_QK_WIDTH, B_V_WIDTH, D_MODEL, D_MODEL)
IN_WIDTH = 3 * A_WIDTH + 2 * B_QK_WIDTH + B_V_WIDTH + 2 * D_MODEL
D_FF = 4 * D_MODEL
ROPE_THETA = 10000.0
NORM_EPS = 1e-6
SUBLN_EPS = 1e-5
Q_BLOCK = 128

kernel_name = "hybrid_dilated_diffattn_gated_block"


def lambda_init_fn(layer):
    return 0.8 - 0.6 * math.exp(-0.3 * layer)


def rms_norm(x, g, eps):
    xf = x.astype(jnp.float32)
    y = xf * lax.rsqrt(jnp.mean(xf * xf, axis=-1, keepdims=True) + eps)
    return (y * g.astype(jnp.float32)).astype(x.dtype)


def rope_tables(seq, dtype):
    pos = jnp.arange(seq, dtype=jnp.float32)
    inv_freq = ROPE_THETA ** (-jnp.arange(0, HEAD_DIM, 2, dtype=jnp.float32) / HEAD_DIM)
    ang = pos[:, None] * inv_freq[None, :]
    ang = jnp.concatenate([ang, ang], axis=-1)
    return jnp.cos(ang).astype(dtype), jnp.sin(ang).astype(dtype)


def apply_rope(t, cos, sin):
    shp = t.shape
    t4 = t.reshape(shp[0], shp[1], -1, HEAD_DIM)
    rot = jnp.concatenate([-t4[..., HALF_DIM:], t4[..., :HALF_DIM]], axis=-1)
    out = t4 * cos[None, :, None, :] + rot * sin[None, :, None, :]
    return out.reshape(shp)


def banded_window_attention(q, k, v, half):
    n, L, h, dh = q.shape
    blk = half
    nb = -(-L // blk)
    lp = nb * blk
    qb = jnp.pad(q, ((0, 0), (0, lp - L), (0, 0), (0, 0))).reshape(n, nb, blk, h, dh)
    pad_kv = ((0, 0), (blk, lp - L + blk), (0, 0), (0, 0))
    kp = jnp.pad(k, pad_kv).reshape(n, nb + 2, blk, h, dh)
    vp = jnp.pad(v, pad_kv).reshape(n, nb + 2, blk, h, dh)
    kw = jnp.concatenate([kp[:, :-2], kp[:, 1:-1], kp[:, 2:]], axis=2)
    vw = jnp.concatenate([vp[:, :-2], vp[:, 1:-1], vp[:, 2:]], axis=2)
    qpos = jnp.arange(nb)[:, None] * blk + jnp.arange(blk)[None, :]
    kpos = (jnp.arange(nb)[:, None] - 1) * blk + jnp.arange(3 * blk)[None, :]
    rel = kpos[:, None, :] - qpos[:, :, None]
    valid = (jnp.abs(rel) <= half) & (kpos[:, None, :] >= 0) & (kpos[:, None, :] < L)
    scale = 1.0 / math.sqrt(dh)
    s = jnp.einsum('ncqhd,nckhd->nhcqk', qb, kw).astype(jnp.float32) * scale
    s = jnp.where(valid[None, None], s, -jnp.inf)
    lse = jax.nn.logsumexp(s, axis=-1)
    p = jnp.exp(s - lse[..., None])
    o = jnp.einsum('nhcqk,nckhd->ncqhd', p.astype(v.dtype), vw).reshape(n, lp, h, dh)[:, :L]
    lse = lse.transpose(0, 2, 3, 1).reshape(n, lp, h)[:, :L]
    return o, lse


def dilated_window_attention(q, k, v):
    b, s, h, dh = q.shape
    outs, lses = [], []
    for window, dil in DILATED_PATTERNS:
        half = window // (2 * dil)
        ls = s // dil

        def to_phase(t):
            return t.reshape(b, ls, dil, h, dh).transpose(0, 2, 1, 3, 4).reshape(b * dil, ls, h, dh)

        o, lse = banded_window_attention(to_phase(q), to_phase(k), to_phase(v), half)
        outs.append(o.reshape(b, dil, ls, h, dh).transpose(0, 2, 1, 3, 4).reshape(b, s, h, dh))
        lses.append(lse.reshape(b, dil, ls, h).transpose(0, 2, 1, 3).reshape(b, s, h))
    w = jax.nn.softmax(jnp.stack(lses, axis=0), axis=0)
    return jnp.einsum('pbsh,pbshd->bshd', w.astype(q.dtype), jnp.stack(outs, axis=0))


def differential_attention(q, k, v, lam, lam_init, subln_g):
    b, s, h, _, dh = q.shape
    nq = s // Q_BLOCK
    scale = 1.0 / math.sqrt(dh)
    qblocks = q.reshape(b, nq, Q_BLOCK, h, 2, dh).transpose(1, 0, 2, 3, 4, 5)

    def block(qb):
        sc = jnp.einsum('bqhcd,bkhcd->bhcqk', qb, k).astype(jnp.float32) * scale
        p = jax.nn.softmax(sc, axis=-1)
        pd = p[:, :, 0] - lam * p[:, :, 1]
        return jnp.einsum('bhqk,bkhe->bqhe', pd.astype(v.dtype), v)

    o = lax.map(block, qblocks)
    o = o.transpose(1, 0, 2, 3, 4).reshape(b, s, h, 2 * dh)
    return rms_norm(o, subln_g, SUBLN_EPS) * (1.0 - lam_init)


def setup_inputs(seed: int = 0) -> dict:
    key = jax.random.key(seed)
    ks = jax.random.split(key, 16)
    f32 = jnp.float32

    def nrm(k, shape, scale):
        return jax.random.normal(k, shape, f32) * scale

    return {
        "x": nrm(ks[0], (BATCH, SEQ, D_MODEL), 1.0),
        "w_in": nrm(ks[1], (DEPTH, D_MODEL, IN_WIDTH), D_MODEL ** -0.5),
        "w_branch_a": nrm(ks[2], (DEPTH, A_WIDTH, D_MODEL), A_WIDTH ** -0.5),
        "w_branch_b": nrm(ks[3], (DEPTH, B_V_WIDTH, D_MODEL), B_V_WIDTH ** -0.5),
        "w_out": nrm(ks[4], (DEPTH, D_MODEL, D_MODEL), D_MODEL ** -0.5),
        "lambda_q1": nrm(ks[5], (DEPTH, HEAD_DIM), 0.1),
        "lambda_k1": nrm(ks[6], (DEPTH, HEAD_DIM), 0.1),
        "lambda_q2": nrm(ks[7], (DEPTH, HEAD_DIM), 0.1),
        "lambda_k2": nrm(ks[8], (DEPTH, HEAD_DIM), 0.1),
        "diff_subln_g": 1.0 + nrm(ks[9], (DEPTH, 2 * HEAD_DIM), 0.02),
        "norm_mix_g": 1.0 + nrm(ks[10], (DEPTH, D_MODEL), 0.02),
        "norm_mlp_g": 1.0 + nrm(ks[11], (DEPTH, D_MODEL), 0.02),
        "w_ff1": nrm(ks[12], (DEPTH, D_MODEL, D_FF), D_MODEL ** -0.5),
        "w_ff2": nrm(ks[13], (DEPTH, D_FF, D_MODEL), D_FF ** -0.5),
        "norm_final_g": 1.0 + nrm(ks[14], (D_MODEL,), 0.02),
    }


def reference(x, w_in, w_branch_a, w_branch_b, w_out, lambda_q1, lambda_k1, lambda_q2, lambda_k2,
              diff_subln_g, norm_mix_g, norm_mlp_g, w_ff1, w_ff2, norm_final_g):
    b, s, _ = x.shape
    cos, sin = rope_tables(s, x.dtype)
    split_idx = np.cumsum(IN_WIDTHS)[:-1].tolist()
    for l in range(DEPTH):
        h_in = rms_norm(x, norm_mix_g[l], NORM_EPS)
        proj = h_in @ w_in[l]
        qa, ka, va, qb, kb, vb, ga, gb = jnp.split(proj, split_idx, axis=-1)
        qa = apply_rope(qa.reshape(b, s, A_HEADS, HEAD_DIM), cos, sin)
        ka = apply_rope(ka.reshape(b, s, A_HEADS, HEAD_DIM), cos, sin)
        va = va.reshape(b, s, A_HEADS, HEAD_DIM)
        qb = apply_rope(qb.reshape(b, s, B_HEADS, 2, HEAD_DIM), cos, sin)
        kb = apply_rope(kb.reshape(b, s, B_HEADS, 2, HEAD_DIM), cos, sin)
        vb = vb.reshape(b, s, B_HEADS, 2 * HEAD_DIM)

        ya = dilated_window_attention(qa, ka, va).reshape(b, s, A_WIDTH) @ w_branch_a[l]

        lam_init = lambda_init_fn(l)
        lam = (jnp.exp(jnp.sum(lambda_q1[l].astype(jnp.float32) * lambda_k1[l].astype(jnp.float32)))
               - jnp.exp(jnp.sum(lambda_q2[l].astype(jnp.float32) * lambda_k2[l].astype(jnp.float32)))
               + lam_init)
        yb = differential_attention(qb, kb, vb, lam, lam_init, diff_subln_g[l]).reshape(b, s, B_V_WIDTH) @ w_branch_b[l]

        merged = jax.nn.sigmoid(ga) * ya + jax.nn.sigmoid(gb) * yb
        x = x + merged @ w_out[l]

        h2 = rms_norm(x, norm_mlp_g[l], NORM_EPS)
        x = x + jnp.square(jax.nn.relu(h2 @ w_ff1[l])) @ w_ff2[l]
    return rms_norm(x, norm_final_g, NORM_EPS)
```

```cpp
#include <hip/hip_runtime.h>
#include <hip/hip_cooperative_groups.h>
#include <cstdio>
#include <cstdint>
namespace cg = cooperative_groups;
namespace pg8 {
#define PG8_LAS __attribute__((address_space(3)))
typedef unsigned short bf16_t;
typedef short bf16x8 __attribute__((ext_vector_type(8)));
typedef float f32x4 __attribute__((ext_vector_type(4)));
typedef unsigned u32x4 __attribute__((ext_vector_type(4)));
constexpr int BM = 256, BK = 64, HALF = 128, HTB = HALF * BK * 2  , STAGE_BYTES = 8 * HTB, NXCD = 8, WGM = 8;

__host__ __device__ __forceinline__ int lds_byte(int r, int c) { const int st = (r >> 4) * 2 + (c >> 5), rr = r & 15, cc = c & 31, ob = rr * 64 + cc * 2; return st * 1024 + (ob ^ (((ob >> 9) & 1) << 5)); }
__host__ __device__ __forceinline__ void stage_rc(int b, int& R, int& C) { const int st = b / 1024, sb = b % 1024, swz = sb ^ (((sb >> 9) & 1) << 5); R = (st >> 1) * 16 + swz / 64; C = (st & 1) * 32 + (swz % 64) / 2; }
__host__ __device__ __forceinline__ int perm32(int rho) { const int n = rho >> 4, i = rho & 15; return 8 * (i >> 2) + 4 * n + (i & 3); }

struct Unit { int pm, pn; };
struct Gemm { const bf16_t* A; const bf16_t* Bt; int M, N, K; };

struct StaticOrder {
    int nM, nN, nwg, G, c;
    __host__ __device__ void init(int M, int N, int G_, int c_) { nM = M / BM; nN = N / BM; nwg = nM * nN; G = G_; c = c_; }
    __host__ __device__ bool next(int i, Unit& u) const {
        const long L = (long)i * G + c; if (L >= nwg) return false;
        int wgid = (int)L; { const int q = nwg / NXCD, r = nwg % NXCD, xcd = wgid % NXCD, off = wgid / NXCD; wgid = (xcd < r ? xcd * (q + 1) : r * (q + 1) + (xcd - r) * q) + off; }
        const int nig = WGM * nN, gid = wgid / nig, fm = gid * WGM, gsz = (nM - fm) < WGM ? (nM - fm) : WGM;
        u.pm = fm + ((wgid % nig) % gsz); u.pn = (wgid % nig) / gsz; return true;
    }
    __device__ __forceinline__ void a_ready(const Unit&) const {}
    __device__ __forceinline__ void done(const Unit&) const {}
};

__device__ __forceinline__ unsigned cvt_pk_bf16(float lo, float hi) { unsigned r; asm volatile("v_cvt_pk_bf16_f32 %0, %1, %2" : "=v"(r) : "v"(lo), "v"(hi)); return r; }
template <class Epi, class Sched, bool ALIGN_EPI = false, bool SP2 = false>
__device__ __forceinline__ void gemm_phase(PG8_LAS unsigned char* lds, const Gemm g, const Sched& S, const Epi& E) {
    const int tid = threadIdx.x, wid = __builtin_amdgcn_readfirstlane(tid >> 6), lane = tid & 63, wr = wid >> 2, wc = wid & 3, fr = lane & 15, fq = lane >> 4;
    const int K = g.K, nt = K / BK;
    unsigned voffA[2], voffB[2];
#pragma unroll
    for (int i = 0; i < 2; ++i) { int R, C; stage_rc(tid * 16 + i * 8192, R, C); const int Rb = Epi::PERM ? ((R & ~31) + perm32(R & 31)) : R;
        voffA[i] = (unsigned)(R * K + C) * 2u; voffB[i] = (unsigned)(Rb * K + C) * 2u; }
    const size_t kstep = (size_t)(BK * 2);
    const size_t hstep = (size_t)HALF * K * 2;
    const size_t tstep = 2 * hstep;
    const unsigned ldsw = (unsigned)wid * 1024u;
    const int aoff = lds_byte(wr * 64 + fr, fq * 8), boff = lds_byte(wc * 32 + fr, fq * 8);
#define PG8_SA(b, h) (((b) * 2 + (h)) * HTB)
#define PG8_SB(b, h) ((4 + (b) * 2 + (h)) * HTB)
#define PG8_STAGE(bufoff, gbase, voff) do { _Pragma("unroll") for (int _i = 0; _i < 2; ++_i) \
        __builtin_amdgcn_global_load_lds((const unsigned*)((const char*)(gbase) + (voff)[_i]), (PG8_LAS unsigned*)(lds + (bufoff) + ldsw + _i * 8192), 16, 0, 0); } while (0)
#define PG8_LDA(dst, b, h) do { _Pragma("unroll") for (int m = 0; m < 4; ++m) _Pragma("unroll") for (int k = 0; k < 2; ++k) dst[m][k] = *(const PG8_LAS bf16x8*)(lds + PG8_SA(b, h) + aoff + m * 2048 + k * 1024); } while (0)
#define PG8_LDB(dst, b, h) do { _Pragma("unroll") for (int n = 0; n < 2; ++n) _Pragma("unroll") for (int k = 0; k < 2; ++k) dst[n][k] = *(const PG8_LAS bf16x8*)(lds + PG8_SB(b, h) + boff + n * 2048 + k * 1024); } while (0)
#define PG8_MMA(ai, bj, At, Bt) do { __builtin_amdgcn_s_setprio(1); _Pragma("unroll") for (int m = 0; m < 4; ++m) _Pragma("unroll") for (int n = 0; n < 2; ++n) _Pragma("unroll") for (int k = 0; k < 2; ++k) \
        acc[ai][bj][m][n] = __builtin_amdgcn_mfma_f32_16x16x32_bf16(Bt[n][k], At[m][k], acc[ai][bj][m][n], 0, 0, 0); __builtin_amdgcn_s_setprio(0); } while (0)
#define PG8_WAIT_V(n) asm volatile("s_waitcnt vmcnt(" #n ")" ::: "memory")
#define PG8_WAIT_L(n) asm volatile("s_waitcnt lgkmcnt(" #n ")" ::: "memory")
#define PG8_BAR __builtin_amdgcn_s_barrier()
#define PG8_SCHED __builtin_amdgcn_sched_barrier(0)
    Unit cur, nxt; int ui = 0;
    if (!S.next(0, cur)) return;
    f32x4 acc[2][2][4][2];
#pragma unroll
    for (int a = 0; a < 2; ++a)
#pragma unroll
        for (int b = 0; b < 2; ++b)
#pragma unroll
            for (int m = 0; m < 4; ++m)
#pragma unroll
                for (int n = 0; n < 2; ++n) acc[a][b][m][n] = (f32x4){0.f, 0.f, 0.f, 0.f};
    bf16x8 At[4][2], B0[2][2], B1[2][2];
    const char* cA = (const char*)g.A + (size_t)cur.pm * tstep; const char* cB = (const char*)g.Bt + (size_t)cur.pn * tstep;
    S.a_ready(cur);
    if constexpr (SP2) {
        PG8_STAGE(PG8_SB(0, 0), cB, voffB); PG8_STAGE(PG8_SB(0, 1), cB + hstep, voffB); PG8_STAGE(PG8_SA(0, 0), cA, voffA); PG8_STAGE(PG8_SA(0, 1), cA + hstep, voffA);
        if (wr == 1) PG8_BAR;
        PG8_WAIT_V(2); PG8_BAR;
        PG8_STAGE(PG8_SB(1, 0), cB + kstep, voffB); PG8_STAGE(PG8_SA(1, 0), cA + kstep, voffA); PG8_STAGE(PG8_SB(1, 1), cB + hstep + kstep, voffB);
        PG8_WAIT_V(6); PG8_BAR;
    } else {
        PG8_STAGE(PG8_SB(0, 0), cB, voffB); PG8_STAGE(PG8_SA(0, 0), cA, voffA); PG8_STAGE(PG8_SB(0, 1), cB + hstep, voffB); PG8_STAGE(PG8_SA(0, 1), cA + hstep, voffA);
        if (wr == 1) PG8_BAR;
        PG8_WAIT_V(4); PG8_BAR;
        PG8_STAGE(PG8_SB(1, 0), cB + kstep, voffB); PG8_STAGE(PG8_SA(1, 0), cA + kstep, voffA); PG8_STAGE(PG8_SB(1, 1), cB + hstep + kstep, voffB);
        PG8_WAIT_V(6); PG8_BAR;
    }
    for (;;) {
        const bool has_next = S.next(ui + 1, nxt);
        const char* nA = has_next ? (const char*)g.A + (size_t)nxt.pm * tstep : cA; const char* nB = has_next ? (const char*)g.Bt + (size_t)nxt.pn * tstep : cB;
        int t_first = 0;
        if constexpr (SP2 && Epi::RELAX) { if (ui > 0) {
            size_t ks_ = kstep; asm volatile("" : "+s"(ks_));
            PG8_LDB(B0, 0, 0); PG8_LDB(B1, 0, 1); PG8_SCHED; PG8_LDA(At, 0, 0); PG8_STAGE(PG8_SA(1, 1), cA + ks_ + hstep, voffA);
            PG8_WAIT_V(24); PG8_WAIT_L(0); PG8_BAR; PG8_MMA(0, 0, At, B0); PG8_MMA(0, 1, At, B1); PG8_BAR; PG8_SCHED;
            PG8_LDA(At, 0, 1); PG8_STAGE(PG8_SB(0, 0), cB + 2 * ks_, voffB); PG8_STAGE(PG8_SB(0, 1), cB + 2 * ks_ + hstep, voffB); PG8_STAGE(PG8_SA(0, 0), cA + 2 * ks_, voffA);
            PG8_WAIT_V(24); PG8_WAIT_L(0); PG8_BAR; PG8_MMA(1, 0, At, B0); PG8_MMA(1, 1, At, B1); PG8_BAR; PG8_SCHED;
            PG8_LDB(B0, 1, 0); PG8_LDB(B1, 1, 1); PG8_SCHED; PG8_LDA(At, 1, 0); PG8_STAGE(PG8_SA(0, 1), cA + 2 * ks_ + hstep, voffA);
            PG8_WAIT_V(8); PG8_WAIT_L(0); PG8_BAR; PG8_MMA(0, 0, At, B0); PG8_MMA(0, 1, At, B1); PG8_BAR; PG8_SCHED;
            PG8_LDA(At, 1, 1); PG8_STAGE(PG8_SB(1, 0), cB + 3 * ks_, voffB); PG8_STAGE(PG8_SB(1, 1), cB + 3 * ks_ + hstep, voffB); PG8_STAGE(PG8_SA(1, 0), cA + 3 * ks_, voffA);
            PG8_WAIT_V(8); PG8_WAIT_L(0); PG8_BAR; PG8_MMA(1, 0, At, B0); PG8_MMA(1, 1, At, B1); PG8_BAR; PG8_SCHED;
            t_first = 2; } }
        for (int t = t_first; t < nt; t += 2) {
            if constexpr (Epi::MIDK) { if (t == (nt >> 1)) E.mid(acc, cur, wr, wc, fr, fq); }
            const bool last = (t == nt - 2);
            const char* a1 = cA + (size_t)(t + 1) * kstep;
            const char* a2 = last ? nA : cA + (size_t)(t + 2) * kstep; const char* b2 = last ? nB : cB + (size_t)(t + 2) * kstep;
            const char* a3 = a2 + kstep; const char* b3 = b2 + kstep;
            if (last && has_next) S.a_ready(nxt);
            if constexpr (SP2) {
            PG8_LDB(B0, 0, 0); PG8_LDB(B1, 0, 1); PG8_SCHED; PG8_LDA(At, 0, 0); PG8_STAGE(PG8_SA(1, 1), a1 + hstep, voffA);
            PG8_WAIT_V(8); PG8_WAIT_L(0); PG8_BAR; PG8_MMA(0, 0, At, B0); PG8_MMA(0, 1, At, B1); PG8_BAR; PG8_SCHED;
            PG8_LDA(At, 0, 1); PG8_STAGE(PG8_SB(0, 0), b2, voffB); PG8_STAGE(PG8_SB(0, 1), b2 + hstep, voffB); PG8_STAGE(PG8_SA(0, 0), a2, voffA);
            PG8_WAIT_V(8); PG8_WAIT_L(0); PG8_BAR; PG8_MMA(1, 0, At, B0); PG8_MMA(1, 1, At, B1); PG8_BAR; PG8_SCHED;
            PG8_LDB(B0, 1, 0); PG8_LDB(B1, 1, 1); PG8_SCHED; PG8_LDA(At, 1, 0); PG8_STAGE(PG8_SA(0, 1), a2 + hstep, voffA);
            PG8_WAIT_V(8); PG8_WAIT_L(0); PG8_BAR; PG8_MMA(0, 0, At, B0); PG8_MMA(0, 1, At, B1); PG8_BAR; PG8_SCHED;
            PG8_LDA(At, 1, 1); PG8_STAGE(PG8_SB(1, 0), b3, voffB); PG8_STAGE(PG8_SB(1, 1), b3 + hstep, voffB); PG8_STAGE(PG8_SA(1, 0), a3, voffA);
            PG8_WAIT_V(8); PG8_WAIT_L(0); PG8_BAR; PG8_MMA(1, 0, At, B0); PG8_MMA(1, 1, At, B1); PG8_BAR; PG8_SCHED;
            } else {
            PG8_LDB(B0, 0, 0); PG8_SCHED; PG8_LDA(At, 0, 0); PG8_STAGE(PG8_SA(1, 1), a1 + hstep, voffA);
            PG8_WAIT_L(8); PG8_BAR; PG8_WAIT_L(0); PG8_MMA(0, 0, At, B0); PG8_BAR; PG8_SCHED;
            PG8_LDB(B1, 0, 1); PG8_STAGE(PG8_SB(0, 0), b2, voffB);
            PG8_BAR; PG8_WAIT_L(0); PG8_MMA(0, 1, At, B1); PG8_BAR;
            PG8_LDA(At, 0, 1); PG8_STAGE(PG8_SA(0, 0), a2, voffA);
            PG8_BAR; PG8_WAIT_L(0); PG8_MMA(1, 0, At, B0); PG8_BAR; PG8_SCHED;
            PG8_STAGE(PG8_SB(0, 1), b2 + hstep, voffB);
            PG8_WAIT_V(6); PG8_BAR; PG8_MMA(1, 1, At, B1); PG8_BAR;
            PG8_LDB(B0, 1, 0); PG8_SCHED; PG8_LDA(At, 1, 0); PG8_STAGE(PG8_SA(0, 1), a2 + hstep, voffA);
            PG8_WAIT_L(8); PG8_BAR; PG8_WAIT_L(0); PG8_MMA(0, 0, At, B0); PG8_BAR; PG8_SCHED;
            PG8_LDB(B1, 1, 1); PG8_STAGE(PG8_SB(1, 0), b3, voffB);
            PG8_BAR; PG8_WAIT_L(0); PG8_MMA(0, 1, At, B1); PG8_BAR;
            PG8_LDA(At, 1, 1); PG8_STAGE(PG8_SA(1, 0), a3, voffA);
            PG8_BAR; PG8_WAIT_L(0); PG8_MMA(1, 0, At, B0); PG8_BAR; PG8_SCHED;
            PG8_STAGE(PG8_SB(1, 1), b3 + hstep, voffB);
            PG8_WAIT_V(6); PG8_BAR; PG8_MMA(1, 1, At, B1); PG8_BAR;
            }
        }
        if constexpr (ALIGN_EPI) { if (wr == 0) PG8_BAR; }
        if constexpr (!Epi::AFTER_DRAIN) { E(acc, cur, wr, wc, fr, fq); S.done(cur); }
        if (!has_next) break;
#pragma unroll
        for (int a = 0; a < 2; ++a)
#pragma unroll
            for (int b = 0; b < 2; ++b)
#pragma unroll
                for (int m = 0; m < 4; ++m)
#pragma unroll
                    for (int n = 0; n < 2; ++n) acc[a][b][m][n] = (f32x4){0.f, 0.f, 0.f, 0.f};
        cur = nxt; cA = nA; cB = nB; ++ui;
        if constexpr (ALIGN_EPI) { if (wr == 1) PG8_BAR; }
    }
    PG8_WAIT_V(0);
    if constexpr (!ALIGN_EPI) { if (wr == 0) PG8_BAR; }
    PG8_BAR;
    if constexpr (Epi::AFTER_DRAIN) { E.fused(acc, cur, wr, wc, fr, fq, lds, wid, lane); S.done(cur); }
#undef PG8_SA
#undef PG8_SB
#undef PG8_STAGE
#undef PG8_LDA
#undef PG8_LDB
#undef PG8_MMA
#undef PG8_WAIT_V
#undef PG8_WAIT_L
#undef PG8_BAR
#undef PG8_SCHED
}
}

#define LAS __attribute__((address_space(3)))
typedef unsigned short bf16;
typedef short bf16x8 __attribute__((ext_vector_type(8)));
typedef short s16x4 __attribute__((ext_vector_type(4)));
typedef float f32x4 __attribute__((ext_vector_type(4)));
typedef float f32x2 __attribute__((ext_vector_type(2)));
typedef float f32x16 __attribute__((ext_vector_type(16)));
typedef unsigned u32x4 __attribute__((ext_vector_type(4)));
typedef unsigned u32x2 __attribute__((ext_vector_type(2)));

constexpr int BATCH = 16, SEQ = 4096, DM = 1024, M = BATCH * SEQ, INW = 5120, DFF = 4096;
constexpr float QSCALE = 0.125f * 1.4426950408889634f;
constexpr size_t MiB = 1u << 20;
constexpr size_t WS_XN = 0, WS_QA = 128 * MiB, WS_KA = 192 * MiB, WS_VA = 256 * MiB, WS_QB = 320 * MiB, WS_KB = 384 * MiB, WS_VB = 448 * MiB;
constexpr size_t WS_SGA = 512 * MiB, WS_SGB = 640 * MiB, WS_AO2 = 768 * MiB, WS_ATTA = 832 * MiB, WS_ATTB = 896 * MiB;
constexpr size_t WS_WIN = 960 * MiB, WS_WA = 970 * MiB, WS_WB = 971 * MiB, WS_WOUT = 972 * MiB, WS_W1 = 974 * MiB, WS_W2 = 982 * MiB;
constexpr size_t WS_LSE = 990 * MiB, WS_SSQ1 = 996 * MiB, WS_SSQ2 = 1000 * MiB, WS_ROPE = 1004 * MiB, WS_CTL = 1005 * MiB, WS_END = 1006 * MiB;
constexpr size_t WS_AO0 = 0, WS_AO1 = 64 * MiB, WS_MERGED = 0, WS_X1B = WS_SGA, WS_H = 0;
constexpr int LDS_BYTES = 152576;
constexpr int NPHASE = 10;

#define MFMA32(a, b, c) __builtin_amdgcn_mfma_f32_32x32x16_bf16((a), (b), (c), 0, 0, 0)
__device__ __forceinline__ int crow(int r, int hi) { return (r & 3) + 8 * (r >> 2) + 4 * hi; }
typedef __bf16 bf16x2_t __attribute__((ext_vector_type(2)));
__device__ __forceinline__ unsigned pk2(float lo, float hi) { f32x2 v = {lo, hi}; bf16x2_t b = __builtin_convertvector(v, bf16x2_t); return __builtin_bit_cast(unsigned, b); }
__device__ __forceinline__ float bflo(unsigned w) { return __uint_as_float(w << 16); }
__device__ __forceinline__ float bfhi(unsigned w) { return __uint_as_float(w & 0xffff0000u); }
__device__ __forceinline__ float wave_sum(float v) {
#pragma unroll
    for (int o = 1; o < 64; o <<= 1) v += __shfl_xor(v, o);
    return v;
}
__device__ __forceinline__ s16x4 vtr(const LAS unsigned char* p) {
    typedef short v4i16_t __attribute__((ext_vector_type(4)));
    return __builtin_bit_cast(s16x4, __builtin_amdgcn_ds_read_tr16_b64_v4i16((LAS v4i16_t*)p));
}
__device__ __forceinline__ bf16x8 cat8(s16x4 lo, s16x4 hi) { return (bf16x8){lo[0], lo[1], lo[2], lo[3], hi[0], hi[1], hi[2], hi[3]}; }
__device__ __forceinline__ bf16x8 pack8(const f32x16& x, int s) {
    u32x4 p; p.x = pk2(x[8 * s], x[8 * s + 1]); p.y = pk2(x[8 * s + 2], x[8 * s + 3]); p.z = pk2(x[8 * s + 4], x[8 * s + 5]); p.w = pk2(x[8 * s + 6], x[8 * s + 7]);
    return __builtin_bit_cast(bf16x8, p);
}
__device__ __forceinline__ float xhalf(float v) { return __shfl_xor(v, 32); }

struct Args {
    const float* x; const float* w_in; const float* w_a; const float* w_b; const float* w_out;
    const float* lq1; const float* lk1; const float* lq2; const float* lk2; const float* subln_g;
    const float* g_mix; const float* g_mlp; const float* w_ff1; const float* w_ff2; const float* g_final;
    float* out; unsigned char* ws; int ph_lo, ph_hi;
};

__device__ __forceinline__ void p0_transpose_item(const float* W, int K, int N, bf16* WT, const float* g, bool perm, LAS float* scr, int item, int lane, int pitch = 0) {
    if (pitch == 0) pitch = K;
    const int nblk = N / 32, kb = item / nblk, nb = item % nblk, k0 = 64 * kb, n0 = 32 * nb, l = lane & 31;
    int sc = n0 + l;
    if (perm) sc = (n0 & ~255) + 64 * ((n0 >> 5) & 3) + 32 * ((n0 >> 7) & 1) + l;
#pragma unroll 8
    for (int i = 0; i < 32; ++i) { const int kk = 2 * i + (lane >> 5); float v = W[(size_t)(k0 + kk) * N + sc]; if (g) v *= g[k0 + kk]; scr[kk * 33 + l] = v; }
    asm volatile("s_waitcnt lgkmcnt(0)" ::: "memory");
    const int c = lane & 7;
#pragma unroll
    for (int j = 0; j < 4; ++j) { const int n = (lane >> 3) + 8 * j; const LAS float* s = scr + (8 * c) * 33 + n;
        u32x4 o; o.x = pk2(s[0 * 33], s[1 * 33]); o.y = pk2(s[2 * 33], s[3 * 33]); o.z = pk2(s[4 * 33], s[5 * 33]); o.w = pk2(s[6 * 33], s[7 * 33]);
        *(u32x4*)(WT + (size_t)(n0 + n) * pitch + k0 + 8 * c) = o; }
    asm volatile("s_waitcnt lgkmcnt(0)" ::: "memory");
}
__device__ __forceinline__ void p0_prologue(const Args& A, LAS unsigned char* lds, int vcu, int G) {
    const int tid = threadIdx.x, lane = tid & 63, wave = tid >> 6;
    unsigned char* ws = A.ws;
    LAS float* scr = (LAS float*)(lds + wave * 8704);
    const int gw = vcu * 8 + wave, NGW = G * 8;
    constexpr int I_IN = 16 * 160, I_A = 8 * 32, I_B = 8 * 32, I_O = 16 * 32, I_1 = 16 * 128, I_2 = 64 * 32, NITEMS = I_IN + I_A + I_B + I_O + I_1 + I_2;
    for (int it = gw; it < NITEMS; it += NGW) {
        int r = it;
        if (r < I_IN) { const int n0 = 32 * (r % 160); const bool perm = (n0 < 1024) || (n0 >= 1536 && n0 < 2560);
            p0_transpose_item(A.w_in, 1024, INW, (bf16*)(ws + WS_WIN), nullptr, perm, scr, r, lane); continue; } r -= I_IN;
        if (r < I_A) { p0_transpose_item(A.w_a, 512, 1024, (bf16*)(ws + WS_WA), nullptr, false, scr, r, lane, 1024); continue; } r -= I_A;
        if (r < I_B) { p0_transpose_item(A.w_b, 512, 1024, (bf16*)(ws + WS_WA) + 512, nullptr, false, scr, r, lane, 1024); continue; } r -= I_B;
        if (r < I_O) { p0_transpose_item(A.w_out, 1024, 1024, (bf16*)(ws + WS_WOUT), nullptr, false, scr, r, lane); continue; } r -= I_O;
        if (r < I_1) { p0_transpose_item(A.w_ff1, 1024, DFF, (bf16*)(ws + WS_W1), A.g_mlp, false, scr, r, lane); continue; } r -= I_1;
        p0_transpose_item(A.w_ff2, DFF, 1024, (bf16*)(ws + WS_W2), nullptr, false, scr, r, lane);
    }
    for (int idx = (vcu * 512 + tid); idx < SEQ * 32; idx += G * 512) {
        const int pos = idx >> 5, i = idx & 31;
        const float inv = powf(10000.0f, -(float)(2 * i) / 64.0f);
        const float ang = (float)pos * inv;
        const double a = (double)ang;
        const double kq = rint(a * 0.63661977236758134308);
        const double r = fma(-kq, 1.57079632679489661923, a);
        const double r2 = r * r;
        double sp = 1.0 / 6227020800.0; sp = sp * r2 - 1.0 / 39916800.0; sp = sp * r2 + 1.0 / 362880.0; sp = sp * r2 - 1.0 / 5040.0; sp = sp * r2 + 1.0 / 120.0; sp = sp * r2 - 1.0 / 6.0; sp = sp * r2 + 1.0; sp *= r;
        double cp = 1.0 / 479001600.0; cp = cp * r2 - 1.0 / 3628800.0; cp = cp * r2 + 1.0 / 40320.0; cp = cp * r2 - 1.0 / 720.0; cp = cp * r2 + 1.0 / 24.0; cp = cp * r2 - 0.5; cp = cp * r2 + 1.0;
        const int q = ((int)kq) & 3;
        const double sv = (q == 0) ? sp : (q == 1) ? cp : (q == 2) ? -sp : -cp;
        const double cv = (q == 0) ? cp : (q == 1) ? -sp : (q == 2) ? -cp : sp;
        ((f32x2*)(ws + WS_ROPE))[idx] = (f32x2){(float)cv, (float)sv};
    }
    bf16* XN = (bf16*)(ws + WS_XN);
    f32x4 gv[4];
#pragma unroll
    for (int j = 0; j < 4; ++j) gv[j] = ((const f32x4*)A.g_mix)[lane + 64 * j];
    for (int m = gw; m < M; m += NGW) {
        const f32x4* xr = (const f32x4*)(A.x + (size_t)m * DM) + lane;
        f32x4 v[4]; float s = 0.f;
#pragma unroll
        for (int j = 0; j < 4; ++j) { v[j] = xr[64 * j]; s += (v[j].x * v[j].x + v[j].y * v[j].y) + (v[j].z * v[j].z + v[j].w * v[j].w); }
        const float rstd = 1.0f / sqrtf(wave_sum(s) * (1.0f / DM) + 1e-6f);
        u32x2* o8 = (u32x2*)(XN + (size_t)m * DM) + lane;
#pragma unroll
        for (int j = 0; j < 4; ++j) { u32x2 w; w.x = pk2(v[j].x * rstd * gv[j].x, v[j].y * rstd * gv[j].y); w.y = pk2(v[j].z * rstd * gv[j].z, v[j].w * rstd * gv[j].w); o8[64 * j] = w; }
    }
}

struct EpiIn {
    static constexpr bool PERM = true, AFTER_DRAIN = false, MIDK = false, RELAX = true;
    unsigned char* ws;
    __device__ __forceinline__ void operator()(const f32x4 (&acc)[2][2][4][2], const pg8::Unit& u, int wr, int wc, int fr, int fq) const {
        const int pn = u.pn, row0 = u.pm * 256 + wr * 64 + fr;
        if (pn >= 12) {
            unsigned char* dst = (unsigned char*)(ws + (pn >= 16 ? WS_SGB : WS_SGA)); const int colt = ((pn - 12) & 3) * 256 + wc * 32 + 8 * fq;
#pragma unroll
            for (int ai = 0; ai < 2; ++ai)
#pragma unroll
                for (int m = 0; m < 4; ++m) { unsigned char* rp = dst + (size_t)(row0 + ai * 128 + m * 16) * 1024 + colt;
#pragma unroll
                    for (int bj = 0; bj < 2; ++bj) { float sg[8];
#pragma unroll
                        for (int j = 0; j < 8; ++j) sg[j] = fmaxf(255.0f * __builtin_amdgcn_rcpf(1.0f + __builtin_amdgcn_exp2f(-1.4426950408889634f * acc[ai][bj][m][j >> 2][j & 3])), 1.0f);
                        u32x2 w; w.x = 0u; w.y = 0u;
                        w.x = __builtin_amdgcn_cvt_pk_u8_f32(sg[0], 0, w.x); w.x = __builtin_amdgcn_cvt_pk_u8_f32(sg[1], 1, w.x); w.x = __builtin_amdgcn_cvt_pk_u8_f32(sg[2], 2, w.x); w.x = __builtin_amdgcn_cvt_pk_u8_f32(sg[3], 3, w.x);
                        w.y = __builtin_amdgcn_cvt_pk_u8_f32(sg[4], 0, w.y); w.y = __builtin_amdgcn_cvt_pk_u8_f32(sg[5], 1, w.y); w.y = __builtin_amdgcn_cvt_pk_u8_f32(sg[6], 2, w.y); w.y = __builtin_amdgcn_cvt_pk_u8_f32(sg[7], 3, w.y);
                        *(u32x2*)(rp + bj * 128) = w; } }
        } else {
            const int reg = pn >> 1;
            bf16* dst = (bf16*)(ws + WS_QA + (size_t)reg * 64 * MiB);
            if (reg == 2 || reg == 5) {
                const int colt = (pn & 1) * 256 + wc * 32 + 8 * fq;
#pragma unroll
                for (int ai = 0; ai < 2; ++ai)
#pragma unroll
                    for (int m = 0; m < 4; ++m) { bf16* rp = dst + (size_t)(row0 + ai * 128 + m * 16) * 512 + colt;
#pragma unroll
                        for (int bj = 0; bj < 2; ++bj) { const f32x4 v0 = acc[ai][bj][m][0], v1 = acc[ai][bj][m][1];
                            u32x4 w; w.x = pk2(v0[0], v0[1]); w.y = pk2(v0[2], v0[3]); w.z = pk2(v1[0], v1[1]); w.w = pk2(v1[2], v1[3]); *(u32x4*)(rp + bj * 128) = w; } }
            } else {
                const float sc = (reg == 0 || reg == 3) ? QSCALE : 1.0f;
                const f32x4* rope = (const f32x4*)(ws + WS_ROPE);
                const int head = 4 * (pn & 1) + wc;
#pragma unroll
                for (int ai = 0; ai < 2; ++ai)
#pragma unroll
                    for (int m = 0; m < 4; ++m) { const int row = row0 + ai * 128 + m * 16, pos = row & (SEQ - 1);
                        const f32x4* tp = rope + ((pos * 32 + 8 * fq) >> 1);
                        const f32x4 t0 = tp[0], t1 = tp[1], t2 = tp[2], t3 = tp[3];
                        const float cs[8] = {t0[0], t0[2], t1[0], t1[2], t2[0], t2[2], t3[0], t3[2]}, sn[8] = {t0[1], t0[3], t1[1], t1[3], t2[1], t2[3], t3[1], t3[3]};
                        float o1[8], o2[8];
#pragma unroll
                        for (int j = 0; j < 8; ++j) { const float x1 = acc[ai][0][m][j >> 2][j & 3], x2 = acc[ai][1][m][j >> 2][j & 3];
                            o1[j] = (x1 * cs[j] - x2 * sn[j]) * sc; o2[j] = (x2 * cs[j] + x1 * sn[j]) * sc; }
                        bf16* rp = dst + (size_t)row * 512 + head * 64 + 8 * fq;
                        u32x4 w1, w2; w1.x = pk2(o1[0], o1[1]); w1.y = pk2(o1[2], o1[3]); w1.z = pk2(o1[4], o1[5]); w1.w = pk2(o1[6], o1[7]);
                        w2.x = pk2(o2[0], o2[1]); w2.y = pk2(o2[2], o2[3]); w2.z = pk2(o2[4], o2[5]); w2.w = pk2(o2[6], o2[7]);
                        *(u32x4*)rp = w1; *(u32x4*)(rp + 32) = w2; }
            }
        }
    }
};
__device__ __forceinline__ void unpack8(const u32x4 g, float (&f)[8]) { f[0] = bflo(g.x); f[1] = bfhi(g.x); f[2] = bflo(g.y); f[3] = bfhi(g.y); f[4] = bflo(g.z); f[5] = bfhi(g.z); f[6] = bflo(g.w); f[7] = bfhi(g.w); }
template <int PASS> struct EpiGate {
    static constexpr bool PERM = true, AFTER_DRAIN = false, MIDK = false, RELAX = true;
    const bf16* SG; bf16* MG;
    __device__ __forceinline__ void operator()(const f32x4 (&acc)[2][2][4][2], const pg8::Unit& u, int wr, int wc, int fr, int fq) const {
        const int row0 = u.pm * 256 + wr * 64 + fr, col0 = u.pn * 256 + wc * 32 + 8 * fq;
#pragma unroll
        for (int ai = 0; ai < 2; ++ai)
#pragma unroll
            for (int m = 0; m < 4; ++m) { const size_t off = (size_t)(row0 + ai * 128 + m * 16) * 1024 + col0;
#pragma unroll
                for (int bj = 0; bj < 2; ++bj) { const size_t o = off + bj * 128; const f32x4 v0 = acc[ai][bj][m][0], v1 = acc[ai][bj][m][1];
                    float g[8]; unpack8(*(const u32x4*)(SG + o), g);
                    float r[8] = {v0[0] * g[0], v0[1] * g[1], v0[2] * g[2], v0[3] * g[3], v1[0] * g[4], v1[1] * g[5], v1[2] * g[6], v1[3] * g[7]};
                    if (PASS == 1) { float p[8]; unpack8(*(const u32x4*)(MG + o), p);
#pragma unroll
                        for (int j = 0; j < 8; ++j) r[j] += p[j]; }
                    u32x4 w; w.x = pk2(r[0], r[1]); w.y = pk2(r[2], r[3]); w.z = pk2(r[4], r[5]); w.w = pk2(r[6], r[7]); *(u32x4*)(MG + o) = w; } }
    }
};
__device__ __forceinline__ void unpack8u(const u32x2 g, float (&f)[8]) {
    f[0] = (float)(g.x & 0xffu); f[1] = (float)((g.x >> 8) & 0xffu); f[2] = (float)((g.x >> 16) & 0xffu); f[3] = (float)(g.x >> 24);
    f[4] = (float)(g.y & 0xffu); f[5] = (float)((g.y >> 8) & 0xffu); f[6] = (float)((g.y >> 16) & 0xffu); f[7] = (float)(g.y >> 24);
}
struct EpiGate2 {
    static constexpr bool PERM = true, AFTER_DRAIN = false, MIDK = true, RELAX = false;
    const unsigned char* SGA_; const unsigned char* SGB_; bf16* MG;
    __device__ __forceinline__ void mid(f32x4 (&acc)[2][2][4][2], const pg8::Unit& u, int wr, int wc, int fr, int fq) const {
        int row0 = u.pm * 256 + wr * 64 + fr, col0 = u.pn * 256 + wc * 32 + 8 * fq;
        asm volatile("" : "+v"(row0), "+v"(col0));
#pragma unroll
        for (int ai = 0; ai < 2; ++ai)
#pragma unroll
            for (int m = 0; m < 4; ++m) { const size_t off = (size_t)(row0 + ai * 128 + m * 16) * 1024 + col0;
#pragma unroll
                for (int bj = 0; bj < 2; ++bj) { const size_t o = off + bj * 128; float ga[8], gb[8]; unpack8u(*(const u32x2*)(SGA_ + o), ga); unpack8u(*(const u32x2*)(SGB_ + o), gb);
#pragma unroll
                    for (int j = 0; j < 8; ++j) acc[ai][bj][m][j >> 2][j & 3] *= ga[j] * __builtin_amdgcn_rcpf(gb[j]);
                    asm volatile("" ::: "memory"); } }
    }
    __device__ __forceinline__ void operator()(const f32x4 (&acc)[2][2][4][2], const pg8::Unit& u, int wr, int wc, int fr, int fq) const {
        const int row0 = u.pm * 256 + wr * 64 + fr, col0 = u.pn * 256 + wc * 32 + 8 * fq;
#pragma unroll
        for (int ai = 0; ai < 2; ++ai)
#pragma unroll
            for (int m = 0; m < 4; ++m) { const size_t off = (size_t)(row0 + ai * 128 + m * 16) * 1024 + col0;
#pragma unroll
                for (int bj = 0; bj < 2; ++bj) { const size_t o = off + bj * 128; const f32x4 v0 = acc[ai][bj][m][0] * (1.0f / 255.0f), v1 = acc[ai][bj][m][1] * (1.0f / 255.0f);
                    float g[8]; unpack8u(*(const u32x2*)(SGB_ + o), g);
                    u32x4 w; w.x = pk2(v0[0] * g[0], v0[1] * g[1]); w.y = pk2(v0[2] * g[2], v0[3] * g[3]); w.z = pk2(v1[0] * g[4], v1[1] * g[5]); w.w = pk2(v1[2] * g[6], v1[3] * g[7]); *(u32x4*)(MG + o) = w; } }
    }
};
struct EpiRes1 {
    static constexpr bool PERM = true, AFTER_DRAIN = false, MIDK = false, RELAX = false;
    const float* xi; bf16* xb; float* ssq;
    __device__ __forceinline__ void operator()(const f32x4 (&acc)[2][2][4][2], const pg8::Unit& u, int wr, int wc, int fr, int fq) const {
        const int row0 = u.pm * 256 + wr * 64 + fr, col0 = u.pn * 256 + wc * 32 + 8 * fq;
#pragma unroll
        for (int ai = 0; ai < 2; ++ai)
#pragma unroll
            for (int m = 0; m < 4; ++m) { const int row = row0 + ai * 128 + m * 16; const size_t off = (size_t)row * 1024 + col0; float ss = 0.f;
#pragma unroll
                for (int bj = 0; bj < 2; ++bj) { const size_t o = off + bj * 128;
                    const f32x4 v0 = *(const f32x4*)(xi + o) + acc[ai][bj][m][0], v1 = *(const f32x4*)(xi + o + 4) + acc[ai][bj][m][1];
                    ss += (v0[0] * v0[0] + v0[1] * v0[1]) + (v0[2] * v0[2] + v0[3] * v0[3]) + (v1[0] * v1[0] + v1[1] * v1[1]) + (v1[2] * v1[2] + v1[3] * v1[3]);
                    u32x4 w; w.x = pk2(v0[0], v0[1]); w.y = pk2(v0[2], v0[3]); w.z = pk2(v1[0], v1[1]); w.w = pk2(v1[2], v1[3]); *(u32x4*)(xb + o) = w; }
                ss += __shfl_xor(ss, 16); ss += __shfl_xor(ss, 32);
                if (fq == 0) ssq[(size_t)row * 16 + u.pn * 4 + wc] = ss; }
    }
};
struct EpiFF1 {
    static constexpr bool PERM = true, AFTER_DRAIN = false, MIDK = false, RELAX = true;
    bf16* H;
    __device__ __forceinline__ void operator()(const f32x4 (&acc)[2][2][4][2], const pg8::Unit& u, int wr, int wc, int fr, int fq) const {
        const int row0 = u.pm * 256 + wr * 64 + fr, col0 = u.pn * 256 + wc * 32 + 8 * fq;
#pragma unroll
        for (int ai = 0; ai < 2; ++ai)
#pragma unroll
            for (int m = 0; m < 4; ++m) { bf16* rp = H + (size_t)(row0 + ai * 128 + m * 16) * DFF + col0;
#pragma unroll
                for (int bj = 0; bj < 2; ++bj) { f32x4 v0 = acc[ai][bj][m][0], v1 = acc[ai][bj][m][1];
#pragma unroll
                    for (int j = 0; j < 4; ++j) { const float t0 = fmaxf(v0[j], 0.f), t1 = fmaxf(v1[j], 0.f); v0[j] = t0 * t0; v1[j] = t1 * t1; }
                    u32x4 w; w.x = pk2(v0[0], v0[1]); w.y = pk2(v0[2], v0[3]); w.z = pk2(v1[0], v1[1]); w.w = pk2(v1[2], v1[3]); *(u32x4*)(rp + bj * 128) = w; } }
    }
};
struct EpiRes2 {
    static constexpr bool PERM = true, AFTER_DRAIN = false, MIDK = false, RELAX = false;
    const bf16* xb; const float* ssq1; float* xo; float* ssq2;
    __device__ __forceinline__ void operator()(const f32x4 (&acc)[2][2][4][2], const pg8::Unit& u, int wr, int wc, int fr, int fq) const {
        const int row0 = u.pm * 256 + wr * 64 + fr, col0 = u.pn * 256 + wc * 32 + 8 * fq;
#pragma unroll
        for (int ai = 0; ai < 2; ++ai)
#pragma unroll
            for (int m = 0; m < 4; ++m) { const int row = row0 + ai * 128 + m * 16; const size_t off = (size_t)row * 1024 + col0;
                const f32x4 pt = *(const f32x4*)(ssq1 + (size_t)row * 16 + 4 * fq); float s = (pt[0] + pt[1]) + (pt[2] + pt[3]);
                s += __shfl_xor(s, 16); s += __shfl_xor(s, 32);
                const float r2 = 1.0f / (s * (1.0f / DM) + 1e-6f);
                float ss = 0.f;
#pragma unroll
                for (int bj = 0; bj < 2; ++bj) { const size_t o = off + bj * 128; float x1[8]; unpack8(*(const u32x4*)(xb + o), x1);
                    const f32x4 a0 = acc[ai][bj][m][0], a1 = acc[ai][bj][m][1];
                    const f32x4 v0 = {x1[0] + r2 * a0[0], x1[1] + r2 * a0[1], x1[2] + r2 * a0[2], x1[3] + r2 * a0[3]}, v1 = {x1[4] + r2 * a1[0], x1[5] + r2 * a1[1], x1[6] + r2 * a1[2], x1[7] + r2 * a1[3]};
                    ss += (v0[0] * v0[0] + v0[1] * v0[1]) + (v0[2] * v0[2] + v0[3] * v0[3]) + (v1[0] * v1[0] + v1[1] * v1[1]) + (v1[2] * v1[2] + v1[3] * v1[3]);
                    *(f32x4*)(xo + o) = v0; *(f32x4*)(xo + o + 4) = v1; }
                ss += __shfl_xor(ss, 16); ss += __shfl_xor(ss, 32);
                if (fq == 0) ssq2[(size_t)row * 16 + u.pn * 4 + wc] = ss; }
    }
};

struct EpiFinal {
    static constexpr bool PERM = true, AFTER_DRAIN = false, MIDK = false, RELAX = false;
    const bf16* xb; const float* ssq1; float* out; const float* gfin; float* slot; unsigned* cnt; LAS unsigned char* xl;
    __device__ __forceinline__ void operator()(const f32x4 (&acc_)[2][2][4][2], const pg8::Unit& u, int wr, int wc, int fr, int fq) const {
        f32x4 (&acc)[2][2][4][2] = const_cast<f32x4 (&)[2][2][4][2]>(acc_);
        const int tid = threadIdx.x, lane = tid & 63, wid = tid >> 6;
        const int row0 = u.pm * 256 + wr * 64 + fr, col0 = u.pn * 256 + wc * 32 + 8 * fq;
        LAS float* P = (LAS float*)xl; LAS float* S = (LAS float*)(xl + 4096); LAS unsigned* flag = (LAS unsigned*)(xl + 5120);
#pragma unroll
        for (int ai = 0; ai < 2; ++ai)
#pragma unroll
            for (int m = 0; m < 4; ++m) { const int rl = ai * 128 + wr * 64 + m * 16 + fr, row = u.pm * 256 + rl;
                const f32x4 pt = *(const f32x4*)(ssq1 + (size_t)row * 16 + 4 * fq); float s = (pt[0] + pt[1]) + (pt[2] + pt[3]);
                s += __shfl_xor(s, 16); s += __shfl_xor(s, 32);
                const float r2 = 1.0f / (s * (1.0f / DM) + 1e-6f);
                float ss = 0.f;
#pragma unroll
                for (int bj = 0; bj < 2; ++bj) { float x1[8]; unpack8(*(const u32x4*)(xb + (size_t)row * 1024 + col0 + bj * 128), x1);
#pragma unroll
                    for (int j = 0; j < 8; ++j) { const float v = x1[j] + r2 * acc[ai][bj][m][j >> 2][j & 3]; acc[ai][bj][m][j >> 2][j & 3] = v; ss += v * v; } }
                ss += __shfl_xor(ss, 16); ss += __shfl_xor(ss, 32);
                if (fq == 0) P[rl * 4 + wc] = ss; }
        asm volatile("s_waitcnt lgkmcnt(0)" ::: "memory"); __builtin_amdgcn_s_barrier(); asm volatile("" ::: "memory");
        const int prow = wid * 32 + (lane & 31);
        if (lane < 32) { const float t = (P[prow * 4 + 0] + P[prow * 4 + 1]) + (P[prow * 4 + 2] + P[prow * 4 + 3]);
            __hip_atomic_store(slot + ((size_t)(u.pm * 256 + prow) * 4 + u.pn), t, __ATOMIC_RELAXED, __HIP_MEMORY_SCOPE_AGENT); }
        asm volatile("s_waitcnt vmcnt(0)" ::: "memory");
        if (lane == 0) __hip_atomic_fetch_add(cnt + 64 * u.pm, 1u, __ATOMIC_RELAXED, __HIP_MEMORY_SCOPE_AGENT);
        if (wid == 0) { unsigned sp = 0;
            while ((unsigned)__builtin_amdgcn_readfirstlane(__hip_atomic_load(cnt + 64 * u.pm, __ATOMIC_RELAXED, __HIP_MEMORY_SCOPE_AGENT)) < 32u) { __builtin_amdgcn_s_sleep(2); if (++sp > (1u << 12)) break; }
            __builtin_amdgcn_fence(__ATOMIC_ACQUIRE, "agent");
            if (lane == 0) flag[0] = 1u; }
        asm volatile("s_waitcnt vmcnt(0) lgkmcnt(0)" ::: "memory"); __builtin_amdgcn_s_barrier(); asm volatile("" ::: "memory");
        if (lane < 32) { const float* sl = slot + (size_t)(u.pm * 256 + prow) * 4; float t = 0.f;
#pragma unroll
            for (int k = 0; k < 4; ++k) t += __hip_atomic_load(sl + k, __ATOMIC_RELAXED, __HIP_MEMORY_SCOPE_AGENT);
            S[prow] = 1.0f / sqrtf(t * (1.0f / DM) + 1e-6f); }
        asm volatile("s_waitcnt vmcnt(0) lgkmcnt(0)" ::: "memory"); __builtin_amdgcn_s_barrier(); asm volatile("" ::: "memory");
#pragma unroll
        for (int bj = 0; bj < 2; ++bj) { const f32x4 g0 = *(const f32x4*)(gfin + col0 + bj * 128), g1 = *(const f32x4*)(gfin + col0 + bj * 128 + 4);
#pragma unroll
            for (int ai = 0; ai < 2; ++ai)
#pragma unroll
                for (int m = 0; m < 4; ++m) { const int rl = ai * 128 + wr * 64 + m * 16 + fr; const float rs = S[rl];
                    float* o = out + (size_t)(u.pm * 256 + rl) * 1024 + col0 + bj * 128;
                    *(f32x4*)o = acc[ai][bj][m][0] * rs * g0; *(f32x4*)(o + 4) = acc[ai][bj][m][1] * rs * g1; } }
        asm volatile("s_waitcnt lgkmcnt(0)" ::: "memory"); __builtin_amdgcn_s_barrier(); asm volatile("" ::: "memory");
    }
};

constexpr int AK_CH = 384 * 16 + 16, AV_DB = 384 * 64 + 64, AV_OFF = 8 * AK_CH, AV_BUF = 2 * AV_DB;
#define GLDS16(gsrc, ldst) do { unsigned keep_; asm volatile("s_mov_b32 %0, m0\n\ts_mov_b32 m0, %2\n\ts_nop 0\n\tglobal_load_lds_dwordx4 %1, off\n\ts_mov_b32 m0, %0" : "=&s"(keep_) : "v"(gsrc), "s"((unsigned)__builtin_amdgcn_readfirstlane(ldst)) : "memory"); } while (0)
struct AUnit { int p, sh, ls, ph, t0, head; size_t rowb; };
__device__ __forceinline__ AUnit attnA_decode(int unit) {
    AUnit a; const int u16 = unit & 15; a.p = (unit >> 4) % 3; a.head = (unit / 48) & 7; a.rowb = (size_t)(unit / 384) * SEQ;
    a.sh = 2 * a.p; a.ls = SEQ >> a.sh; a.ph = u16 & ((1 << a.sh) - 1); a.t0 = 256 * (u16 >> a.sh); return a;
}
__device__ __forceinline__ void attnA_dma(LAS unsigned char* lds, const unsigned char* ws, int unit, int vbuf, int wid, int lane) {
    const AUnit a = attnA_decode(unit);
    const bf16* KA = (const bf16*)(ws + WS_KA); const bf16* VA = (const bf16*)(ws + WS_VA);
    const unsigned ldsb = (unsigned)(unsigned long)lds;
#pragma unroll
    for (int k = 0; k < 6; ++k) { const int idx = wid * 6 + k, lr = 8 * idx + (lane >> 3); int t = a.t0 - 64 + lr; t = t < 0 ? 0 : (t > a.ls - 1 ? a.ls - 1 : t);
        const bf16* g = KA + (a.rowb + ((size_t)t << a.sh) + a.ph) * 512 + a.head * 64 + (((lane & 7) ^ ((lr >> 1) & 7)) * 8); GLDS16(g, ldsb + idx * 1024); }
#pragma unroll
    for (int k = 0; k < 6; ++k) { const int idx = wid * 6 + k, dblk = idx / 24, rg = idx % 24; int t = a.t0 - 64 + rg * 16 + (lane >> 2); t = t < 0 ? 0 : (t > a.ls - 1 ? a.ls - 1 : t);
        const bf16* g = VA + (a.rowb + ((size_t)t << a.sh) + a.ph) * 512 + a.head * 64 + dblk * 32 + (lane & 3) * 8; GLDS16(g, ldsb + vbuf + dblk * AV_DB + rg * 1024); }
}
__device__ __forceinline__ void attnA_phase(LAS unsigned char* lds, const unsigned char* ws, int vcu, int G) {
    const int tid = threadIdx.x, lane = tid & 63, w = __builtin_amdgcn_readfirstlane(tid >> 6), r = lane & 31, h = lane >> 5;
    constexpr int NU = BATCH * 8 * 3 * 16;
    const bf16* QA = (const bf16*)(ws + WS_QA);
    if (vcu < NU) attnA_dma(lds, ws, vcu, AV_OFF, w, lane);
    int it = 0;
    bf16x8 qn[4];
    if (vcu < NU) { const AUnit a = attnA_decode(vcu); const size_t qr = a.rowb + ((size_t)(a.t0 + 32 * w + r) << a.sh) + a.ph;
#pragma unroll
        for (int ks = 0; ks < 4; ++ks) qn[ks] = *(const bf16x8*)(QA + qr * 512 + a.head * 64 + 16 * ks + 8 * h); }
    for (int unit = vcu; unit < NU; unit += G, ++it) {
        const AUnit a = attnA_decode(unit);
        const int vbuf = AV_OFF + (it & 1) * AV_BUF;
        bf16* AO = (bf16*)(ws + (a.p == 0 ? WS_AO0 : a.p == 1 ? WS_AO1 : WS_AO2)); float* LSE = (float*)(ws + WS_LSE) + (size_t)a.p * M * 8;
        const int tq = a.t0 + 32 * w + r; const size_t qrow = a.rowb + ((size_t)tq << a.sh) + a.ph;
        bf16x8 qf[4];
#pragma unroll
        for (int ks = 0; ks < 4; ++ks) qf[ks] = qn[ks];
        asm volatile("s_waitcnt vmcnt(0)" ::: "memory");
        __syncthreads();
        f32x16 s[5];
        {
            bf16x8 kf[2][4];
            const LAS unsigned char* kp = lds + (32 * w + r) * 128;
            int kx[4];
#pragma unroll
            for (int ks = 0; ks < 4; ++ks) kx[ks] = ((2 * ks + h) ^ ((r >> 1) & 7)) * 16;
#pragma unroll
            for (int ks = 0; ks < 4; ++ks) kf[0][ks] = *(const LAS bf16x8*)(kp + kx[ks]);
#pragma unroll
            for (int j = 0; j < 5; ++j) {
                if (j + 1 < 5) {
#pragma unroll
                    for (int ks = 0; ks < 4; ++ks) kf[(j + 1) & 1][ks] = *(const LAS bf16x8*)(kp + kx[ks] + (j + 1) * 4096); }
                __builtin_amdgcn_sched_barrier(0);
                f32x16 acc = {};
#pragma unroll
                for (int ks = 0; ks < 4; ++ks) acc = MFMA32(kf[j & 1][ks], qf[ks], acc);
                s[j] = acc;
                __builtin_amdgcn_sched_barrier(0);
            }
        }
        __syncthreads();
        if (unit + G < NU) { attnA_dma(lds, ws, unit + G, AV_OFF + ((it + 1) & 1) * AV_BUF, w, lane);
            const AUnit an = attnA_decode(unit + G); const size_t qr = an.rowb + ((size_t)(an.t0 + 32 * w + r) << an.sh) + an.ph;
#pragma unroll
            for (int ks = 0; ks < 4; ++ks) qn[ks] = *(const bf16x8*)(QA + qr * 512 + an.head * 64 + 16 * ks + 8 * h); }
        float mx = -INFINITY;
        if ((a.t0 - 64 + 32 * w >= 0) && (a.t0 + 32 * w + 96 <= a.ls)) {
#pragma unroll
            for (int i = 0; i < 16; ++i) { const int cr = crow(i, h);
                s[0][i] = (cr >= r) ? s[0][i] : -INFINITY; s[4][i] = (cr <= r) ? s[4][i] : -INFINITY; }
#pragma unroll
            for (int j = 0; j < 5; ++j)
#pragma unroll
                for (int i = 0; i < 16; ++i) mx = fmaxf(mx, s[j][i]);
        } else {
#pragma unroll
            for (int j = 0; j < 5; ++j)
#pragma unroll
                for (int i = 0; i < 16; ++i) { const int cr = crow(i, h), rel = 32 * j + cr - 64 - r, tk = a.t0 - 64 + 32 * w + 32 * j + cr;
                    const bool valid = (rel >= -64) && (rel <= 64) && (tk >= 0) && (tk < a.ls);
                    const float v = valid ? s[j][i] : -INFINITY; s[j][i] = v; mx = fmaxf(mx, v); }
        }
        mx = fmaxf(mx, xhalf(mx));
        float l = 0.f;
#pragma unroll
        for (int j = 0; j < 5; ++j)
#pragma unroll
            for (int i = 0; i < 16; ++i) { const float e = __builtin_amdgcn_exp2f(s[j][i] - mx); s[j][i] = e; l += e; }
        l += xhalf(l);
        f32x16 o[2] = {};
        const int i16 = lane & 15, qd = i16 >> 2, pp = i16 & 3, blk = (lane >> 4) & 1;
        const LAS unsigned char* vb = lds + vbuf + (32 * w + 4 * h + qd) * 64 + blk * 32 + pp * 8;
#pragma unroll
        for (int j = 0; j < 5; ++j)
#pragma unroll
            for (int sp = 0; sp < 2; ++sp) { const bf16x8 pf = pack8(s[j], sp);
#pragma unroll
                for (int db = 0; db < 2; ++db) { const LAS unsigned char* av = vb + db * AV_DB + (32 * j + 16 * sp) * 64;
                    const bf16x8 vf = cat8(vtr(av), vtr(av + 512)); o[db] = MFMA32(vf, pf, o[db]); } }
        const float rl = 1.0f / l;
        bf16* op = AO + qrow * 512 + a.head * 64 + 8 * h;
#pragma unroll
        for (int db = 0; db < 2; ++db)
#pragma unroll
            for (int gp = 0; gp < 2; ++gp) {
                unsigned a0 = pk2(o[db][8 * gp] * rl, o[db][8 * gp + 1] * rl), a1 = pk2(o[db][8 * gp + 2] * rl, o[db][8 * gp + 3] * rl);
                unsigned b0 = pk2(o[db][8 * gp + 4] * rl, o[db][8 * gp + 5] * rl), b1 = pk2(o[db][8 * gp + 6] * rl, o[db][8 * gp + 7] * rl);
                const auto s0 = __builtin_amdgcn_permlane32_swap(a0, b0, false, false); const auto s1 = __builtin_amdgcn_permlane32_swap(a1, b1, false, false);
                u32x4 wv; wv.x = s0[0]; wv.y = s1[0]; wv.z = s0[1]; wv.w = s1[1];
                *(u32x4*)(op + 32 * db + 16 * gp) = wv; }
        if (h == 0) LSE[qrow * 8 + a.head] = mx + __builtin_amdgcn_logf(l);
    }
    __syncthreads();
}

__device__ __forceinline__ void attnA_combine(const unsigned char* ws, int vcu, int G) {
    const bf16* A0 = (const bf16*)(ws + WS_AO0); const bf16* A1 = (const bf16*)(ws + WS_AO1); const bf16* A2 = (const bf16*)(ws + WS_AO2);
    const float* LSE = (const float*)(ws + WS_LSE); bf16* O = (bf16*)(ws + WS_ATTA);
    for (size_t it = (size_t)vcu * 512 + threadIdx.x; it < (size_t)M * 64; it += (size_t)G * 512) {
        const size_t rh = it >> 3;
        const float l0 = LSE[rh], l1 = LSE[(size_t)M * 8 + rh], l2 = LSE[(size_t)2 * M * 8 + rh];
        const float mx = fmaxf(l0, fmaxf(l1, l2));
        float w0 = __builtin_amdgcn_exp2f(l0 - mx), w1 = __builtin_amdgcn_exp2f(l1 - mx), w2 = __builtin_amdgcn_exp2f(l2 - mx);
        const float inv = 1.0f / (w0 + w1 + w2); w0 *= inv; w1 *= inv; w2 *= inv;
        const u32x4 a = *(const u32x4*)(A0 + it * 8), bq = *(const u32x4*)(A1 + it * 8), c = *(const u32x4*)(A2 + it * 8);
        u32x4 o;
#pragma unroll
        for (int k = 0; k < 4; ++k) o[k] = pk2(w0 * bflo(a[k]) + w1 * bflo(bq[k]) + w2 * bflo(c[k]), w0 * bfhi(a[k]) + w1 * bfhi(bq[k]) + w2 * bfhi(c[k]));
        *(u32x4*)(O + (it >> 6) * 1024 + (it & 63) * 8) = o;
    }
}

constexpr int BK_CH = 64 * 16 + 16, BK_IMG = 8 * BK_CH, BV_DB = 64 * 64 + 64, BV_IMG = 4 * BV_DB, BBUF = 2 * BK_IMG + BV_IMG;
__device__ __forceinline__ void attnB_unit(LAS unsigned char* lds, const unsigned char* ws, int unit, float lam, const float* subln_g) {
    const int tid = threadIdx.x, lane = tid & 63, wid = __builtin_amdgcn_readfirstlane(tid >> 6), w = wid & 3, c = wid >> 2, r = lane & 31, h = lane >> 5;
    const int qb = unit & 31, hd = (unit >> 5) & 3, b = unit >> 7, q0 = qb * 128;
    const bf16* QB = (const bf16*)(ws + WS_QB); const bf16* KB = (const bf16*)(ws + WS_KB); const bf16* VB = (const bf16*)(ws + WS_VB); bf16* OB = (bf16*)(ws + WS_ATTA);
    const size_t rowb = (size_t)b * SEQ;
    const size_t qrow = rowb + q0 + 32 * w + r;
    bf16x8 qf[4];
#pragma unroll
    for (int ks = 0; ks < 4; ++ks) qf[ks] = *(const bf16x8*)(QB + qrow * 512 + hd * 128 + c * 64 + 16 * ks + 8 * h);
    const int rot = (qb * 2) & 63;
    const bf16* kg = KB + (rowb + lane) * 512 + hd * 128 + wid * 8;
    const bf16* vg0 = VB + (rowb + (wid & 3) * 16 + (lane >> 2)) * 512 + hd * 128 + (wid >> 2) * 32 + (lane & 3) * 8;
    const unsigned ldsb = (unsigned)(unsigned long)lds;
    const unsigned kd = ldsb + wid * BK_CH, vd0 = ldsb + 2 * BK_IMG + (wid >> 2) * BV_DB + (wid & 3) * 1024;
#define B_DMA(t, boff) do { const size_t go = (size_t)(((t) + rot) & 63) * 64 * 512; \
        GLDS16(kg + go, kd + (boff)); GLDS16(kg + go + 64, kd + BK_IMG + (boff)); GLDS16(vg0 + go, vd0 + (boff)); GLDS16(vg0 + go + 64, vd0 + 2 * BV_DB + (boff)); } while (0)
#define B_WAITBAR() do { asm volatile("s_waitcnt vmcnt(0)" ::: "memory"); __syncthreads(); } while (0)
#define B_QK(boff, S0, S1) do { const LAS unsigned char* kb_ = lds + (boff) + koff; _Pragma("unroll") for (int ks = 0; ks < 4; ++ks) { \
        const bf16x8 a0 = *(const LAS bf16x8*)(kb_ + 2 * ks * BK_CH), a1 = *(const LAS bf16x8*)(kb_ + 2 * ks * BK_CH + 512); \
        S0 = MFMA32(a0, qf[ks], S0); S1 = MFMA32(a1, qf[ks], S1); } } while (0)
    const int i16 = lane & 15, qd = i16 >> 2, pp = i16 & 3, blk = (lane >> 4) & 1;
    const int voff = 2 * BK_IMG + (4 * h + qd) * 64 + blk * 32 + pp * 8, koff = c * BK_IMG + h * BK_CH + r * 16;
    constexpr int NT = SEQ / 64;
    B_DMA(0, 0); B_DMA(1, BBUF);
    B_WAITBAR();
    f32x16 n0 = {}, n1 = {};
    B_QK(0, n0, n1);
    float mrow = fmaxf(n0[0], n1[0]);
#pragma unroll
    for (int i = 1; i < 16; ++i) mrow = fmaxf(mrow, fmaxf(n0[i], n1[i]));
    mrow = fmaxf(mrow, xhalf(mrow));
    f32x16 negm;
#pragma unroll
    for (int i = 0; i < 16; ++i) { negm[i] = -mrow; n0[i] -= mrow; n1[i] -= mrow; }
    f32x16 o[4] = {}; float l = 0.f;
    f32x16 e0, r1; float lp = 0.f;
#pragma unroll
    for (int i = 0; i < 16; ++i) { e0[i] = __builtin_amdgcn_exp2f(n0[i]); lp += e0[i]; }
    r1 = n1;
#define SB() __builtin_amdgcn_sched_barrier(0)
#define B_ITER(t, bcur, bnext, bnn) do { \
        if ((t) + 2 < NT) B_DMA((t) + 2, bnn); \
        bf16x8 kf[8]; \
        if ((t) + 1 < NT) { const LAS unsigned char* kb_ = lds + (bnext) + koff; \
            _Pragma("unroll") for (int ks = 0; ks < 4; ++ks) { kf[2 * ks] = *(const LAS bf16x8*)(kb_ + 2 * ks * BK_CH); kf[2 * ks + 1] = *(const LAS bf16x8*)(kb_ + 2 * ks * BK_CH + 512); } } \
        bf16x8 pf[4]; pf[0] = pack8(e0, 0); pf[1] = pack8(e0, 1); \
        SB(); \
          \
        if ((t) + 1 < NT) { n0 = negm; n1 = negm; \
            _Pragma("unroll") for (int ks = 0; ks < 4; ++ks) { n0 = MFMA32(kf[2 * ks], qf[ks], n0); n1 = MFMA32(kf[2 * ks + 1], qf[ks], n1); } } \
        float lsum = lp; \
        _Pragma("unroll") for (int i = 0; i < 16; ++i) { r1[i] = __builtin_amdgcn_exp2f(r1[i]); lsum += r1[i]; } \
        pf[2] = pack8(r1, 0); pf[3] = pack8(r1, 1); \
        l += lsum; \
        SB(); \
          \
        const LAS unsigned char* vb_ = lds + (bcur) + voff; \
        _Pragma("unroll") for (int kk = 0; kk < 4; ++kk) \
        _Pragma("unroll") for (int db = 0; db < 4; ++db) { const LAS unsigned char* a = vb_ + db * BV_DB + kk * 1024; \
                const bf16x8 vf = cat8(vtr(a), vtr(a + 512)); o[db] = MFMA32(vf, pf[kk], o[db]); } \
        if ((t) + 1 < NT) { lp = 0.f; _Pragma("unroll") for (int i = 0; i < 16; ++i) { e0[i] = __builtin_amdgcn_exp2f(n0[i]); lp += e0[i]; } } \
          \
        if (__any(lsum > 0x1p40f)) { float ls2 = lsum + xhalf(lsum); const float d = ls2 > 0x1p40f ? floorf(__builtin_amdgcn_logf(ls2)) : 0.f, f = __builtin_amdgcn_exp2f(-d); l *= f; lp *= f; \
            _Pragma("unroll") for (int i = 0; i < 16; ++i) { negm[i] -= d; n1[i] -= d; e0[i] *= f; } \
            _Pragma("unroll") for (int db = 0; db < 4; ++db) _Pragma("unroll") for (int i = 0; i < 16; ++i) o[db][i] *= f; } \
        r1 = n1; \
        B_WAITBAR(); } while (0)
    for (int t3 = 0; t3 < NT - 1; t3 += 3) {
        B_ITER(t3, 0, BBUF, 2 * BBUF);
        B_ITER(t3 + 1, BBUF, 2 * BBUF, 0);
        B_ITER(t3 + 2, 2 * BBUF, 0, BBUF);
    }
    B_ITER(NT - 1, 0, BBUF, 2 * BBUF);
#undef B_ITER
#undef B_QK
#undef B_DMA
    l += xhalf(l);
    const float rl = 1.0f / l;
    LAS float* ex = (LAS float*)lds + w * 4096 + lane;
    if (c == 1) {
#pragma unroll
        for (int db = 0; db < 4; ++db)
#pragma unroll
            for (int i = 0; i < 16; ++i) ex[(db * 16 + i) * 64] = o[db][i] * rl;
    }
    __syncthreads();
    if (c == 0) {
        float ss = 0.f;
#pragma unroll
        for (int db = 0; db < 4; ++db)
#pragma unroll
            for (int i = 0; i < 16; ++i) { const float v = o[db][i] * rl - lam * ex[(db * 16 + i) * 64]; o[db][i] = v; ss += v * v; }
        ss += xhalf(ss);
        const float rs = 0.8f / sqrtf(ss * (1.0f / 128.0f) + 1e-5f);
        bf16* op = OB + qrow * 1024 + 512 + hd * 128 + 8 * h;
#pragma unroll
        for (int db = 0; db < 4; ++db)
#pragma unroll
            for (int gp = 0; gp < 2; ++gp) {
                const f32x4 ga = *(const f32x4*)(subln_g + 32 * db + 16 * gp + 4 * h), gb = *(const f32x4*)(subln_g + 32 * db + 16 * gp + 8 + 4 * h);
                unsigned a0 = pk2(o[db][8 * gp] * rs * ga[0], o[db][8 * gp + 1] * rs * ga[1]), a1 = pk2(o[db][8 * gp + 2] * rs * ga[2], o[db][8 * gp + 3] * rs * ga[3]);
                unsigned b0 = pk2(o[db][8 * gp + 4] * rs * gb[0], o[db][8 * gp + 5] * rs * gb[1]), b1 = pk2(o[db][8 * gp + 6] * rs * gb[2], o[db][8 * gp + 7] * rs * gb[3]);
                const auto s0 = __builtin_amdgcn_permlane32_swap(a0, b0, false, false); const auto s1 = __builtin_amdgcn_permlane32_swap(a1, b1, false, false);
                u32x4 wv; wv.x = s0[0]; wv.y = s1[0]; wv.z = s0[1]; wv.w = s1[1];
                *(u32x4*)(op + 32 * db + 16 * gp) = wv; }
    }
    __syncthreads();
}

#define XB_TMO      128
#define XB_XCNT(j)  (256  + 64 * (j))
#define XB_XSUB(j)  (1280 + 64 * (j))
#define XB_XGEN(j)  (2304 + 64 * (j))
#define XB_TOP      3328
#define XB_TOPGEN   3392
#define XCD_BAR_WORDS 3456
#define XB_SPIN_CAP (1u << 18)

__device__ __forceinline__ unsigned xb_ld(unsigned* p)              { return __hip_atomic_load(p, __ATOMIC_RELAXED, __HIP_MEMORY_SCOPE_AGENT); }
__device__ __forceinline__ unsigned xb_add(unsigned* p, unsigned v) { return __hip_atomic_fetch_add(p, v, __ATOMIC_RELAXED, __HIP_MEMORY_SCOPE_AGENT); }
__device__ __forceinline__ unsigned xb_xcc_id() { return (unsigned)__builtin_amdgcn_s_getreg((3 << 11) | 20) & 0xFu; }
#define XB_SPIN(cond, bar) do { unsigned _sp = 0; while (cond) { __builtin_amdgcn_s_sleep(1); \
    if ((++_sp & 255u) == 0u) { if (xb_ld(&(bar)[XB_TMO])) break; if (_sp > XB_SPIN_CAP) { atomicAdd(&(bar)[XB_TMO], 1u); break; } } } } while (0)

struct XcdBarrier {
    unsigned* bar; unsigned x;
    volatile LAS unsigned* st;
};

__device__ __forceinline__ XcdBarrier xcd_barrier_post(unsigned* bar, volatile LAS unsigned* st) {
    XcdBarrier b; b.bar = bar; b.x = xb_xcc_id(); b.st = st;
    if (threadIdx.x == 0) (void)xb_add(&bar[XB_XCNT(b.x)], 1u);
    return b;
}
__device__ __forceinline__ void xcd_barrier_complete(unsigned* bar, unsigned x, unsigned& nloc, unsigned& nx) {
    const unsigned G = gridDim.x * gridDim.y * gridDim.z;
    unsigned sum, cnt, mine, sp = 0u;
    for (;;) {
        sum = 0u; cnt = 0u; mine = 0u;
#pragma unroll
        for (unsigned j = 0; j < 16; ++j) { const unsigned c = xb_ld(&bar[XB_XCNT(j)]); sum += c; cnt += (c > 0u) ? 1u : 0u; mine = (j == x) ? c : mine; }
        if (sum == G) break;
        __builtin_amdgcn_s_sleep(1);
        if ((++sp & 255u) == 0u) { if (xb_ld(&bar[XB_TMO])) break; if (sp > XB_SPIN_CAP) { atomicAdd(&bar[XB_TMO], 1u); break; } }
    }
    nloc = mine > 0u ? mine : 1u; nx = cnt > 0u ? cnt : 1u;
}

__device__ __forceinline__ void xcd_barrier(const XcdBarrier& b) {
    asm volatile("s_waitcnt vmcnt(0)" ::: "memory");
    __syncthreads();
    if (threadIdx.x == 0) {
        unsigned* bar = b.bar;
        __builtin_amdgcn_s_waitcnt(0);
        unsigned nloc = b.st[0], nx = b.st[1];
        if (nloc == 0u) { xcd_barrier_complete(bar, b.x, nloc, nx); b.st[0] = nloc; b.st[1] = nx; }
        const unsigned old = xb_add(&bar[XB_XSUB(b.x)], 1u);
        const unsigned gen = old / nloc;
        if (old + 1u == (gen + 1u) * nloc) {
            __builtin_amdgcn_fence(__ATOMIC_RELEASE, "agent");
            asm volatile("s_waitcnt vmcnt(0)" ::: "memory");
            const unsigned og = xb_add(&bar[XB_TOP], 1u);
            const unsigned tg = og / nx;
            if (og + 1u == (tg + 1u) * nx) xb_add(&bar[XB_TOPGEN], 1u);
            else XB_SPIN(xb_ld(&bar[XB_TOPGEN]) == tg, bar);
            __builtin_amdgcn_fence(__ATOMIC_ACQUIRE, "agent");
            xb_add(&bar[XB_XGEN(b.x)], 1u);
            asm volatile("s_waitcnt vmcnt(0)" ::: "memory");
        } else {
            XB_SPIN(xb_ld(&bar[XB_XGEN(b.x)]) == gen, bar);
            __builtin_amdgcn_fence(__ATOMIC_ACQUIRE, "agent");
            asm volatile("s_waitcnt vmcnt(0)" ::: "memory");
        }
    }
    __syncthreads();
}


__global__ void __launch_bounds__(512, 2) fwd_kernel(Args A) {
    extern __shared__ __attribute__((aligned(16))) unsigned char lds_raw[];
    LAS unsigned char* lds = (LAS unsigned char*)lds_raw;
    const int G = gridDim.x, bx = blockIdx.x, tid = threadIdx.x;
    const int vcu = (G % 8 == 0) ? (bx % 8) * (G / 8) + bx / 8 : bx;
    unsigned char* ws = A.ws;
    const int lo = A.ph_lo, hi = A.ph_hi;
    volatile LAS unsigned* MISC = (volatile LAS unsigned*)(lds + 151552);
    if (tid < 16) MISC[tid] = 0u;
    __syncthreads();
    if (lo == -12345) cg::this_grid().sync();
    XcdBarrier bar = xcd_barrier_post((unsigned*)(ws + WS_CTL), MISC + 8);
#define IN(k) (lo <= (k) && (k) < hi)
#define SEAM(k) do { if (IN(k) && IN((k) + 1)) xcd_barrier(bar); } while (0)
    if (IN(0)) p0_prologue(A, lds, vcu, G);
    SEAM(0);
    if (IN(1)) {
        pg8::Gemm g{(const bf16*)(ws + WS_XN), (const bf16*)(ws + WS_WIN), M, INW, 1024}; pg8::StaticOrder S; S.init(M, INW, G, bx);
        EpiIn E{ws};
        pg8::gemm_phase<EpiIn, pg8::StaticOrder, true, true>(lds, g, S, E);
    }
    SEAM(1);
    if (IN(2)) attnA_phase(lds, ws, vcu, G);
    SEAM(2);
    if (IN(3)) {
        attnA_combine(ws, vcu, G);
        float d1 = 0.f, d2 = 0.f;
        for (int i = 0; i < 64; ++i) { d1 += A.lq1[i] * A.lk1[i]; d2 += A.lq2[i] * A.lk2[i]; }
        const float lam = expf(d1) - expf(d2) + 0.2f;
        if (tid >= 256) __builtin_amdgcn_s_setprio(1);
        for (int u = vcu; u < BATCH * 4 * 32; u += G) attnB_unit(lds, ws, u, lam, A.subln_g);
        __builtin_amdgcn_s_setprio(0);
    }
    SEAM(3);
    if (IN(4)) {
        pg8::Gemm g{(const bf16*)(ws + WS_ATTA), (const bf16*)(ws + WS_WA), M, 1024, 1024}; pg8::StaticOrder S; S.init(M, 1024, G, bx);
        EpiGate2 E{(const unsigned char*)(ws + WS_SGA), (const unsigned char*)(ws + WS_SGB), (bf16*)(ws + WS_MERGED)};
        pg8::gemm_phase<EpiGate2, pg8::StaticOrder, true, true>(lds, g, S, E);
    }
    SEAM(4);
    if (IN(5)) {
        pg8::Gemm g{(const bf16*)(ws + WS_MERGED), (const bf16*)(ws + WS_WOUT), M, 1024, 1024}; pg8::StaticOrder S; S.init(M, 1024, G, bx);
        EpiRes1 E{A.x, (bf16*)(ws + WS_X1B), (float*)(ws + WS_SSQ1)};
        pg8::gemm_phase<EpiRes1, pg8::StaticOrder, true, true>(lds, g, S, E);
    }
    SEAM(5);
    if (IN(6)) {
        pg8::Gemm g{(const bf16*)(ws + WS_X1B), (const bf16*)(ws + WS_W1), M, DFF, 1024}; pg8::StaticOrder S; S.init(M, DFF, G, bx);
        EpiFF1 E{(bf16*)(ws + WS_H)};
        pg8::gemm_phase<EpiFF1, pg8::StaticOrder, true, true>(lds, g, S, E);
    }
    SEAM(6);
    if (IN(7)) {
        pg8::Gemm g{(const bf16*)(ws + WS_H), (const bf16*)(ws + WS_W2), M, 1024, DFF}; pg8::StaticOrder S; S.init(M, 1024, G, bx);
        EpiFinal E{(const bf16*)(ws + WS_X1B), (const float*)(ws + WS_SSQ1), A.out, A.g_final, (float*)(ws + WS_SSQ2), (unsigned*)(ws + WS_CTL + 65536), lds + 131072};
        pg8::gemm_phase<EpiFinal, pg8::StaticOrder, true, true>(lds, g, S, E);
    }
#undef IN
#undef SEAM
}

#ifndef MK_PER_PHASE
#define MK_PER_PHASE 0
#endif
extern "C" void kernel_launch(void* const* d_in, const int* in_sizes, int n_in, void* d_out, int out_size, void* d_ws, size_t ws_size, hipStream_t stream) {
    static int grid = 0;
    if (grid == 0) {
        if (n_in != 15 || in_sizes[0] != M * DM || out_size != M * DM || ws_size < WS_END) { fprintf(stderr, "kernel_launch: unexpected shapes / workspace (%d inputs, ws %zu)\n", n_in, ws_size); grid = -1; return; }
        int dev = 0, cus = 0, per_cu = 0;
        (void)hipGetDevice(&dev); (void)hipDeviceGetAttribute(&cus, hipDeviceAttributeMultiprocessorCount, dev);
        (void)hipFuncSetAttribute((const void*)fwd_kernel, hipFuncAttributeMaxDynamicSharedMemorySize, LDS_BYTES);
        (void)hipOccupancyMaxActiveBlocksPerMultiprocessor(&per_cu, (const void*)fwd_kernel, 512, LDS_BYTES);
        if (per_cu < 1) per_cu = 1;
        grid = cus * per_cu;
        fprintf(stderr, "kernel_launch: %d CUs x %d = grid %d\n", cus, per_cu, grid);
    }
    if (grid < 0) return;
    (void)hipMemsetAsync((unsigned char*)d_ws + WS_CTL, 0, 131072, stream);
    Args a{};
    a.x = (const float*)d_in[0]; a.w_in = (const float*)d_in[1]; a.w_a = (const float*)d_in[2]; a.w_b = (const float*)d_in[3]; a.w_out = (const float*)d_in[4];
    a.lq1 = (const float*)d_in[5]; a.lk1 = (const float*)d_in[6]; a.lq2 = (const float*)d_in[7]; a.lk2 = (const float*)d_in[8]; a.subln_g = (const float*)d_in[9];
    a.g_mix = (const float*)d_in[10]; a.g_mlp = (const float*)d_in[11]; a.w_ff1 = (const float*)d_in[12]; a.w_ff2 = (const float*)d_in[13]; a.g_final = (const float*)d_in[14];
    a.out = (float*)d_out; a.ws = (unsigned char*)d_ws;
#if MK_PER_PHASE
    for (int ph = 0; ph < NPHASE - 1; ++ph) { a.ph_lo = ph; a.ph_hi = ph + 1; hipLaunchKernelGGL(fwd_kernel, dim3(grid), dim3(512), LDS_BYTES, stream, a); }
#else
    a.ph_lo = 0; a.ph_hi = NPHASE;
    void* args[] = {&a};
    hipError_t e = hipLaunchCooperativeKernel((const void*)fwd_kernel, dim3(grid), dim3(512), args, LDS_BYTES, stream);
    if (e != hipSuccess) fprintf(stderr, "cooperative launch failed: %s (grid %d)\n", hipGetErrorString(e), grid);
#endif
}
```

```cpp
#include <hip/hip_runtime.h>
#include <hip/hip_cooperative_groups.h>
#include <cstdio>
#include <cstdint>
namespace cg = cooperative_groups;
namespace pg8 {
#define PG8_LAS __attribute__((address_space(3)))
typedef unsigned short bf16_t;
typedef short bf16x8 __attribute__((ext_vector_type(8)));
typedef float f32x4 __attribute__((ext_vector_type(4)));
typedef unsigned u32x4 __attribute__((ext_vector_type(4)));
constexpr int BM = 256, BK = 64, HALF = 128, HTB = HALF * BK * 2  , STAGE_BYTES = 8 * HTB, NXCD = 8, WGM = 8;

__host__ __device__ __forceinline__ int lds_byte(int r, int c) { const int st = (r >> 4) * 2 + (c >> 5), rr = r & 15, cc = c & 31, ob = rr * 64 + cc * 2; return st * 1024 + (ob ^ (((ob >> 9) & 1) << 5)); }
__host__ __device__ __forceinline__ void stage_rc(int b, int& R, int& C) { const int st = b / 1024, sb = b % 1024, swz = sb ^ (((sb >> 9) & 1) << 5); R = (st >> 1) * 16 + swz / 64; C = (st & 1) * 32 + (swz % 64) / 2; }
__host__ __device__ __forceinline__ int perm32(int rho) { const int n = rho >> 4, i = rho & 15; return 8 * (i >> 2) + 4 * n + (i & 3); }

struct Unit { int pm, pn; };
struct Gemm { const bf16_t* A; const bf16_t* Bt; int M, N, K; };

struct StaticOrder {
    int nM, nN, nwg, G, c, wgm;
    __host__ __device__ void init(int M, int N, int G_, int c_, int wgm_ = WGM) { nM = M / BM; nN = N / BM; nwg = nM * nN; G = G_; c = c_; wgm = wgm_; }
    __host__ __device__ bool next(int i, Unit& u) const {
        const long L = (long)i * G + c; if (L >= nwg) return false;
        int wgid = (int)L; { const int q = nwg / NXCD, r = nwg % NXCD, xcd = wgid % NXCD, off = wgid / NXCD; wgid = (xcd < r ? xcd * (q + 1) : r * (q + 1) + (xcd - r) * q) + off; }
        const int nig = wgm * nN, gid = wgid / nig, fm = gid * wgm, gsz = (nM - fm) < wgm ? (nM - fm) : wgm;
        u.pm = fm + ((wgid % nig) % gsz); u.pn = (wgid % nig) / gsz; return true;
    }
    __device__ __forceinline__ void a_ready(const Unit&) const {}
    __device__ __forceinline__ void done(const Unit&) const {}
};

__device__ __forceinline__ unsigned cvt_pk_bf16(float lo, float hi) { unsigned r; asm volatile("v_cvt_pk_bf16_f32 %0, %1, %2" : "=v"(r) : "v"(lo), "v"(hi)); return r; }
template <class Epi, class Sched, bool ALIGN_EPI = false, bool SP2 = false>
__device__ __forceinline__ void gemm_phase(PG8_LAS unsigned char* lds, const Gemm g, const Sched& S, const Epi& E) {
    const int tid = threadIdx.x, wid = __builtin_amdgcn_readfirstlane(tid >> 6), lane = tid & 63, wr = wid >> 2, wc = wid & 3, fr = lane & 15, fq = lane >> 4;
    const int K = g.K, nt = K / BK;
    unsigned voffA[2], voffB[2];
#pragma unroll
    for (int i = 0; i < 2; ++i) { int R, C; stage_rc(tid * 16 + i * 8192, R, C); const int Rb = Epi::PERM ? ((R & ~31) + perm32(R & 31)) : R;
        voffA[i] = (unsigned)(R * K + C) * 2u; voffB[i] = (unsigned)(Rb * K + C) * 2u; }
    const size_t kstep = (size_t)(BK * 2);
    const size_t hstep = (size_t)HALF * K * 2;
    const size_t tstep = 2 * hstep;
    const unsigned ldsw = (unsigned)wid * 1024u;
    const int aoff = lds_byte(wr * 64 + fr, fq * 8), boff = lds_byte(wc * 32 + fr, fq * 8);
#define PG8_SA(b, h) (((b) * 2 + (h)) * HTB)
#define PG8_SB(b, h) ((4 + (b) * 2 + (h)) * HTB)
#define PG8_STAGE(bufoff, gbase, voff) do { _Pragma("unroll") for (int _i = 0; _i < 2; ++_i) \
        __builtin_amdgcn_global_load_lds((const unsigned*)((const char*)(gbase) + (voff)[_i]), (PG8_LAS unsigned*)(lds + (bufoff) + ldsw + _i * 8192), 16, 0, 0); } while (0)
#define PG8_LDA(dst, b, h) do { _Pragma("unroll") for (int m = 0; m < 4; ++m) _Pragma("unroll") for (int k = 0; k < 2; ++k) dst[m][k] = *(const PG8_LAS bf16x8*)(lds + PG8_SA(b, h) + aoff + m * 2048 + k * 1024); } while (0)
#define PG8_LDB(dst, b, h) do { _Pragma("unroll") for (int n = 0; n < 2; ++n) _Pragma("unroll") for (int k = 0; k < 2; ++k) dst[n][k] = *(const PG8_LAS bf16x8*)(lds + PG8_SB(b, h) + boff + n * 2048 + k * 1024); } while (0)
#define PG8_MMA(ai, bj, At, Bt) do { __builtin_amdgcn_s_setprio(1); _Pragma("unroll") for (int m = 0; m < 4; ++m) _Pragma("unroll") for (int n = 0; n < 2; ++n) _Pragma("unroll") for (int k = 0; k < 2; ++k) \
        acc[ai][bj][m][n] = __builtin_amdgcn_mfma_f32_16x16x32_bf16(Bt[n][k], At[m][k], acc[ai][bj][m][n], 0, 0, 0); __builtin_amdgcn_s_setprio(0); } while (0)
#define PG8_WAIT_V(n) asm volatile("s_waitcnt vmcnt(" #n ")" ::: "memory")
#define PG8_WAIT_L(n) asm volatile("s_waitcnt lgkmcnt(" #n ")" ::: "memory")
#define PG8_BAR __builtin_amdgcn_s_barrier()
#define PG8_SCHED __builtin_amdgcn_sched_barrier(0)
    Unit cur, nxt; int ui = 0;
    if (!S.next(0, cur)) return;
    f32x4 acc[2][2][4][2];
#pragma unroll
    for (int a = 0; a < 2; ++a)
#pragma unroll
        for (int b = 0; b < 2; ++b)
#pragma unroll
            for (int m = 0; m < 4; ++m)
#pragma unroll
                for (int n = 0; n < 2; ++n) acc[a][b][m][n] = (f32x4){0.f, 0.f, 0.f, 0.f};
    bf16x8 At[4][2], B0[2][2], B1[2][2];
    const char* cA = (const char*)g.A + (size_t)cur.pm * tstep; const char* cB = (const char*)g.Bt + (size_t)cur.pn * tstep;
    S.a_ready(cur);
    if constexpr (SP2) {
        PG8_STAGE(PG8_SB(0, 0), cB, voffB); PG8_STAGE(PG8_SB(0, 1), cB + hstep, voffB); PG8_STAGE(PG8_SA(0, 0), cA, voffA); PG8_STAGE(PG8_SA(0, 1), cA + hstep, voffA);
        if (wr == 1) PG8_BAR;
        PG8_WAIT_V(2); PG8_BAR;
        PG8_STAGE(PG8_SB(1, 0), cB + kstep, voffB); PG8_STAGE(PG8_SA(1, 0), cA + kstep, voffA); PG8_STAGE(PG8_SB(1, 1), cB + hstep + kstep, voffB);
        PG8_WAIT_V(6); PG8_BAR;
    } else {
        PG8_STAGE(PG8_SB(0, 0), cB, voffB); PG8_STAGE(PG8_SA(0, 0), cA, voffA); PG8_STAGE(PG8_SB(0, 1), cB + hstep, voffB); PG8_STAGE(PG8_SA(0, 1), cA + hstep, voffA);
        if (wr == 1) PG8_BAR;
        PG8_WAIT_V(4); PG8_BAR;
        PG8_STAGE(PG8_SB(1, 0), cB + kstep, voffB); PG8_STAGE(PG8_SA(1, 0), cA + kstep, voffA); PG8_STAGE(PG8_SB(1, 1), cB + hstep + kstep, voffB);
        PG8_WAIT_V(6); PG8_BAR;
    }
    for (;;) {
        const bool has_next = S.next(ui + 1, nxt);
        const char* nA = has_next ? (const char*)g.A + (size_t)nxt.pm * tstep : cA; const char* nB = has_next ? (const char*)g.Bt + (size_t)nxt.pn * tstep : cB;
        for (int t = 0; t < nt; t += 2) {
            if constexpr (Epi::MIDK) { if (t == (nt >> 1)) E.mid(acc, cur, wr, wc, fr, fq); }
            const bool last = (t == nt - 2);
            const char* a1 = cA + (size_t)(t + 1) * kstep;
            const char* a2 = last ? nA : cA + (size_t)(t + 2) * kstep; const char* b2 = last ? nB : cB + (size_t)(t + 2) * kstep;
            const char* a3 = a2 + kstep; const char* b3 = b2 + kstep;
            if (last && has_next) S.a_ready(nxt);
            if constexpr (SP2) {
            PG8_LDB(B0, 0, 0); PG8_LDB(B1, 0, 1); PG8_SCHED; PG8_LDA(At, 0, 0); PG8_STAGE(PG8_SA(1, 1), a1 + hstep, voffA);
            PG8_WAIT_V(8); PG8_WAIT_L(0); PG8_BAR; PG8_MMA(0, 0, At, B0); PG8_MMA(0, 1, At, B1); PG8_BAR; PG8_SCHED;
            PG8_LDA(At, 0, 1); PG8_STAGE(PG8_SB(0, 0), b2, voffB); PG8_STAGE(PG8_SB(0, 1), b2 + hstep, voffB); PG8_STAGE(PG8_SA(0, 0), a2, voffA);
            PG8_WAIT_V(8); PG8_WAIT_L(0); PG8_BAR; PG8_MMA(1, 0, At, B0); PG8_MMA(1, 1, At, B1); PG8_BAR; PG8_SCHED;
            PG8_LDB(B0, 1, 0); PG8_LDB(B1, 1, 1); PG8_SCHED; PG8_LDA(At, 1, 0); PG8_STAGE(PG8_SA(0, 1), a2 + hstep, voffA);
            PG8_WAIT_V(8); PG8_WAIT_L(0); PG8_BAR; PG8_MMA(0, 0, At, B0); PG8_MMA(0, 1, At, B1); PG8_BAR; PG8_SCHED;
            PG8_LDA(At, 1, 1); PG8_STAGE(PG8_SB(1, 0), b3, voffB); PG8_STAGE(PG8_SB(1, 1), b3 + hstep, voffB); PG8_STAGE(PG8_SA(1, 0), a3, voffA);
            PG8_WAIT_V(8); PG8_WAIT_L(0); PG8_BAR; PG8_MMA(1, 0, At, B0); PG8_MMA(1, 1, At, B1); PG8_BAR; PG8_SCHED;
            } else {
            PG8_LDB(B0, 0, 0); PG8_SCHED; PG8_LDA(At, 0, 0); PG8_STAGE(PG8_SA(1, 1), a1 + hstep, voffA);
            PG8_WAIT_L(8); PG8_BAR; PG8_WAIT_L(0); PG8_MMA(0, 0, At, B0); PG8_BAR; PG8_SCHED;
            PG8_LDB(B1, 0, 1); PG8_STAGE(PG8_SB(0, 0), b2, voffB);
            PG8_BAR; PG8_WAIT_L(0); PG8_MMA(0, 1, At, B1); PG8_BAR;
            PG8_LDA(At, 0, 1); PG8_STAGE(PG8_SA(0, 0), a2, voffA);
            PG8_BAR; PG8_WAIT_L(0); PG8_MMA(1, 0, At, B0); PG8_BAR; PG8_SCHED;
            PG8_STAGE(PG8_SB(0, 1), b2 + hstep, voffB);
            PG8_WAIT_V(6); PG8_BAR; PG8_MMA(1, 1, At, B1); PG8_BAR;
            PG8_LDB(B0, 1, 0); PG8_SCHED; PG8_LDA(At, 1, 0); PG8_STAGE(PG8_SA(0, 1), a2 + hstep, voffA);
            PG8_WAIT_L(8); PG8_BAR; PG8_WAIT_L(0); PG8_MMA(0, 0, At, B0); PG8_BAR; PG8_SCHED;
            PG8_LDB(B1, 1, 1); PG8_STAGE(PG8_SB(1, 0), b3, voffB);
            PG8_BAR; PG8_WAIT_L(0); PG8_MMA(0, 1, At, B1); PG8_BAR;
            PG8_LDA(At, 1, 1); PG8_STAGE(PG8_SA(1, 0), a3, voffA);
            PG8_BAR; PG8_WAIT_L(0); PG8_MMA(1, 0, At, B0); PG8_BAR; PG8_SCHED;
            PG8_STAGE(PG8_SB(1, 1), b3 + hstep, voffB);
            PG8_WAIT_V(6); PG8_BAR; PG8_MMA(1, 1, At, B1); PG8_BAR;
            }
        }
        if constexpr (ALIGN_EPI) { if (wr == 0) PG8_BAR; }
        if constexpr (!Epi::AFTER_DRAIN) { E(acc, cur, wr, wc, fr, fq); S.done(cur); }
        if (!has_next) break;
#pragma unroll
        for (int a = 0; a < 2; ++a)
#pragma unroll
            for (int b = 0; b < 2; ++b)
#pragma unroll
                for (int m = 0; m < 4; ++m)
#pragma unroll
                    for (int n = 0; n < 2; ++n) acc[a][b][m][n] = (f32x4){0.f, 0.f, 0.f, 0.f};
        cur = nxt; cA = nA; cB = nB; ++ui;
        if constexpr (ALIGN_EPI) { if (wr == 1) PG8_BAR; }
    }
    PG8_WAIT_V(0);
    if constexpr (!ALIGN_EPI) { if (wr == 0) PG8_BAR; }
    PG8_BAR;
    if constexpr (Epi::AFTER_DRAIN) { E.fused(acc, cur, wr, wc, fr, fq, lds, wid, lane); S.done(cur); }
#undef PG8_SA
#undef PG8_SB
#undef PG8_STAGE
#undef PG8_LDA
#undef PG8_LDB
#undef PG8_MMA
#undef PG8_WAIT_V
#undef PG8_WAIT_L
#undef PG8_BAR
#undef PG8_SCHED
}
}

#define LAS __attribute__((address_space(3)))
typedef unsigned short bf16;
typedef short bf16x8 __attribute__((ext_vector_type(8)));
typedef short s16x4 __attribute__((ext_vector_type(4)));
typedef float f32x4 __attribute__((ext_vector_type(4)));
typedef float f32x2 __attribute__((ext_vector_type(2)));
typedef float f32x16 __attribute__((ext_vector_type(16)));
typedef unsigned u32x4 __attribute__((ext_vector_type(4)));
typedef unsigned u32x2 __attribute__((ext_vector_type(2)));

constexpr int BATCH = 16, SEQ = 4096, DM = 1024, M = BATCH * SEQ, INW = 5120, DFF = 4096;
constexpr float QSCALE = 0.125f * 1.4426950408889634f;
constexpr size_t MiB = 1u << 20;
constexpr size_t WS_XN = 0, WS_QA = 128 * MiB, WS_KA = 192 * MiB, WS_VA = 256 * MiB, WS_QB = 320 * MiB, WS_KB = 384 * MiB, WS_VB = 448 * MiB;
constexpr size_t WS_SGA = 512 * MiB, WS_SGB = 640 * MiB, WS_AO2 = 768 * MiB, WS_ATTA = 832 * MiB, WS_ATTB = 896 * MiB;
constexpr size_t WS_WIN = 960 * MiB, WS_WA = 970 * MiB, WS_WB = 971 * MiB, WS_WOUT = 972 * MiB, WS_W1 = 974 * MiB, WS_W2 = 982 * MiB;
constexpr size_t WS_LSE = 990 * MiB, WS_SSQ1 = 996 * MiB, WS_SSQ2 = 1000 * MiB, WS_ROPE = 1004 * MiB, WS_CTL = 1005 * MiB, WS_END = 1006 * MiB;
constexpr size_t WS_AO0 = 0, WS_AO1 = 64 * MiB, WS_MERGED = 0, WS_X1B = WS_SGA, WS_H = 0;
constexpr int LDS_BYTES = 152576;
constexpr int NPHASE = 10;

#define MFMA32(a, b, c) __builtin_amdgcn_mfma_f32_32x32x16_bf16((a), (b), (c), 0, 0, 0)
__device__ __forceinline__ int crow(int r, int hi) { return (r & 3) + 8 * (r >> 2) + 4 * hi; }
typedef __bf16 bf16x2_t __attribute__((ext_vector_type(2)));
__device__ __forceinline__ unsigned pk2(float lo, float hi) { f32x2 v = {lo, hi}; bf16x2_t b = __builtin_convertvector(v, bf16x2_t); return __builtin_bit_cast(unsigned, b); }
__device__ __forceinline__ float bflo(unsigned w) { return __uint_as_float(w << 16); }
__device__ __forceinline__ float bfhi(unsigned w) { return __uint_as_float(w & 0xffff0000u); }
__device__ __forceinline__ float wave_sum(float v) {
#pragma unroll
    for (int o = 1; o < 64; o <<= 1) v += __shfl_xor(v, o);
    return v;
}
__device__ __forceinline__ s16x4 vtr(const LAS unsigned char* p) {
    typedef short v4i16_t __attribute__((ext_vector_type(4)));
    return __builtin_bit_cast(s16x4, __builtin_amdgcn_ds_read_tr16_b64_v4i16((LAS v4i16_t*)p));
}
__device__ __forceinline__ bf16x8 cat8(s16x4 lo, s16x4 hi) { return (bf16x8){lo[0], lo[1], lo[2], lo[3], hi[0], hi[1], hi[2], hi[3]}; }
__device__ __forceinline__ bf16x8 pack8(const f32x16& x, int s) {
    u32x4 p; p.x = pk2(x[8 * s], x[8 * s + 1]); p.y = pk2(x[8 * s + 2], x[8 * s + 3]); p.z = pk2(x[8 * s + 4], x[8 * s + 5]); p.w = pk2(x[8 * s + 6], x[8 * s + 7]);
    return __builtin_bit_cast(bf16x8, p);
}
__device__ __forceinline__ float xhalf(float v) { return __shfl_xor(v, 32); }

struct Args {
    const float* x; const float* w_in; const float* w_a; const float* w_b; const float* w_out;
    const float* lq1; const float* lk1; const float* lq2; const float* lk2; const float* subln_g;
    const float* g_mix; const float* g_mlp; const float* w_ff1; const float* w_ff2; const float* g_final;
    float* out; unsigned char* ws; int ph_lo, ph_hi;
};

__device__ __forceinline__ void p0_transpose_item(const float* W, int K, int N, bf16* WT, const float* g, bool perm, LAS float* scr, int item, int lane, int pitch = 0) {
    if (pitch == 0) pitch = K;
    const int nblk = N / 32, kb = item / nblk, nb = item % nblk, k0 = 64 * kb, n0 = 32 * nb, l = lane & 31;
    int sc = n0 + l;
    if (perm) sc = (n0 & ~255) + 64 * ((n0 >> 5) & 3) + 32 * ((n0 >> 7) & 1) + l;
#pragma unroll 8
    for (int i = 0; i < 32; ++i) { const int kk = 2 * i + (lane >> 5); float v = W[(size_t)(k0 + kk) * N + sc]; if (g) v *= g[k0 + kk]; scr[kk * 33 + l] = v; }
    asm volatile("s_waitcnt lgkmcnt(0)" ::: "memory");
    const int c = lane & 7;
#pragma unroll
    for (int j = 0; j < 4; ++j) { const int n = (lane >> 3) + 8 * j; const LAS float* s = scr + (8 * c) * 33 + n;
        u32x4 o; o.x = pk2(s[0 * 33], s[1 * 33]); o.y = pk2(s[2 * 33], s[3 * 33]); o.z = pk2(s[4 * 33], s[5 * 33]); o.w = pk2(s[6 * 33], s[7 * 33]);
        *(u32x4*)(WT + (size_t)(n0 + n) * pitch + k0 + 8 * c) = o; }
    asm volatile("s_waitcnt lgkmcnt(0)" ::: "memory");
}
__device__ __forceinline__ void p0_prologue(const Args& A, LAS unsigned char* lds, int vcu, int G) {
    const int tid = threadIdx.x, lane = tid & 63, wave = tid >> 6;
    unsigned char* ws = A.ws;
    LAS float* scr = (LAS float*)(lds + wave * 8704);
    const int gw = vcu * 8 + wave, NGW = G * 8;
    constexpr int I_IN = 16 * 160, I_A = 8 * 32, I_B = 8 * 32, I_O = 16 * 32, I_1 = 16 * 128, I_2 = 64 * 32, NITEMS = I_IN + I_A + I_B + I_O + I_1 + I_2;
    for (int it = gw; it < NITEMS; it += NGW) {
        int r = it;
        if (r < I_IN) { const int n0 = 32 * (r % 160); const bool perm = (n0 < 1024) || (n0 >= 1536 && n0 < 2560);
            p0_transpose_item(A.w_in, 1024, INW, (bf16*)(ws + WS_WIN), nullptr, perm, scr, r, lane); continue; } r -= I_IN;
        if (r < I_A) { p0_transpose_item(A.w_a, 512, 1024, (bf16*)(ws + WS_WA), nullptr, false, scr, r, lane, 1024); continue; } r -= I_A;
        if (r < I_B) { p0_transpose_item(A.w_b, 512, 1024, (bf16*)(ws + WS_WA) + 512, nullptr, false, scr, r, lane, 1024); continue; } r -= I_B;
        if (r < I_O) { p0_transpose_item(A.w_out, 1024, 1024, (bf16*)(ws + WS_WOUT), nullptr, false, scr, r, lane); continue; } r -= I_O;
        if (r < I_1) { p0_transpose_item(A.w_ff1, 1024, DFF, (bf16*)(ws + WS_W1), A.g_mlp, false, scr, r, lane); continue; } r -= I_1;
        p0_transpose_item(A.w_ff2, DFF, 1024, (bf16*)(ws + WS_W2), nullptr, false, scr, r, lane);
    }
    for (int idx = (vcu * 512 + tid); idx < SEQ * 32; idx += G * 512) {
        const int pos = idx >> 5, i = idx & 31;
        const float inv = powf(10000.0f, -(float)(2 * i) / 64.0f);
        const float ang = (float)pos * inv;
        const double a = (double)ang;
        const double kq = rint(a * 0.63661977236758134308);
        const double r = fma(-kq, 1.57079632679489661923, a);
        const double r2 = r * r;
        double sp = 1.0 / 6227020800.0; sp = sp * r2 - 1.0 / 39916800.0; sp = sp * r2 + 1.0 / 362880.0; sp = sp * r2 - 1.0 / 5040.0; sp = sp * r2 + 1.0 / 120.0; sp = sp * r2 - 1.0 / 6.0; sp = sp * r2 + 1.0; sp *= r;
        double cp = 1.0 / 479001600.0; cp = cp * r2 - 1.0 / 3628800.0; cp = cp * r2 + 1.0 / 40320.0; cp = cp * r2 - 1.0 / 720.0; cp = cp * r2 + 1.0 / 24.0; cp = cp * r2 - 0.5; cp = cp * r2 + 1.0;
        const int q = ((int)kq) & 3;
        const double sv = (q == 0) ? sp : (q == 1) ? cp : (q == 2) ? -sp : -cp;
        const double cv = (q == 0) ? cp : (q == 1) ? -sp : (q == 2) ? -cp : sp;
        ((f32x2*)(ws + WS_ROPE))[idx] = (f32x2){(float)cv, (float)sv};
    }
    bf16* XN = (bf16*)(ws + WS_XN);
    f32x4 gv[4];
#pragma unroll
    for (int j = 0; j < 4; ++j) gv[j] = ((const f32x4*)A.g_mix)[lane + 64 * j];
    for (int m = gw; m < M; m += NGW) {
        const f32x4* xr = (const f32x4*)(A.x + (size_t)m * DM) + lane;
        f32x4 v[4]; float s = 0.f;
#pragma unroll
        for (int j = 0; j < 4; ++j) { v[j] = xr[64 * j]; s += (v[j].x * v[j].x + v[j].y * v[j].y) + (v[j].z * v[j].z + v[j].w * v[j].w); }
        const float rstd = 1.0f / sqrtf(wave_sum(s) * (1.0f / DM) + 1e-6f);
        u32x2* o8 = (u32x2*)(XN + (size_t)m * DM) + lane;
#pragma unroll
        for (int j = 0; j < 4; ++j) { u32x2 w; w.x = pk2(v[j].x * rstd * gv[j].x, v[j].y * rstd * gv[j].y); w.y = pk2(v[j].z * rstd * gv[j].z, v[j].w * rstd * gv[j].w); o8[64 * j] = w; }
    }
}

struct EpiIn {
    static constexpr bool PERM = true, AFTER_DRAIN = false, MIDK = false;
    unsigned char* ws;
    __device__ __forceinline__ void operator()(const f32x4 (&acc)[2][2][4][2], const pg8::Unit& u, int wr, int wc, int fr, int fq) const {
        const int pn = u.pn, row0 = u.pm * 256 + wr * 64 + fr;
        if (pn >= 12) {
            unsigned char* dst = (unsigned char*)(ws + (pn >= 16 ? WS_SGB : WS_SGA)); const int colt = ((pn - 12) & 3) * 256 + wc * 32 + 8 * fq;
#pragma unroll
            for (int ai = 0; ai < 2; ++ai)
#pragma unroll
                for (int m = 0; m < 4; ++m) { unsigned char* rp = dst + (size_t)(row0 + ai * 128 + m * 16) * 1024 + colt;
#pragma unroll
                    for (int bj = 0; bj < 2; ++bj) { float sg[8];
#pragma unroll
                        for (int j = 0; j < 8; ++j) sg[j] = fmaxf(255.0f * __builtin_amdgcn_rcpf(1.0f + __builtin_amdgcn_exp2f(-1.4426950408889634f * acc[ai][bj][m][j >> 2][j & 3])), 1.0f);
                        u32x2 w; w.x = 0u; w.y = 0u;
                        w.x = __builtin_amdgcn_cvt_pk_u8_f32(sg[0], 0, w.x); w.x = __builtin_amdgcn_cvt_pk_u8_f32(sg[1], 1, w.x); w.x = __builtin_amdgcn_cvt_pk_u8_f32(sg[2], 2, w.x); w.x = __builtin_amdgcn_cvt_pk_u8_f32(sg[3], 3, w.x);
                        w.y = __builtin_amdgcn_cvt_pk_u8_f32(sg[4], 0, w.y); w.y = __builtin_amdgcn_cvt_pk_u8_f32(sg[5], 1, w.y); w.y = __builtin_amdgcn_cvt_pk_u8_f32(sg[6], 2, w.y); w.y = __builtin_amdgcn_cvt_pk_u8_f32(sg[7], 3, w.y);
                        *(u32x2*)(rp + bj * 128) = w; } }
        } else {
            const int reg = pn >> 1;
            bf16* dst = (bf16*)(ws + WS_QA + (size_t)reg * 64 * MiB);
            if (reg == 2 || reg == 5) {
                const int colt = (pn & 1) * 256 + wc * 32 + 8 * fq;
#pragma unroll
                for (int ai = 0; ai < 2; ++ai)
#pragma unroll
                    for (int m = 0; m < 4; ++m) { bf16* rp = dst + (size_t)(row0 + ai * 128 + m * 16) * 512 + colt;
#pragma unroll
                        for (int bj = 0; bj < 2; ++bj) { const f32x4 v0 = acc[ai][bj][m][0], v1 = acc[ai][bj][m][1];
                            u32x4 w; w.x = pk2(v0[0], v0[1]); w.y = pk2(v0[2], v0[3]); w.z = pk2(v1[0], v1[1]); w.w = pk2(v1[2], v1[3]); *(u32x4*)(rp + bj * 128) = w; } }
            } else {
                const float sc = (reg == 0 || reg == 3) ? QSCALE : 1.0f;
                const f32x4* rope = (const f32x4*)(ws + WS_ROPE);
                const int head = 4 * (pn & 1) + wc;
#pragma unroll
                for (int ai = 0; ai < 2; ++ai)
#pragma unroll
                    for (int m = 0; m < 4; ++m) { const int row = row0 + ai * 128 + m * 16, pos = row & (SEQ - 1);
                        const f32x4* tp = rope + ((pos * 32 + 8 * fq) >> 1);
                        const f32x4 t0 = tp[0], t1 = tp[1], t2 = tp[2], t3 = tp[3];
                        const float cs[8] = {t0[0], t0[2], t1[0], t1[2], t2[0], t2[2], t3[0], t3[2]}, sn[8] = {t0[1], t0[3], t1[1], t1[3], t2[1], t2[3], t3[1], t3[3]};
                        float o1[8], o2[8];
#pragma unroll
                        for (int j = 0; j < 8; ++j) { const float x1 = acc[ai][0][m][j >> 2][j & 3], x2 = acc[ai][1][m][j >> 2][j & 3];
                            o1[j] = (x1 * cs[j] - x2 * sn[j]) * sc; o2[j] = (x2 * cs[j] + x1 * sn[j]) * sc; }
                        bf16* rp = dst + (size_t)row * 512 + head * 64 + 8 * fq;
                        u32x4 w1, w2; w1.x = pk2(o1[0], o1[1]); w1.y = pk2(o1[2], o1[3]); w1.z = pk2(o1[4], o1[5]); w1.w = pk2(o1[6], o1[7]);
                        w2.x = pk2(o2[0], o2[1]); w2.y = pk2(o2[2], o2[3]); w2.z = pk2(o2[4], o2[5]); w2.w = pk2(o2[6], o2[7]);
                        *(u32x4*)rp = w1; *(u32x4*)(rp + 32) = w2; }
            }
        }
    }
};
__device__ __forceinline__ void unpack8(const u32x4 g, float (&f)[8]) { f[0] = bflo(g.x); f[1] = bfhi(g.x); f[2] = bflo(g.y); f[3] = bfhi(g.y); f[4] = bflo(g.z); f[5] = bfhi(g.z); f[6] = bflo(g.w); f[7] = bfhi(g.w); }
template <int PASS> struct EpiGate {
    static constexpr bool PERM = true, AFTER_DRAIN = false, MIDK = false;
    const bf16* SG; bf16* MG;
    __device__ __forceinline__ void operator()(const f32x4 (&acc)[2][2][4][2], const pg8::Unit& u, int wr, int wc, int fr, int fq) const {
        const int row0 = u.pm * 256 + wr * 64 + fr, col0 = u.pn * 256 + wc * 32 + 8 * fq;
#pragma unroll
        for (int ai = 0; ai < 2; ++ai)
#pragma unroll
            for (int m = 0; m < 4; ++m) { const size_t off = (size_t)(row0 + ai * 128 + m * 16) * 1024 + col0;
#pragma unroll
                for (int bj = 0; bj < 2; ++bj) { const size_t o = off + bj * 128; const f32x4 v0 = acc[ai][bj][m][0], v1 = acc[ai][bj][m][1];
                    float g[8]; unpack8(*(const u32x4*)(SG + o), g);
                    float r[8] = {v0[0] * g[0], v0[1] * g[1], v0[2] * g[2], v0[3] * g[3], v1[0] * g[4], v1[1] * g[5], v1[2] * g[6], v1[3] * g[7]};
                    if (PASS == 1) { float p[8]; unpack8(*(const u32x4*)(MG + o), p);
#pragma unroll
                        for (int j = 0; j < 8; ++j) r[j] += p[j]; }
                    u32x4 w; w.x = pk2(r[0], r[1]); w.y = pk2(r[2], r[3]); w.z = pk2(r[4], r[5]); w.w = pk2(r[6], r[7]); *(u32x4*)(MG + o) = w; } }
    }
};
__device__ __forceinline__ void unpack8u(const u32x2 g, float (&f)[8]) {
    f[0] = (float)(g.x & 0xffu); f[1] = (float)((g.x >> 8) & 0xffu); f[2] = (float)((g.x >> 16) & 0xffu); f[3] = (float)(g.x >> 24);
    f[4] = (float)(g.y & 0xffu); f[5] = (float)((g.y >> 8) & 0xffu); f[6] = (float)((g.y >> 16) & 0xffu); f[7] = (float)(g.y >> 24);
}
struct EpiGate2 {
    static constexpr bool PERM = true, AFTER_DRAIN = false, MIDK = true;
    const unsigned char* SGA_; const unsigned char* SGB_; bf16* MG;
    __device__ __forceinline__ void mid(f32x4 (&acc)[2][2][4][2], const pg8::Unit& u, int wr, int wc, int fr, int fq) const {
        int row0 = u.pm * 256 + wr * 64 + fr, col0 = u.pn * 256 + wc * 32 + 8 * fq;
        asm volatile("" : "+v"(row0), "+v"(col0));
#pragma unroll
        for (int ai = 0; ai < 2; ++ai)
#pragma unroll
            for (int m = 0; m < 4; ++m) { const size_t off = (size_t)(row0 + ai * 128 + m * 16) * 1024 + col0;
#pragma unroll
                for (int bj = 0; bj < 2; ++bj) { const size_t o = off + bj * 128; float ga[8], gb[8]; unpack8u(*(const u32x2*)(SGA_ + o), ga); unpack8u(*(const u32x2*)(SGB_ + o), gb);
#pragma unroll
                    for (int j = 0; j < 8; ++j) acc[ai][bj][m][j >> 2][j & 3] *= ga[j] * __builtin_amdgcn_rcpf(gb[j]);
                    asm volatile("" ::: "memory"); } }
    }
    __device__ __forceinline__ void operator()(const f32x4 (&acc)[2][2][4][2], const pg8::Unit& u, int wr, int wc, int fr, int fq) const {
        const int row0 = u.pm * 256 + wr * 64 + fr, col0 = u.pn * 256 + wc * 32 + 8 * fq;
#pragma unroll
        for (int ai = 0; ai < 2; ++ai)
#pragma unroll
            for (int m = 0; m < 4; ++m) { const size_t off = (size_t)(row0 + ai * 128 + m * 16) * 1024 + col0;
#pragma unroll
                for (int bj = 0; bj < 2; ++bj) { const size_t o = off + bj * 128; const f32x4 v0 = acc[ai][bj][m][0] * (1.0f / 255.0f), v1 = acc[ai][bj][m][1] * (1.0f / 255.0f);
                    float g[8]; unpack8u(*(const u32x2*)(SGB_ + o), g);
                    u32x4 w; w.x = pk2(v0[0] * g[0], v0[1] * g[1]); w.y = pk2(v0[2] * g[2], v0[3] * g[3]); w.z = pk2(v1[0] * g[4], v1[1] * g[5]); w.w = pk2(v1[2] * g[6], v1[3] * g[7]); *(u32x4*)(MG + o) = w; } }
    }
};
struct EpiRes1 {
    static constexpr bool PERM = true, AFTER_DRAIN = false, MIDK = false;
    const float* xi; bf16* xb; float* ssq;
    __device__ __forceinline__ void operator()(const f32x4 (&acc)[2][2][4][2], const pg8::Unit& u, int wr, int wc, int fr, int fq) const {
        const int row0 = u.pm * 256 + wr * 64 + fr, col0 = u.pn * 256 + wc * 32 + 8 * fq;
#pragma unroll
        for (int ai = 0; ai < 2; ++ai)
#pragma unroll
            for (int m = 0; m < 4; ++m) { const int row = row0 + ai * 128 + m * 16; const size_t off = (size_t)row * 1024 + col0; float ss = 0.f;
#pragma unroll
                for (int bj = 0; bj < 2; ++bj) { const size_t o = off + bj * 128;
                    const f32x4 v0 = *(const f32x4*)(xi + o) + acc[ai][bj][m][0], v1 = *(const f32x4*)(xi + o + 4) + acc[ai][bj][m][1];
                    ss += (v0[0] * v0[0] + v0[1] * v0[1]) + (v0[2] * v0[2] + v0[3] * v0[3]) + (v1[0] * v1[0] + v1[1] * v1[1]) + (v1[2] * v1[2] + v1[3] * v1[3]);
                    u32x4 w; w.x = pk2(v0[0], v0[1]); w.y = pk2(v0[2], v0[3]); w.z = pk2(v1[0], v1[1]); w.w = pk2(v1[2], v1[3]); *(u32x4*)(xb + o) = w; }
                ss += __shfl_xor(ss, 16); ss += __shfl_xor(ss, 32);
                if (fq == 0) ssq[(size_t)row * 16 + u.pn * 4 + wc] = ss; }
    }
};
struct EpiFF1 {
    static constexpr bool PERM = true, AFTER_DRAIN = false, MIDK = false;
    bf16* H;
    __device__ __forceinline__ void operator()(const f32x4 (&acc)[2][2][4][2], const pg8::Unit& u, int wr, int wc, int fr, int fq) const {
        const int row0 = u.pm * 256 + wr * 64 + fr, col0 = u.pn * 256 + wc * 32 + 8 * fq;
#pragma unroll
        for (int ai = 0; ai < 2; ++ai)
#pragma unroll
            for (int m = 0; m < 4; ++m) { bf16* rp = H + (size_t)(row0 + ai * 128 + m * 16) * DFF + col0;
#pragma unroll
                for (int bj = 0; bj < 2; ++bj) { f32x4 v0 = acc[ai][bj][m][0], v1 = acc[ai][bj][m][1];
#pragma unroll
                    for (int j = 0; j < 4; ++j) { const float t0 = fmaxf(v0[j], 0.f), t1 = fmaxf(v1[j], 0.f); v0[j] = t0 * t0; v1[j] = t1 * t1; }
                    u32x4 w; w.x = pk2(v0[0], v0[1]); w.y = pk2(v0[2], v0[3]); w.z = pk2(v1[0], v1[1]); w.w = pk2(v1[2], v1[3]); *(u32x4*)(rp + bj * 128) = w; } }
    }
};
struct EpiRes2 {
    static constexpr bool PERM = true, AFTER_DRAIN = false, MIDK = false;
    const bf16* xb; const float* ssq1; float* xo; float* ssq2;
    __device__ __forceinline__ void operator()(const f32x4 (&acc)[2][2][4][2], const pg8::Unit& u, int wr, int wc, int fr, int fq) const {
        const int row0 = u.pm * 256 + wr * 64 + fr, col0 = u.pn * 256 + wc * 32 + 8 * fq;
#pragma unroll
        for (int ai = 0; ai < 2; ++ai)
#pragma unroll
            for (int m = 0; m < 4; ++m) { const int row = row0 + ai * 128 + m * 16; const size_t off = (size_t)row * 1024 + col0;
                const f32x4 pt = *(const f32x4*)(ssq1 + (size_t)row * 16 + 4 * fq); float s = (pt[0] + pt[1]) + (pt[2] + pt[3]);
                s += __shfl_xor(s, 16); s += __shfl_xor(s, 32);
                const float r2 = 1.0f / (s * (1.0f / DM) + 1e-6f);
                float ss = 0.f;
#pragma unroll
                for (int bj = 0; bj < 2; ++bj) { const size_t o = off + bj * 128; float x1[8]; unpack8(*(const u32x4*)(xb + o), x1);
                    const f32x4 a0 = acc[ai][bj][m][0], a1 = acc[ai][bj][m][1];
                    const f32x4 v0 = {x1[0] + r2 * a0[0], x1[1] + r2 * a0[1], x1[2] + r2 * a0[2], x1[3] + r2 * a0[3]}, v1 = {x1[4] + r2 * a1[0], x1[5] + r2 * a1[1], x1[6] + r2 * a1[2], x1[7] + r2 * a1[3]};
                    ss += (v0[0] * v0[0] + v0[1] * v0[1]) + (v0[2] * v0[2] + v0[3] * v0[3]) + (v1[0] * v1[0] + v1[1] * v1[1]) + (v1[2] * v1[2] + v1[3] * v1[3]);
                    *(f32x4*)(xo + o) = v0; *(f32x4*)(xo + o + 4) = v1; }
                ss += __shfl_xor(ss, 16); ss += __shfl_xor(ss, 32);
                if (fq == 0) ssq2[(size_t)row * 16 + u.pn * 4 + wc] = ss; }
    }
};

struct EpiFinal {
    static constexpr bool PERM = true, AFTER_DRAIN = false, MIDK = false;
    const bf16* xb; const float* ssq1; float* out; const float* gfin; float* slot; unsigned* cnt; LAS unsigned char* xl;
    __device__ __forceinline__ void operator()(const f32x4 (&acc_)[2][2][4][2], const pg8::Unit& u, int wr, int wc, int fr, int fq) const {
        f32x4 (&acc)[2][2][4][2] = const_cast<f32x4 (&)[2][2][4][2]>(acc_);
        const int tid = threadIdx.x, lane = tid & 63, wid = tid >> 6;
        const int row0 = u.pm * 256 + wr * 64 + fr, col0 = u.pn * 256 + wc * 32 + 8 * fq;
        LAS float* P = (LAS float*)xl; LAS float* S = (LAS float*)(xl + 4096); LAS unsigned* flag = (LAS unsigned*)(xl + 5120);
#pragma unroll
        for (int ai = 0; ai < 2; ++ai)
#pragma unroll
            for (int m = 0; m < 4; ++m) { const int rl = ai * 128 + wr * 64 + m * 16 + fr, row = u.pm * 256 + rl;
                const f32x4 pt = *(const f32x4*)(ssq1 + (size_t)row * 16 + 4 * fq); float s = (pt[0] + pt[1]) + (pt[2] + pt[3]);
                s += __shfl_xor(s, 16); s += __shfl_xor(s, 32);
                const float r2 = 1.0f / (s * (1.0f / DM) + 1e-6f);
                float ss = 0.f;
#pragma unroll
                for (int bj = 0; bj < 2; ++bj) { float x1[8]; unpack8(*(const u32x4*)(xb + (size_t)row * 1024 + col0 + bj * 128), x1);
#pragma unroll
                    for (int j = 0; j < 8; ++j) { const float v = x1[j] + r2 * acc[ai][bj][m][j >> 2][j & 3]; acc[ai][bj][m][j >> 2][j & 3] = v; ss += v * v; } }
                ss += __shfl_xor(ss, 16); ss += __shfl_xor(ss, 32);
                if (fq == 0) P[rl * 4 + wc] = ss; }
        asm volatile("s_waitcnt lgkmcnt(0)" ::: "memory"); __builtin_amdgcn_s_barrier(); asm volatile("" ::: "memory");
        const int prow = wid * 32 + (lane & 31);
        if (lane < 32) { const float t = (P[prow * 4 + 0] + P[prow * 4 + 1]) + (P[prow * 4 + 2] + P[prow * 4 + 3]);
            __hip_atomic_store(slot + ((size_t)(u.pm * 256 + prow) * 4 + u.pn), t, __ATOMIC_RELAXED, __HIP_MEMORY_SCOPE_AGENT); }
        asm volatile("s_waitcnt vmcnt(0)" ::: "memory");
        if (lane == 0) __hip_atomic_fetch_add(cnt + 64 * u.pm, 1u, __ATOMIC_RELAXED, __HIP_MEMORY_SCOPE_AGENT);
        if (wid == 0) { unsigned sp = 0;
            while ((unsigned)__builtin_amdgcn_readfirstlane(__hip_atomic_load(cnt + 64 * u.pm, __ATOMIC_RELAXED, __HIP_MEMORY_SCOPE_AGENT)) < 32u) { __builtin_amdgcn_s_sleep(2); if (++sp > (1u << 12)) break; }
            __builtin_amdgcn_fence(__ATOMIC_ACQUIRE, "agent");
            if (lane == 0) flag[0] = 1u; }
        asm volatile("s_waitcnt vmcnt(0) lgkmcnt(0)" ::: "memory"); __builtin_amdgcn_s_barrier(); asm volatile("" ::: "memory");
        if (lane < 32) { const float* sl = slot + (size_t)(u.pm * 256 + prow) * 4; float t = 0.f;
#pragma unroll
            for (int k = 0; k < 4; ++k) t += __hip_atomic_load(sl + k, __ATOMIC_RELAXED, __HIP_MEMORY_SCOPE_AGENT);
            S[prow] = 1.0f / sqrtf(t * (1.0f / DM) + 1e-6f); }
        asm volatile("s_waitcnt vmcnt(0) lgkmcnt(0)" ::: "memory"); __builtin_amdgcn_s_barrier(); asm volatile("" ::: "memory");
#pragma unroll
        for (int bj = 0; bj < 2; ++bj) { const f32x4 g0 = *(const f32x4*)(gfin + col0 + bj * 128), g1 = *(const f32x4*)(gfin + col0 + bj * 128 + 4);
#pragma unroll
            for (int ai = 0; ai < 2; ++ai)
#pragma unroll
                for (int m = 0; m < 4; ++m) { const int rl = ai * 128 + wr * 64 + m * 16 + fr; const float rs = S[rl];
                    float* o = out + (size_t)(u.pm * 256 + rl) * 1024 + col0 + bj * 128;
                    *(f32x4*)o = acc[ai][bj][m][0] * rs * g0; *(f32x4*)(o + 4) = acc[ai][bj][m][1] * rs * g1; } }
        asm volatile("s_waitcnt lgkmcnt(0)" ::: "memory"); __builtin_amdgcn_s_barrier(); asm volatile("" ::: "memory");
    }
};

constexpr int AK_CH = 384 * 16 + 16, AV_DB = 384 * 64 + 64, AV_OFF = 8 * AK_CH, AV_BUF = 2 * AV_DB;
#define GLDS16(gsrc, ldst) do { unsigned keep_; asm volatile("s_mov_b32 %0, m0\n\ts_mov_b32 m0, %2\n\ts_nop 0\n\tglobal_load_lds_dwordx4 %1, off\n\ts_mov_b32 m0, %0" : "=&s"(keep_) : "v"(gsrc), "s"((unsigned)__builtin_amdgcn_readfirstlane(ldst)) : "memory"); } while (0)
struct AUnit { int p, sh, ls, ph, t0, head; size_t rowb; };
__device__ __forceinline__ AUnit attnA_decode(int unit) {
    AUnit a; const int u16 = unit & 15; a.p = (unit >> 4) % 3; a.head = (unit / 48) & 7; a.rowb = (size_t)(unit / 384) * SEQ;
    a.sh = 2 * a.p; a.ls = SEQ >> a.sh; a.ph = u16 & ((1 << a.sh) - 1); a.t0 = 256 * (u16 >> a.sh); return a;
}
__device__ __forceinline__ void attnA_dma(LAS unsigned char* lds, const unsigned char* ws, int unit, int vbuf, int wid, int lane) {
    const AUnit a = attnA_decode(unit);
    const bf16* KA = (const bf16*)(ws + WS_KA); const bf16* VA = (const bf16*)(ws + WS_VA);
    const unsigned ldsb = (unsigned)(unsigned long)lds;
#pragma unroll
    for (int k = 0; k < 6; ++k) { const int idx = wid * 6 + k, lr = 8 * idx + (lane >> 3); int t = a.t0 - 64 + lr; t = t < 0 ? 0 : (t > a.ls - 1 ? a.ls - 1 : t);
        const bf16* g = KA + (a.rowb + ((size_t)t << a.sh) + a.ph) * 512 + a.head * 64 + (((lane & 7) ^ ((lr >> 1) & 7)) * 8); GLDS16(g, ldsb + idx * 1024); }
#pragma unroll
    for (int k = 0; k < 6; ++k) { const int idx = wid * 6 + k, dblk = idx / 24, rg = idx % 24; int t = a.t0 - 64 + rg * 16 + (lane >> 2); t = t < 0 ? 0 : (t > a.ls - 1 ? a.ls - 1 : t);
        const bf16* g = VA + (a.rowb + ((size_t)t << a.sh) + a.ph) * 512 + a.head * 64 + dblk * 32 + (lane & 3) * 8; GLDS16(g, ldsb + vbuf + dblk * AV_DB + rg * 1024); }
}
__device__ __forceinline__ void attnA_phase(LAS unsigned char* lds, const unsigned char* ws, int vcu, int G) {
    const int tid = threadIdx.x, lane = tid & 63, w = __builtin_amdgcn_readfirstlane(tid >> 6), r = lane & 31, h = lane >> 5;
    constexpr int NU = BATCH * 8 * 3 * 16;
    const bf16* QA = (const bf16*)(ws + WS_QA);
    if (vcu < NU) attnA_dma(lds, ws, vcu, AV_OFF, w, lane);
    int it = 0;
    bf16x8 qn[4];
    if (vcu < NU) { const AUnit a = attnA_decode(vcu); const size_t qr = a.rowb + ((size_t)(a.t0 + 32 * w + r) << a.sh) + a.ph;
#pragma unroll
        for (int ks = 0; ks < 4; ++ks) qn[ks] = *(const bf16x8*)(QA + qr * 512 + a.head * 64 + 16 * ks + 8 * h); }
    for (int unit = vcu; unit < NU; unit += G, ++it) {
        const AUnit a = attnA_decode(unit);
        const int vbuf = AV_OFF + (it & 1) * AV_BUF;
        bf16* AO = (bf16*)(ws + (a.p == 0 ? WS_AO0 : a.p == 1 ? WS_AO1 : WS_AO2)); float* LSE = (float*)(ws + WS_LSE) + (size_t)a.p * M * 8;
        const int tq = a.t0 + 32 * w + r; const size_t qrow = a.rowb + ((size_t)tq << a.sh) + a.ph;
        bf16x8 qf[4];
#pragma unroll
        for (int ks = 0; ks < 4; ++ks) qf[ks] = qn[ks];
        asm volatile("s_waitcnt vmcnt(0)" ::: "memory");
        __syncthreads();
        f32x16 s[5];
        {
            bf16x8 kf[2][4];
            const LAS unsigned char* kp = lds + (32 * w + r) * 128;
            int kx[4];
#pragma unroll
            for (int ks = 0; ks < 4; ++ks) kx[ks] = ((2 * ks + h) ^ ((r >> 1) & 7)) * 16;
#pragma unroll
            for (int ks = 0; ks < 4; ++ks) kf[0][ks] = *(const LAS bf16x8*)(kp + kx[ks]);
#pragma unroll
            for (int j = 0; j < 5; ++j) {
                if (j + 1 < 5) {
#pragma unroll
                    for (int ks = 0; ks < 4; ++ks) kf[(j + 1) & 1][ks] = *(const LAS bf16x8*)(kp + kx[ks] + (j + 1) * 4096); }
                __builtin_amdgcn_sched_barrier(0);
                f32x16 acc = {};
#pragma unroll
                for (int ks = 0; ks < 4; ++ks) acc = MFMA32(kf[j & 1][ks], qf[ks], acc);
                s[j] = acc;
                __builtin_amdgcn_sched_barrier(0);
            }
        }
        __syncthreads();
        if (unit + G < NU) { attnA_dma(lds, ws, unit + G, AV_OFF + ((it + 1) & 1) * AV_BUF, w, lane);
            const AUnit an = attnA_decode(unit + G); const size_t qr = an.rowb + ((size_t)(an.t0 + 32 * w + r) << an.sh) + an.ph;
#pragma unroll
            for (int ks = 0; ks < 4; ++ks) qn[ks] = *(const bf16x8*)(QA + qr * 512 + an.head * 64 + 16 * ks + 8 * h); }
        float mx = -INFINITY;
        if ((a.t0 - 64 + 32 * w >= 0) && (a.t0 + 32 * w + 96 <= a.ls)) {
#pragma unroll
            for (int i = 0; i < 16; ++i) { const int cr = crow(i, h);
                s[0][i] = (cr >= r) ? s[0][i] : -INFINITY; s[4][i] = (cr <= r) ? s[4][i] : -INFINITY; }
#pragma unroll
            for (int j = 0; j < 5; ++j)
#pragma unroll
                for (int i = 0; i < 16; ++i) mx = fmaxf(mx, s[j][i]);
        } else {
#pragma unroll
            for (int j = 0; j < 5; ++j)
#pragma unroll
                for (int i = 0; i < 16; ++i) { const int cr = crow(i, h), rel = 32 * j + cr - 64 - r, tk = a.t0 - 64 + 32 * w + 32 * j + cr;
                    const bool valid = (rel >= -64) && (rel <= 64) && (tk >= 0) && (tk < a.ls);
                    const float v = valid ? s[j][i] : -INFINITY; s[j][i] = v; mx = fmaxf(mx, v); }
        }
        mx = fmaxf(mx, xhalf(mx));
        float l = 0.f;
#pragma unroll
        for (int j = 0; j < 5; ++j)
#pragma unroll
            for (int i = 0; i < 16; ++i) { const float e = __builtin_amdgcn_exp2f(s[j][i] - mx); s[j][i] = e; l += e; }
        l += xhalf(l);
        f32x16 o[2] = {};
        const int i16 = lane & 15, qd = i16 >> 2, pp = i16 & 3, blk = (lane >> 4) & 1;
        const LAS unsigned char* vb = lds + vbuf + (32 * w + 4 * h + qd) * 64 + blk * 32 + pp * 8;
#pragma unroll
        for (int j = 0; j < 5; ++j)
#pragma unroll
            for (int sp = 0; sp < 2; ++sp) { const bf16x8 pf = pack8(s[j], sp);
#pragma unroll
                for (int db = 0; db < 2; ++db) { const LAS unsigned char* av = vb + db * AV_DB + (32 * j + 16 * sp) * 64;
                    const bf16x8 vf = cat8(vtr(av), vtr(av + 512)); o[db] = MFMA32(vf, pf, o[db]); } }
        const float rl = 1.0f / l;
        bf16* op = AO + qrow * 512 + a.head * 64 + 8 * h;
#pragma unroll
        for (int db = 0; db < 2; ++db)
#pragma unroll
            for (int gp = 0; gp < 2; ++gp) {
                unsigned a0 = pk2(o[db][8 * gp] * rl, o[db][8 * gp + 1] * rl), a1 = pk2(o[db][8 * gp + 2] * rl, o[db][8 * gp + 3] * rl);
                unsigned b0 = pk2(o[db][8 * gp + 4] * rl, o[db][8 * gp + 5] * rl), b1 = pk2(o[db][8 * gp + 6] * rl, o[db][8 * gp + 7] * rl);
                const auto s0 = __builtin_amdgcn_permlane32_swap(a0, b0, false, false); const auto s1 = __builtin_amdgcn_permlane32_swap(a1, b1, false, false);
                u32x4 wv; wv.x = s0[0]; wv.y = s1[0]; wv.z = s0[1]; wv.w = s1[1];
                *(u32x4*)(op + 32 * db + 16 * gp) = wv; }
        if (h == 0) LSE[qrow * 8 + a.head] = mx + __builtin_amdgcn_logf(l);
    }
    __syncthreads();
}

__device__ __forceinline__ void attnA_combine(const unsigned char* ws, int vcu, int G) {
    const bf16* A0 = (const bf16*)(ws + WS_AO0); const bf16* A1 = (const bf16*)(ws + WS_AO1); const bf16* A2 = (const bf16*)(ws + WS_AO2);
    const float* LSE = (const float*)(ws + WS_LSE); bf16* O = (bf16*)(ws + WS_ATTA);
    for (size_t it = (size_t)vcu * 512 + threadIdx.x; it < (size_t)M * 64; it += (size_t)G * 512) {
        const size_t rh = it >> 3;
        const float l0 = LSE[rh], l1 = LSE[(size_t)M * 8 + rh], l2 = LSE[(size_t)2 * M * 8 + rh];
        const float mx = fmaxf(l0, fmaxf(l1, l2));
        float w0 = __builtin_amdgcn_exp2f(l0 - mx), w1 = __builtin_amdgcn_exp2f(l1 - mx), w2 = __builtin_amdgcn_exp2f(l2 - mx);
        const float inv = 1.0f / (w0 + w1 + w2); w0 *= inv; w1 *= inv; w2 *= inv;
        const u32x4 a = *(const u32x4*)(A0 + it * 8), bq = *(const u32x4*)(A1 + it * 8), c = *(const u32x4*)(A2 + it * 8);
        u32x4 o;
#pragma unroll
        for (int k = 0; k < 4; ++k) o[k] = pk2(w0 * bflo(a[k]) + w1 * bflo(bq[k]) + w2 * bflo(c[k]), w0 * bfhi(a[k]) + w1 * bfhi(bq[k]) + w2 * bfhi(c[k]));
        *(u32x4*)(O + (it >> 6) * 1024 + (it & 63) * 8) = o;
    }
}

constexpr int BK_CH = 64 * 16 + 16, BK_IMG = 8 * BK_CH, BV_DB = 64 * 64 + 64, BV_IMG = 4 * BV_DB, BBUF = 2 * BK_IMG + BV_IMG;
__device__ __forceinline__ void attnB_unit(LAS unsigned char* lds, const unsigned char* ws, int unit, float lam, const float* subln_g) {
    const int tid = threadIdx.x, lane = tid & 63, wid = __builtin_amdgcn_readfirstlane(tid >> 6), w = wid & 3, c = wid >> 2, r = lane & 31, h = lane >> 5;
    const int qb = unit & 31, hd = (unit >> 5) & 3, b = unit >> 7, q0 = qb * 128;
    const bf16* QB = (const bf16*)(ws + WS_QB); const bf16* KB = (const bf16*)(ws + WS_KB); const bf16* VB = (const bf16*)(ws + WS_VB); bf16* OB = (bf16*)(ws + WS_ATTA);
    const size_t rowb = (size_t)b * SEQ;
    const size_t qrow = rowb + q0 + 32 * w + r;
    bf16x8 qf[4];
#pragma unroll
    for (int ks = 0; ks < 4; ++ks) qf[ks] = *(const bf16x8*)(QB + qrow * 512 + hd * 128 + c * 64 + 16 * ks + 8 * h);
    const int rot = (qb * 2) & 63;
    const bf16* kg = KB + (rowb + lane) * 512 + hd * 128 + wid * 8;
    const bf16* vg0 = VB + (rowb + (wid & 3) * 16 + (lane >> 2)) * 512 + hd * 128 + (wid >> 2) * 32 + (lane & 3) * 8;
    const unsigned ldsb = (unsigned)(unsigned long)lds;
    const unsigned kd = ldsb + wid * BK_CH, vd0 = ldsb + 2 * BK_IMG + (wid >> 2) * BV_DB + (wid & 3) * 1024;
#define B_DMA(t, boff) do { const size_t go = (size_t)(((t) + rot) & 63) * 64 * 512; \
        GLDS16(kg + go, kd + (boff)); GLDS16(kg + go + 64, kd + BK_IMG + (boff)); GLDS16(vg0 + go, vd0 + (boff)); GLDS16(vg0 + go + 64, vd0 + 2 * BV_DB + (boff)); } while (0)
#define B_WAITBAR() do { asm volatile("s_waitcnt vmcnt(0)" ::: "memory"); __syncthreads(); } while (0)
#define B_QK(boff, S0, S1) do { const LAS unsigned char* kb_ = lds + (boff) + koff; _Pragma("unroll") for (int ks = 0; ks < 4; ++ks) { \
        const bf16x8 a0 = *(const LAS bf16x8*)(kb_ + 2 * ks * BK_CH), a1 = *(const LAS bf16x8*)(kb_ + 2 * ks * BK_CH + 512); \
        S0 = MFMA32(a0, qf[ks], S0); S1 = MFMA32(a1, qf[ks], S1); } } while (0)
    const int i16 = lane & 15, qd = i16 >> 2, pp = i16 & 3, blk = (lane >> 4) & 1;
    const int voff = 2 * BK_IMG + (4 * h + qd) * 64 + blk * 32 + pp * 8, koff = c * BK_IMG + h * BK_CH + r * 16;
    constexpr int NT = SEQ / 64;
    B_DMA(0, 0); B_DMA(1, BBUF);
    B_WAITBAR();
    f32x16 n0 = {}, n1 = {};
    B_QK(0, n0, n1);
    float mrow = fmaxf(n0[0], n1[0]);
#pragma unroll
    for (int i = 1; i < 16; ++i) mrow = fmaxf(mrow, fmaxf(n0[i], n1[i]));
    mrow = fmaxf(mrow, xhalf(mrow));
    f32x16 negm;
#pragma unroll
    for (int i = 0; i < 16; ++i) { negm[i] = -mrow; n0[i] -= mrow; n1[i] -= mrow; }
    f32x16 o[4] = {}; float l = 0.f;
#define SB() __builtin_amdgcn_sched_barrier(0)
#define B_ITER(t, bcur, bnext, bnn) do { \
        if ((t) + 2 < NT) B_DMA((t) + 2, bnn); \
        f32x16 s0 = n0, s1 = n1; bf16x8 kf[8]; \
        if ((t) + 1 < NT) { const LAS unsigned char* kb_ = lds + (bnext) + koff; \
            _Pragma("unroll") for (int ks = 0; ks < 4; ++ks) { kf[2 * ks] = *(const LAS bf16x8*)(kb_ + 2 * ks * BK_CH); kf[2 * ks + 1] = *(const LAS bf16x8*)(kb_ + 2 * ks * BK_CH + 512); } } \
        SB(); \
        float lsum = 0.f; bf16x8 pf[4]; \
        _Pragma("unroll") for (int i = 0; i < 16; ++i) { s0[i] = __builtin_amdgcn_exp2f(s0[i]); lsum += s0[i]; } \
        pf[0] = pack8(s0, 0); pf[1] = pack8(s0, 1); \
        SB(); \
        if ((t) + 1 < NT) { n0 = negm; n1 = negm; \
            _Pragma("unroll") for (int ks = 0; ks < 4; ++ks) { n0 = MFMA32(kf[2 * ks], qf[ks], n0); n1 = MFMA32(kf[2 * ks + 1], qf[ks], n1); } } \
        _Pragma("unroll") for (int i = 0; i < 16; ++i) { s1[i] = __builtin_amdgcn_exp2f(s1[i]); lsum += s1[i]; } \
        pf[2] = pack8(s1, 0); pf[3] = pack8(s1, 1); \
        l += lsum; \
        const LAS unsigned char* vb_ = lds + (bcur) + voff; \
        _Pragma("unroll") for (int kk = 0; kk < 4; ++kk) \
        _Pragma("unroll") for (int db = 0; db < 4; ++db) { const LAS unsigned char* a = vb_ + db * BV_DB + kk * 1024; \
                const bf16x8 vf = cat8(vtr(a), vtr(a + 512)); o[db] = MFMA32(vf, pf[kk], o[db]); } \
        if (__any(lsum > 0x1p40f)) { float ls2 = lsum + xhalf(lsum); const float d = ls2 > 0x1p40f ? floorf(__builtin_amdgcn_logf(ls2)) : 0.f, f = __builtin_amdgcn_exp2f(-d); l *= f; \
            _Pragma("unroll") for (int i = 0; i < 16; ++i) { negm[i] -= d; n0[i] -= d; n1[i] -= d; } \
            _Pragma("unroll") for (int db = 0; db < 4; ++db) _Pragma("unroll") for (int i = 0; i < 16; ++i) o[db][i] *= f; } \
        B_WAITBAR(); } while (0)
    for (int t3 = 0; t3 < NT - 1; t3 += 3) {
        B_ITER(t3, 0, BBUF, 2 * BBUF);
        B_ITER(t3 + 1, BBUF, 2 * BBUF, 0);
        B_ITER(t3 + 2, 2 * BBUF, 0, BBUF);
    }
    B_ITER(NT - 1, 0, BBUF, 2 * BBUF);
#undef B_ITER
#undef B_QK
#undef B_DMA
    l += xhalf(l);
    const float rl = 1.0f / l;
    LAS float* ex = (LAS float*)lds + w * 4096 + lane;
    if (c == 1) {
#pragma unroll
        for (int db = 0; db < 4; ++db)
#pragma unroll
            for (int i = 0; i < 16; ++i) ex[(db * 16 + i) * 64] = o[db][i] * rl;
    }
    __syncthreads();
    if (c == 0) {
        float ss = 0.f;
#pragma unroll
        for (int db = 0; db < 4; ++db)
#pragma unroll
            for (int i = 0; i < 16; ++i) { const float v = o[db][i] * rl - lam * ex[(db * 16 + i) * 64]; o[db][i] = v; ss += v * v; }
        ss += xhalf(ss);
        const float rs = 0.8f / sqrtf(ss * (1.0f / 128.0f) + 1e-5f);
        bf16* op = OB + qrow * 1024 + 512 + hd * 128 + 8 * h;
#pragma unroll
        for (int db = 0; db < 4; ++db)
#pragma unroll
            for (int gp = 0; gp < 2; ++gp) {
                const f32x4 ga = *(const f32x4*)(subln_g + 32 * db + 16 * gp + 4 * h), gb = *(const f32x4*)(subln_g + 32 * db + 16 * gp + 8 + 4 * h);
                unsigned a0 = pk2(o[db][8 * gp] * rs * ga[0], o[db][8 * gp + 1] * rs * ga[1]), a1 = pk2(o[db][8 * gp + 2] * rs * ga[2], o[db][8 * gp + 3] * rs * ga[3]);
                unsigned b0 = pk2(o[db][8 * gp + 4] * rs * gb[0], o[db][8 * gp + 5] * rs * gb[1]), b1 = pk2(o[db][8 * gp + 6] * rs * gb[2], o[db][8 * gp + 7] * rs * gb[3]);
                const auto s0 = __builtin_amdgcn_permlane32_swap(a0, b0, false, false); const auto s1 = __builtin_amdgcn_permlane32_swap(a1, b1, false, false);
                u32x4 wv; wv.x = s0[0]; wv.y = s1[0]; wv.z = s0[1]; wv.w = s1[1];
                *(u32x4*)(op + 32 * db + 16 * gp) = wv; }
    }
    __syncthreads();
}

#define XB_TMO      128
#define XB_XCNT(j)  (256  + 64 * (j))
#define XB_XSUB(j)  (1280 + 64 * (j))
#define XB_XGEN(j)  (2304 + 64 * (j))
#define XB_TOP      3328
#define XB_TOPGEN   3392
#define XCD_BAR_WORDS 3456
#define XB_SPIN_CAP (1u << 18)

__device__ __forceinline__ unsigned xb_ld(unsigned* p)              { return __hip_atomic_load(p, __ATOMIC_RELAXED, __HIP_MEMORY_SCOPE_AGENT); }
__device__ __forceinline__ unsigned xb_add(unsigned* p, unsigned v) { return __hip_atomic_fetch_add(p, v, __ATOMIC_RELAXED, __HIP_MEMORY_SCOPE_AGENT); }
__device__ __forceinline__ unsigned xb_xcc_id() { return (unsigned)__builtin_amdgcn_s_getreg((3 << 11) | 20) & 0xFu; }
#define XB_SPIN(cond, bar) do { unsigned _sp = 0; while (cond) { __builtin_amdgcn_s_sleep(1); \
    if ((++_sp & 255u) == 0u) { if (xb_ld(&(bar)[XB_TMO])) break; if (_sp > XB_SPIN_CAP) { atomicAdd(&(bar)[XB_TMO], 1u); break; } } } } while (0)

struct XcdBarrier {
    unsigned* bar; unsigned x;
    volatile LAS unsigned* st;
};

__device__ __forceinline__ XcdBarrier xcd_barrier_post(unsigned* bar, volatile LAS unsigned* st) {
    XcdBarrier b; b.bar = bar; b.x = xb_xcc_id(); b.st = st;
    if (threadIdx.x == 0) (void)xb_add(&bar[XB_XCNT(b.x)], 1u);
    return b;
}
__device__ __forceinline__ void xcd_barrier_complete(unsigned* bar, unsigned x, unsigned& nloc, unsigned& nx) {
    const unsigned G = gridDim.x * gridDim.y * gridDim.z;
    unsigned sum, cnt, mine, sp = 0u;
    for (;;) {
        sum = 0u; cnt = 0u; mine = 0u;
#pragma unroll
        for (unsigned j = 0; j < 16; ++j) { const unsigned c = xb_ld(&bar[XB_XCNT(j)]); sum += c; cnt += (c > 0u) ? 1u : 0u; mine = (j == x) ? c : mine; }
        if (sum == G) break;
        __builtin_amdgcn_s_sleep(1);
        if ((++sp & 255u) == 0u) { if (xb_ld(&bar[XB_TMO])) break; if (sp > XB_SPIN_CAP) { atomicAdd(&bar[XB_TMO], 1u); break; } }
    }
    nloc = mine > 0u ? mine : 1u; nx = cnt > 0u ? cnt : 1u;
}

__device__ __forceinline__ void xcd_barrier(const XcdBarrier& b) {
    asm volatile("s_waitcnt vmcnt(0)" ::: "memory");
    __syncthreads();
    if (threadIdx.x == 0) {
        unsigned* bar = b.bar;
        __builtin_amdgcn_s_waitcnt(0);
        unsigned nloc = b.st[0], nx = b.st[1];
        if (nloc == 0u) { xcd_barrier_complete(bar, b.x, nloc, nx); b.st[0] = nloc; b.st[1] = nx; }
        const unsigned old = xb_add(&bar[XB_XSUB(b.x)], 1u);
        const unsigned gen = old / nloc;
        if (old + 1u == (gen + 1u) * nloc) {
            __builtin_amdgcn_fence(__ATOMIC_RELEASE, "agent");
            asm volatile("s_waitcnt vmcnt(0)" ::: "memory");
            const unsigned og = xb_add(&bar[XB_TOP], 1u);
            const unsigned tg = og / nx;
            if (og + 1u == (tg + 1u) * nx) xb_add(&bar[XB_TOPGEN], 1u);
            else XB_SPIN(xb_ld(&bar[XB_TOPGEN]) == tg, bar);
            __builtin_amdgcn_fence(__ATOMIC_ACQUIRE, "agent");
            xb_add(&bar[XB_XGEN(b.x)], 1u);
            asm volatile("s_waitcnt vmcnt(0)" ::: "memory");
        } else {
            XB_SPIN(xb_ld(&bar[XB_XGEN(b.x)]) == gen, bar);
            __builtin_amdgcn_fence(__ATOMIC_ACQUIRE, "agent");
            asm volatile("s_waitcnt vmcnt(0)" ::: "memory");
        }
    }
    __syncthreads();
}


__global__ void __launch_bounds__(512, 2) fwd_kernel(Args A) {
    extern __shared__ __attribute__((aligned(16))) unsigned char lds_raw[];
    LAS unsigned char* lds = (LAS unsigned char*)lds_raw;
    const int G = gridDim.x, bx = blockIdx.x, tid = threadIdx.x;
    const int vcu = (G % 8 == 0) ? (bx % 8) * (G / 8) + bx / 8 : bx;
    unsigned char* ws = A.ws;
    const int lo = A.ph_lo, hi = A.ph_hi;
    volatile LAS unsigned* MISC = (volatile LAS unsigned*)(lds + 151552);
    if (tid < 16) MISC[tid] = 0u;
    __syncthreads();
    if (lo == -12345) cg::this_grid().sync();
    XcdBarrier bar = xcd_barrier_post((unsigned*)(ws + WS_CTL), MISC + 8);
#define IN(k) (lo <= (k) && (k) < hi)
#define SEAM(k) do { if (IN(k) && IN((k) + 1)) xcd_barrier(bar); } while (0)
    if (IN(0)) p0_prologue(A, lds, vcu, G);
    SEAM(0);
    if (IN(1)) {
        pg8::Gemm g{(const bf16*)(ws + WS_XN), (const bf16*)(ws + WS_WIN), M, INW, 1024}; pg8::StaticOrder S; S.init(M, INW, G, bx, 4);
        EpiIn E{ws};
        pg8::gemm_phase<EpiIn, pg8::StaticOrder, true, true>(lds, g, S, E);
    }
    SEAM(1);
    if (IN(2)) attnA_phase(lds, ws, vcu, G);
    SEAM(2);
    if (IN(3)) {
        attnA_combine(ws, vcu, G);
        float d1 = 0.f, d2 = 0.f;
        for (int i = 0; i < 64; ++i) { d1 += A.lq1[i] * A.lk1[i]; d2 += A.lq2[i] * A.lk2[i]; }
        const float lam = expf(d1) - expf(d2) + 0.2f;
        if (tid >= 256) __builtin_amdgcn_s_setprio(1);
        for (int u = vcu; u < BATCH * 4 * 32; u += G) attnB_unit(lds, ws, u, lam, A.subln_g);
        __builtin_amdgcn_s_setprio(0);
    }
    SEAM(3);
    if (IN(4)) {
        pg8::Gemm g{(const bf16*)(ws + WS_ATTA), (const bf16*)(ws + WS_WA), M, 1024, 1024}; pg8::StaticOrder S; S.init(M, 1024, G, bx);
        EpiGate2 E{(const unsigned char*)(ws + WS_SGA), (const unsigned char*)(ws + WS_SGB), (bf16*)(ws + WS_MERGED)};
        pg8::gemm_phase<EpiGate2, pg8::StaticOrder, true, true>(lds, g, S, E);
    }
    SEAM(4);
    if (IN(5)) {
        pg8::Gemm g{(const bf16*)(ws + WS_MERGED), (const bf16*)(ws + WS_WOUT), M, 1024, 1024}; pg8::StaticOrder S; S.init(M, 1024, G, bx);
        EpiRes1 E{A.x, (bf16*)(ws + WS_X1B), (float*)(ws + WS_SSQ1)};
        pg8::gemm_phase<EpiRes1, pg8::StaticOrder, true, true>(lds, g, S, E);
    }
    SEAM(5);
    if (IN(6)) {
        pg8::Gemm g{(const bf16*)(ws + WS_X1B), (const bf16*)(ws + WS_W1), M, DFF, 1024}; pg8::StaticOrder S; S.init(M, DFF, G, bx);
        EpiFF1 E{(bf16*)(ws + WS_H)};
        pg8::gemm_phase<EpiFF1, pg8::StaticOrder, true, true>(lds, g, S, E);
    }
    SEAM(6);
    if (IN(7)) {
        pg8::Gemm g{(const bf16*)(ws + WS_H), (const bf16*)(ws + WS_W2), M, 1024, DFF}; pg8::StaticOrder S; S.init(M, 1024, G, bx);
        EpiFinal E{(const bf16*)(ws + WS_X1B), (const float*)(ws + WS_SSQ1), A.out, A.g_final, (float*)(ws + WS_SSQ2), (unsigned*)(ws + WS_CTL + 65536), lds + 131072};
        pg8::gemm_phase<EpiFinal, pg8::StaticOrder, true, true>(lds, g, S, E);
    }
#undef IN
#undef SEAM
}

#ifndef MK_PER_PHASE
#define MK_PER_PHASE 0
#endif
extern "C" void kernel_launch(void* const* d_in, const int* in_sizes, int n_in, void* d_out, int out_size, void* d_ws, size_t ws_size, hipStream_t stream) {
    static int grid = 0;
    if (grid == 0) {
        if (n_in != 15 || in_sizes[0] != M * DM || out_size != M * DM || ws_size < WS_END) { fprintf(stderr, "kernel_launch: unexpected shapes / workspace (%d inputs, ws %zu)\n", n_in, ws_size); grid = -1; return; }
        int dev = 0, cus = 0, per_cu = 0;
        (void)hipGetDevice(&dev); (void)hipDeviceGetAttribute(&cus, hipDeviceAttributeMultiprocessorCount, dev);
        (void)hipFuncSetAttribute((const void*)fwd_kernel, hipFuncAttributeMaxDynamicSharedMemorySize, LDS_BYTES);
        (void)hipOccupancyMaxActiveBlocksPerMultiprocessor(&per_cu, (const void*)fwd_kernel, 512, LDS_BYTES);
        if (per_cu < 1) per_cu = 1;
        grid = cus * per_cu;
        fprintf(stderr, "kernel_launch: %d CUs x %d = grid %d\n", cus, per_cu, grid);
    }
    if (grid < 0) return;
    (void)hipMemsetAsync((unsigned char*)d_ws + WS_CTL, 0, 131072, stream);
    Args a{};
    a.x = (const float*)d_in[0]; a.w_in = (const float*)d_in[1]; a.w_a = (const float*)d_in[2]; a.w_b = (const float*)d_in[3]; a.w_out = (const float*)d_in[4];
    a.lq1 = (const float*)d_in[5]; a.lk1 = (const float*)d_in[6]; a.lq2 = (const float*)d_in[7]; a.lk2 = (const float*)d_in[8]; a.subln_g = (const float*)d_in[9];
    a.g_mix = (const float*)d_in[10]; a.g_mlp = (const float*)d_in[11]; a.w_ff1 = (const float*)d_in[12]; a.w_ff2 = (const float*)d_in[13]; a.g_final = (const float*)d_in[14];
    a.out = (float*)d_out; a.ws = (unsigned char*)d_ws;
#if MK_PER_PHASE
    for (int ph = 0; ph < NPHASE - 1; ++ph) { a.ph_lo = ph; a.ph_hi = ph + 1; hipLaunchKernelGGL(fwd_kernel, dim3(grid), dim3(512), LDS_BYTES, stream, a); }
#else
    a.ph_lo = 0; a.ph_hi = NPHASE;
    void* args[] = {&a};
    hipError_t e = hipLaunchCooperativeKernel((const void*)fwd_kernel, dim3(grid), dim3(512), args, LDS_BYTES, stream);
    if (e != hipSuccess) fprintf(stderr, "cooperative launch failed: %s (grid %d)\n", hipGetErrorString(e), grid);
#endif
}
```

```cpp
#include <hip/hip_runtime.h>
#include <hip/hip_cooperative_groups.h>
#include <cstdio>
#include <cstdint>
namespace cg = cooperative_groups;
namespace pg8 {
#define PG8_LAS __attribute__((address_space(3)))
typedef unsigned short bf16_t;
typedef short bf16x8 __attribute__((ext_vector_type(8)));
typedef float f32x4 __attribute__((ext_vector_type(4)));
typedef unsigned u32x4 __attribute__((ext_vector_type(4)));
constexpr int BM = 256, BK = 64, HALF = 128, HTB = HALF * BK * 2  , STAGE_BYTES = 8 * HTB, NXCD = 8, WGM = 8;

__host__ __device__ __forceinline__ int lds_byte(int r, int c) { const int st = (r >> 4) * 2 + (c >> 5), rr = r & 15, cc = c & 31, ob = rr * 64 + cc * 2; return st * 1024 + (ob ^ (((ob >> 9) & 1) << 5)); }
__host__ __device__ __forceinline__ void stage_rc(int b, int& R, int& C) { const int st = b / 1024, sb = b % 1024, swz = sb ^ (((sb >> 9) & 1) << 5); R = (st >> 1) * 16 + swz / 64; C = (st & 1) * 32 + (swz % 64) / 2; }
__host__ __device__ __forceinline__ int perm32(int rho) { const int n = rho >> 4, i = rho & 15; return 8 * (i >> 2) + 4 * n + (i & 3); }

struct Unit { int pm, pn; };
struct Gemm { const bf16_t* A; const bf16_t* Bt; int M, N, K; };

struct StaticOrder {
    int nM, nN, nwg, G, c, wgm;
    __host__ __device__ void init(int M, int N, int G_, int c_, int wgm_ = WGM) { nM = M / BM; nN = N / BM; nwg = nM * nN; G = G_; c = c_; wgm = wgm_; }
    __host__ __device__ bool next(int i, Unit& u) const {
        const long L = (long)i * G + c; if (L >= nwg) return false;
        int wgid = (int)L; { const int q = nwg / NXCD, r = nwg % NXCD, xcd = wgid % NXCD, off = wgid / NXCD; wgid = (xcd < r ? xcd * (q + 1) : r * (q + 1) + (xcd - r) * q) + off; }
        const int nig = wgm * nN, gid = wgid / nig, fm = gid * wgm, gsz = (nM - fm) < wgm ? (nM - fm) : wgm;
        u.pm = fm + ((wgid % nig) % gsz); u.pn = (wgid % nig) / gsz; return true;
    }
    __device__ __forceinline__ void a_ready(const Unit&) const {}
    __device__ __forceinline__ void done(const Unit&) const {}
};

__device__ __forceinline__ unsigned cvt_pk_bf16(float lo, float hi) { unsigned r; asm volatile("v_cvt_pk_bf16_f32 %0, %1, %2" : "=v"(r) : "v"(lo), "v"(hi)); return r; }
template <class Epi, class Sched, bool ALIGN_EPI = false, bool SP2 = false>
__device__ __forceinline__ void gemm_phase(PG8_LAS unsigned char* lds, const Gemm g, const Sched& S, const Epi& E) {
    const int tid = threadIdx.x, wid = __builtin_amdgcn_readfirstlane(tid >> 6), lane = tid & 63, wr = wid >> 2, wc = wid & 3, fr = lane & 15, fq = lane >> 4;
    const int K = g.K, nt = K / BK;
    unsigned voffA[2], voffB[2];
#pragma unroll
    for (int i = 0; i < 2; ++i) { int R, C; stage_rc(tid * 16 + i * 8192, R, C); const int Rb = Epi::PERM ? ((R & ~31) + perm32(R & 31)) : R;
        voffA[i] = (unsigned)(R * K + C) * 2u; voffB[i] = (unsigned)(Rb * K + C) * 2u; }
    const size_t kstep = (size_t)(BK * 2);
    const size_t hstep = (size_t)HALF * K * 2;
    const size_t tstep = 2 * hstep;
    const unsigned ldsw = (unsigned)wid * 1024u;
    const int aoff = lds_byte(wr * 64 + fr, fq * 8), boff = lds_byte(wc * 32 + fr, fq * 8);
#define PG8_SA(b, h) (((b) * 2 + (h)) * HTB)
#define PG8_SB(b, h) ((4 + (b) * 2 + (h)) * HTB)
#define PG8_STAGE(bufoff, gbase, voff) do { _Pragma("unroll") for (int _i = 0; _i < 2; ++_i) \
        __builtin_amdgcn_global_load_lds((const unsigned*)((const char*)(gbase) + (voff)[_i]), (PG8_LAS unsigned*)(lds + (bufoff) + ldsw + _i * 8192), 16, 0, 0); } while (0)
#define PG8_LDA(dst, b, h) do { _Pragma("unroll") for (int m = 0; m < 4; ++m) _Pragma("unroll") for (int k = 0; k < 2; ++k) dst[m][k] = *(const PG8_LAS bf16x8*)(lds + PG8_SA(b, h) + aoff + m * 2048 + k * 1024); } while (0)
#define PG8_LDB(dst, b, h) do { _Pragma("unroll") for (int n = 0; n < 2; ++n) _Pragma("unroll") for (int k = 0; k < 2; ++k) dst[n][k] = *(const PG8_LAS bf16x8*)(lds + PG8_SB(b, h) + boff + n * 2048 + k * 1024); } while (0)
#define PG8_MMA(ai, bj, At, Bt) do { __builtin_amdgcn_s_setprio(1); _Pragma("unroll") for (int m = 0; m < 4; ++m) _Pragma("unroll") for (int n = 0; n < 2; ++n) _Pragma("unroll") for (int k = 0; k < 2; ++k) \
        acc[ai][bj][m][n] = __builtin_amdgcn_mfma_f32_16x16x32_bf16(Bt[n][k], At[m][k], acc[ai][bj][m][n], 0, 0, 0); __builtin_amdgcn_s_setprio(0); } while (0)
#define PG8_WAIT_V(n) asm volatile("s_waitcnt vmcnt(" #n ")" ::: "memory")
#define PG8_WAIT_L(n) asm volatile("s_waitcnt lgkmcnt(" #n ")" ::: "memory")
#define PG8_BAR __builtin_amdgcn_s_barrier()
#define PG8_SCHED __builtin_amdgcn_sched_barrier(0)
    Unit cur, nxt; int ui = 0;
    if (!S.next(0, cur)) return;
    f32x4 acc[2][2][4][2];
#pragma unroll
    for (int a = 0; a < 2; ++a)
#pragma unroll
        for (int b = 0; b < 2; ++b)
#pragma unroll
            for (int m = 0; m < 4; ++m)
#pragma unroll
                for (int n = 0; n < 2; ++n) acc[a][b][m][n] = (f32x4){0.f, 0.f, 0.f, 0.f};
    bf16x8 At[4][2], B0[2][2], B1[2][2];
    const char* cA = (const char*)g.A + (size_t)cur.pm * tstep; const char* cB = (const char*)g.Bt + (size_t)cur.pn * tstep;
    S.a_ready(cur);
    if constexpr (SP2) {
        PG8_STAGE(PG8_SB(0, 0), cB, voffB); PG8_STAGE(PG8_SB(0, 1), cB + hstep, voffB); PG8_STAGE(PG8_SA(0, 0), cA, voffA); PG8_STAGE(PG8_SA(0, 1), cA + hstep, voffA);
        if (wr == 1) PG8_BAR;
        PG8_WAIT_V(2); PG8_BAR;
        PG8_STAGE(PG8_SB(1, 0), cB + kstep, voffB); PG8_STAGE(PG8_SA(1, 0), cA + kstep, voffA); PG8_STAGE(PG8_SB(1, 1), cB + hstep + kstep, voffB);
        PG8_WAIT_V(6); PG8_BAR;
    } else {
        PG8_STAGE(PG8_SB(0, 0), cB, voffB); PG8_STAGE(PG8_SA(0, 0), cA, voffA); PG8_STAGE(PG8_SB(0, 1), cB + hstep, voffB); PG8_STAGE(PG8_SA(0, 1), cA + hstep, voffA);
        if (wr == 1) PG8_BAR;
        PG8_WAIT_V(4); PG8_BAR;
        PG8_STAGE(PG8_SB(1, 0), cB + kstep, voffB); PG8_STAGE(PG8_SA(1, 0), cA + kstep, voffA); PG8_STAGE(PG8_SB(1, 1), cB + hstep + kstep, voffB);
        PG8_WAIT_V(6); PG8_BAR;
    }
    for (;;) {
        const bool has_next = S.next(ui + 1, nxt);
        const char* nA = has_next ? (const char*)g.A + (size_t)nxt.pm * tstep : cA; const char* nB = has_next ? (const char*)g.Bt + (size_t)nxt.pn * tstep : cB;
        for (int t = 0; t < nt; t += 2) {
            if constexpr (Epi::MIDK) { if (t == (nt >> 1)) E.mid(acc, cur, wr, wc, fr, fq); }
            const bool last = (t == nt - 2);
            const char* a1 = cA + (size_t)(t + 1) * kstep;
            const char* a2 = last ? nA : cA + (size_t)(t + 2) * kstep; const char* b2 = last ? nB : cB + (size_t)(t + 2) * kstep;
            const char* a3 = a2 + kstep; const char* b3 = b2 + kstep;
            if (last && has_next) S.a_ready(nxt);
            if constexpr (SP2) {
            PG8_LDB(B0, 0, 0); PG8_LDB(B1, 0, 1); PG8_SCHED; PG8_LDA(At, 0, 0); PG8_STAGE(PG8_SA(1, 1), a1 + hstep, voffA);
            PG8_WAIT_V(8); PG8_WAIT_L(0); PG8_BAR; PG8_MMA(0, 0, At, B0); PG8_MMA(0, 1, At, B1); PG8_BAR; PG8_SCHED;
            PG8_LDA(At, 0, 1); PG8_STAGE(PG8_SB(0, 0), b2, voffB); PG8_STAGE(PG8_SB(0, 1), b2 + hstep, voffB); PG8_STAGE(PG8_SA(0, 0), a2, voffA);
            PG8_WAIT_V(8); PG8_WAIT_L(0); PG8_BAR; PG8_MMA(1, 0, At, B0); PG8_MMA(1, 1, At, B1); PG8_BAR; PG8_SCHED;
            PG8_LDB(B0, 1, 0); PG8_LDB(B1, 1, 1); PG8_SCHED; PG8_LDA(At, 1, 0); PG8_STAGE(PG8_SA(0, 1), a2 + hstep, voffA);
            PG8_WAIT_V(8); PG8_WAIT_L(0); PG8_BAR; PG8_MMA(0, 0, At, B0); PG8_MMA(0, 1, At, B1); PG8_BAR; PG8_SCHED;
            PG8_LDA(At, 1, 1); PG8_STAGE(PG8_SB(1, 0), b3, voffB); PG8_STAGE(PG8_SB(1, 1), b3 + hstep, voffB); PG8_STAGE(PG8_SA(1, 0), a3, voffA);
            PG8_WAIT_V(8); PG8_WAIT_L(0); PG8_BAR; PG8_MMA(1, 0, At, B0); PG8_MMA(1, 1, At, B1); PG8_BAR; PG8_SCHED;
            } else {
            PG8_LDB(B0, 0, 0); PG8_SCHED; PG8_LDA(At, 0, 0); PG8_STAGE(PG8_SA(1, 1), a1 + hstep, voffA);
            PG8_WAIT_L(8); PG8_BAR; PG8_WAIT_L(0); PG8_MMA(0, 0, At, B0); PG8_BAR; PG8_SCHED;
            PG8_LDB(B1, 0, 1); PG8_STAGE(PG8_SB(0, 0), b2, voffB);
            PG8_BAR; PG8_WAIT_L(0); PG8_MMA(0, 1, At, B1); PG8_BAR;
            PG8_LDA(At, 0, 1); PG8_STAGE(PG8_SA(0, 0), a2, voffA);
            PG8_BAR; PG8_WAIT_L(0); PG8_MMA(1, 0, At, B0); PG8_BAR; PG8_SCHED;
            PG8_STAGE(PG8_SB(0, 1), b2 + hstep, voffB);
            PG8_WAIT_V(6); PG8_BAR; PG8_MMA(1, 1, At, B1); PG8_BAR;
            PG8_LDB(B0, 1, 0); PG8_SCHED; PG8_LDA(At, 1, 0); PG8_STAGE(PG8_SA(0, 1), a2 + hstep, voffA);
            PG8_WAIT_L(8); PG8_BAR; PG8_WAIT_L(0); PG8_MMA(0, 0, At, B0); PG8_BAR; PG8_SCHED;
            PG8_LDB(B1, 1, 1); PG8_STAGE(PG8_SB(1, 0), b3, voffB);
            PG8_BAR; PG8_WAIT_L(0); PG8_MMA(0, 1, At, B1); PG8_BAR;
            PG8_LDA(At, 1, 1); PG8_STAGE(PG8_SA(1, 0), a3, voffA);
            PG8_BAR; PG8_WAIT_L(0); PG8_MMA(1, 0, At, B0); PG8_BAR; PG8_SCHED;
            PG8_STAGE(PG8_SB(1, 1), b3 + hstep, voffB);
            PG8_WAIT_V(6); PG8_BAR; PG8_MMA(1, 1, At, B1); PG8_BAR;
            }
        }
        if constexpr (ALIGN_EPI) { if (wr == 0) PG8_BAR; }
        if constexpr (!Epi::AFTER_DRAIN) { E(acc, cur, wr, wc, fr, fq); S.done(cur); }
        if (!has_next) break;
#pragma unroll
        for (int a = 0; a < 2; ++a)
#pragma unroll
            for (int b = 0; b < 2; ++b)
#pragma unroll
                for (int m = 0; m < 4; ++m)
#pragma unroll
                    for (int n = 0; n < 2; ++n) acc[a][b][m][n] = (f32x4){0.f, 0.f, 0.f, 0.f};
        cur = nxt; cA = nA; cB = nB; ++ui;
        if constexpr (ALIGN_EPI) { if (wr == 1) PG8_BAR; }
    }
    PG8_WAIT_V(0);
    if constexpr (!ALIGN_EPI) { if (wr == 0) PG8_BAR; }
    PG8_BAR;
    if constexpr (Epi::AFTER_DRAIN) { E.fused(acc, cur, wr, wc, fr, fq, lds, wid, lane); S.done(cur); }
#undef PG8_SA
#undef PG8_SB
#undef PG8_STAGE
#undef PG8_LDA
#undef PG8_LDB
#undef PG8_MMA
#undef PG8_WAIT_V
#undef PG8_WAIT_L
#undef PG8_BAR
#undef PG8_SCHED
}
}

#define LAS __attribute__((address_space(3)))
typedef unsigned short bf16;
typedef short bf16x8 __attribute__((ext_vector_type(8)));
typedef short s16x4 __attribute__((ext_vector_type(4)));
typedef float f32x4 __attribute__((ext_vector_type(4)));
typedef float f32x2 __attribute__((ext_vector_type(2)));
typedef float f32x16 __attribute__((ext_vector_type(16)));
typedef unsigned u32x4 __attribute__((ext_vector_type(4)));
typedef unsigned u32x2 __attribute__((ext_vector_type(2)));

constexpr int BATCH = 16, SEQ = 4096, DM = 1024, M = BATCH * SEQ, INW = 5120, DFF = 4096;
constexpr float QSCALE = 0.125f * 1.4426950408889634f;
constexpr size_t MiB = 1u << 20;
constexpr size_t WS_XN = 0, WS_QA = 128 * MiB, WS_KA = 192 * MiB, WS_VA = 256 * MiB, WS_QB = 320 * MiB, WS_KB = 384 * MiB, WS_VB = 448 * MiB;
constexpr size_t WS_SGA = 512 * MiB, WS_SGB = 640 * MiB, WS_AO2 = 768 * MiB, WS_ATTA = 832 * MiB, WS_ATTB = 896 * MiB;
constexpr size_t WS_WIN = 960 * MiB, WS_WA = 970 * MiB, WS_WB = 971 * MiB, WS_WOUT = 972 * MiB, WS_W1 = 974 * MiB, WS_W2 = 982 * MiB;
constexpr size_t WS_LSE = 990 * MiB, WS_SSQ1 = 996 * MiB, WS_SSQ2 = 1000 * MiB, WS_ROPE = 1004 * MiB, WS_CTL = 1005 * MiB, WS_END = 1006 * MiB;
constexpr size_t WS_AO0 = 0, WS_AO1 = 64 * MiB, WS_MERGED = 0, WS_X1B = WS_SGA, WS_H = 0;
constexpr int LDS_BYTES = 152576;
constexpr int NPHASE = 10;

#define MFMA32(a, b, c) __builtin_amdgcn_mfma_f32_32x32x16_bf16((a), (b), (c), 0, 0, 0)
__device__ __forceinline__ int crow(int r, int hi) { return (r & 3) + 8 * (r >> 2) + 4 * hi; }
typedef __bf16 bf16x2_t __attribute__((ext_vector_type(2)));
__device__ __forceinline__ unsigned pk2(float lo, float hi) { f32x2 v = {lo, hi}; bf16x2_t b = __builtin_convertvector(v, bf16x2_t); return __builtin_bit_cast(unsigned, b); }
__device__ __forceinline__ float bflo(unsigned w) { return __uint_as_float(w << 16); }
__device__ __forceinline__ float bfhi(unsigned w) { return __uint_as_float(w & 0xffff0000u); }
__device__ __forceinline__ float wave_sum(float v) {
#pragma unroll
    for (int o = 1; o < 64; o <<= 1) v += __shfl_xor(v, o);
    return v;
}
__device__ __forceinline__ s16x4 vtr(const LAS unsigned char* p) {
    typedef short v4i16_t __attribute__((ext_vector_type(4)));
    return __builtin_bit_cast(s16x4, __builtin_amdgcn_ds_read_tr16_b64_v4i16((LAS v4i16_t*)p));
}
__device__ __forceinline__ bf16x8 cat8(s16x4 lo, s16x4 hi) { return (bf16x8){lo[0], lo[1], lo[2], lo[3], hi[0], hi[1], hi[2], hi[3]}; }
__device__ __forceinline__ bf16x8 pack8(const f32x16& x, int s) {
    u32x4 p; p.x = pk2(x[8 * s], x[8 * s + 1]); p.y = pk2(x[8 * s + 2], x[8 * s + 3]); p.z = pk2(x[8 * s + 4], x[8 * s + 5]); p.w = pk2(x[8 * s + 6], x[8 * s + 7]);
    return __builtin_bit_cast(bf16x8, p);
}
__device__ __forceinline__ float xhalf(float v) { return __shfl_xor(v, 32); }

struct Args {
    const float* x; const float* w_in; const float* w_a; const float* w_b; const float* w_out;
    const float* lq1; const float* lk1; const float* lq2; const float* lk2; const float* subln_g;
    const float* g_mix; const float* g_mlp; const float* w_ff1; const float* w_ff2; const float* g_final;
    float* out; unsigned char* ws; int ph_lo, ph_hi;
};

__device__ __forceinline__ void p0_transpose_item(const float* W, int K, int N, bf16* WT, const float* g, bool perm, LAS float* scr, int item, int lane, int pitch = 0) {
    if (pitch == 0) pitch = K;
    const int nblk = N / 32, kb = item / nblk, nb = item % nblk, k0 = 64 * kb, n0 = 32 * nb, l = lane & 31;
    int sc = n0 + l;
    if (perm) sc = (n0 & ~255) + 64 * ((n0 >> 5) & 3) + 32 * ((n0 >> 7) & 1) + l;
#pragma unroll 8
    for (int i = 0; i < 32; ++i) { const int kk = 2 * i + (lane >> 5); float v = W[(size_t)(k0 + kk) * N + sc]; if (g) v *= g[k0 + kk]; scr[kk * 33 + l] = v; }
    asm volatile("s_waitcnt lgkmcnt(0)" ::: "memory");
    const int c = lane & 7;
#pragma unroll
    for (int j = 0; j < 4; ++j) { const int n = (lane >> 3) + 8 * j; const LAS float* s = scr + (8 * c) * 33 + n;
        u32x4 o; o.x = pk2(s[0 * 33], s[1 * 33]); o.y = pk2(s[2 * 33], s[3 * 33]); o.z = pk2(s[4 * 33], s[5 * 33]); o.w = pk2(s[6 * 33], s[7 * 33]);
        *(u32x4*)(WT + (size_t)(n0 + n) * pitch + k0 + 8 * c) = o; }
    asm volatile("s_waitcnt lgkmcnt(0)" ::: "memory");
}
__device__ __forceinline__ void p0_prologue(const Args& A, LAS unsigned char* lds, int vcu, int G) {
    const int tid = threadIdx.x, lane = tid & 63, wave = tid >> 6;
    unsigned char* ws = A.ws;
    LAS float* scr = (LAS float*)(lds + wave * 8704);
    const int gw = vcu * 8 + wave, NGW = G * 8;
    constexpr int I_IN = 16 * 160, I_A = 8 * 32, I_B = 8 * 32, I_O = 16 * 32, I_1 = 16 * 128, I_2 = 64 * 32, NITEMS = I_IN + I_A + I_B + I_O + I_1 + I_2;
    for (int it = gw; it < NITEMS; it += NGW) {
        int r = it;
        if (r < I_IN) { const int n0 = 32 * (r % 160); const bool perm = (n0 < 1024) || (n0 >= 1536 && n0 < 2560);
            p0_transpose_item(A.w_in, 1024, INW, (bf16*)(ws + WS_WIN), nullptr, perm, scr, r, lane); continue; } r -= I_IN;
        if (r < I_A) { p0_transpose_item(A.w_a, 512, 1024, (bf16*)(ws + WS_WA), nullptr, false, scr, r, lane, 1024); continue; } r -= I_A;
        if (r < I_B) { p0_transpose_item(A.w_b, 512, 1024, (bf16*)(ws + WS_WA) + 512, nullptr, false, scr, r, lane, 1024); continue; } r -= I_B;
        if (r < I_O) { p0_transpose_item(A.w_out, 1024, 1024, (bf16*)(ws + WS_WOUT), nullptr, false, scr, r, lane); continue; } r -= I_O;
        if (r < I_1) { p0_transpose_item(A.w_ff1, 1024, DFF, (bf16*)(ws + WS_W1), A.g_mlp, false, scr, r, lane); continue; } r -= I_1;
        p0_transpose_item(A.w_ff2, DFF, 1024, (bf16*)(ws + WS_W2), nullptr, false, scr, r, lane);
    }
    for (int idx = (vcu * 512 + tid); idx < SEQ * 32; idx += G * 512) {
        const int pos = idx >> 5, i = idx & 31;
        const float inv = powf(10000.0f, -(float)(2 * i) / 64.0f);
        const float ang = (float)pos * inv;
        const double a = (double)ang;
        const double kq = rint(a * 0.63661977236758134308);
        const double r = fma(-kq, 1.57079632679489661923, a);
        const double r2 = r * r;
        double sp = 1.0 / 6227020800.0; sp = sp * r2 - 1.0 / 39916800.0; sp = sp * r2 + 1.0 / 362880.0; sp = sp * r2 - 1.0 / 5040.0; sp = sp * r2 + 1.0 / 120.0; sp = sp * r2 - 1.0 / 6.0; sp = sp * r2 + 1.0; sp *= r;
        double cp = 1.0 / 479001600.0; cp = cp * r2 - 1.0 / 3628800.0; cp = cp * r2 + 1.0 / 40320.0; cp = cp * r2 - 1.0 / 720.0; cp = cp * r2 + 1.0 / 24.0; cp = cp * r2 - 0.5; cp = cp * r2 + 1.0;
        const int q = ((int)kq) & 3;
        const double sv = (q == 0) ? sp : (q == 1) ? cp : (q == 2) ? -sp : -cp;
        const double cv = (q == 0) ? cp : (q == 1) ? -sp : (q == 2) ? -cp : sp;
        ((f32x2*)(ws + WS_ROPE))[idx] = (f32x2){(float)cv, (float)sv};
    }
    bf16* XN = (bf16*)(ws + WS_XN);
    f32x4 gv[4];
#pragma unroll
    for (int j = 0; j < 4; ++j) gv[j] = ((const f32x4*)A.g_mix)[lane + 64 * j];
    for (int m = gw; m < M; m += NGW) {
        const f32x4* xr = (const f32x4*)(A.x + (size_t)m * DM) + lane;
        f32x4 v[4]; float s = 0.f;
#pragma unroll
        for (int j = 0; j < 4; ++j) { v[j] = __builtin_nontemporal_load(xr + 64 * j); s += (v[j].x * v[j].x + v[j].y * v[j].y) + (v[j].z * v[j].z + v[j].w * v[j].w); }
        const float rstd = 1.0f / sqrtf(wave_sum(s) * (1.0f / DM) + 1e-6f);
        u32x2* o8 = (u32x2*)(XN + (size_t)m * DM) + lane;
#pragma unroll
        for (int j = 0; j < 4; ++j) { u32x2 w; w.x = pk2(v[j].x * rstd * gv[j].x, v[j].y * rstd * gv[j].y); w.y = pk2(v[j].z * rstd * gv[j].z, v[j].w * rstd * gv[j].w); o8[64 * j] = w; }
    }
}

struct EpiIn {
    static constexpr bool PERM = true, AFTER_DRAIN = false, MIDK = false;
    unsigned char* ws;
    __device__ __forceinline__ void operator()(const f32x4 (&acc)[2][2][4][2], const pg8::Unit& u, int wr, int wc, int fr, int fq) const {
        const int pn = u.pn, row0 = u.pm * 256 + wr * 64 + fr;
        if (pn >= 12) {
            unsigned char* dst = (unsigned char*)(ws + (pn >= 16 ? WS_SGB : WS_SGA)); const int colt = ((pn - 12) & 3) * 256 + wc * 32 + 8 * fq;
#pragma unroll
            for (int ai = 0; ai < 2; ++ai)
#pragma unroll
                for (int m = 0; m < 4; ++m) { unsigned char* rp = dst + (size_t)(row0 + ai * 128 + m * 16) * 1024 + colt;
#pragma unroll
                    for (int bj = 0; bj < 2; ++bj) { float sg[8];
#pragma unroll
                        for (int j = 0; j < 8; ++j) sg[j] = fmaxf(255.0f * __builtin_amdgcn_rcpf(1.0f + __builtin_amdgcn_exp2f(-1.4426950408889634f * acc[ai][bj][m][j >> 2][j & 3])), 1.0f);
                        u32x2 w; w.x = 0u; w.y = 0u;
                        w.x = __builtin_amdgcn_cvt_pk_u8_f32(sg[0], 0, w.x); w.x = __builtin_amdgcn_cvt_pk_u8_f32(sg[1], 1, w.x); w.x = __builtin_amdgcn_cvt_pk_u8_f32(sg[2], 2, w.x); w.x = __builtin_amdgcn_cvt_pk_u8_f32(sg[3], 3, w.x);
                        w.y = __builtin_amdgcn_cvt_pk_u8_f32(sg[4], 0, w.y); w.y = __builtin_amdgcn_cvt_pk_u8_f32(sg[5], 1, w.y); w.y = __builtin_amdgcn_cvt_pk_u8_f32(sg[6], 2, w.y); w.y = __builtin_amdgcn_cvt_pk_u8_f32(sg[7], 3, w.y);
                        *(u32x2*)(rp + bj * 128) = w; } }
        } else {
            const int reg = pn >> 1;
            bf16* dst = (bf16*)(ws + WS_QA + (size_t)reg * 64 * MiB);
            if (reg == 2 || reg == 5) {
                const int colt = (pn & 1) * 256 + wc * 32 + 8 * fq;
#pragma unroll
                for (int ai = 0; ai < 2; ++ai)
#pragma unroll
                    for (int m = 0; m < 4; ++m) { bf16* rp = dst + (size_t)(row0 + ai * 128 + m * 16) * 512 + colt;
#pragma unroll
                        for (int bj = 0; bj < 2; ++bj) { const f32x4 v0 = acc[ai][bj][m][0], v1 = acc[ai][bj][m][1];
                            u32x4 w; w.x = pk2(v0[0], v0[1]); w.y = pk2(v0[2], v0[3]); w.z = pk2(v1[0], v1[1]); w.w = pk2(v1[2], v1[3]); *(u32x4*)(rp + bj * 128) = w; } }
            } else {
                const float sc = (reg == 0 || reg == 3) ? QSCALE : 1.0f;
                const f32x4* rope = (const f32x4*)(ws + WS_ROPE);
                const int head = 4 * (pn & 1) + wc;
#pragma unroll
                for (int ai = 0; ai < 2; ++ai)
#pragma unroll
                    for (int m = 0; m < 4; ++m) { const int row = row0 + ai * 128 + m * 16, pos = row & (SEQ - 1);
                        const f32x4* tp = rope + ((pos * 32 + 8 * fq) >> 1);
                        const f32x4 t0 = tp[0], t1 = tp[1], t2 = tp[2], t3 = tp[3];
                        const float cs[8] = {t0[0], t0[2], t1[0], t1[2], t2[0], t2[2], t3[0], t3[2]}, sn[8] = {t0[1], t0[3], t1[1], t1[3], t2[1], t2[3], t3[1], t3[3]};
                        float o1[8], o2[8];
#pragma unroll
                        for (int j = 0; j < 8; ++j) { const float x1 = acc[ai][0][m][j >> 2][j & 3], x2 = acc[ai][1][m][j >> 2][j & 3];
                            o1[j] = (x1 * cs[j] - x2 * sn[j]) * sc; o2[j] = (x2 * cs[j] + x1 * sn[j]) * sc; }
                        bf16* rp = dst + (size_t)row * 512 + head * 64 + 8 * fq;
                        u32x4 w1, w2; w1.x = pk2(o1[0], o1[1]); w1.y = pk2(o1[2], o1[3]); w1.z = pk2(o1[4], o1[5]); w1.w = pk2(o1[6], o1[7]);
                        w2.x = pk2(o2[0], o2[1]); w2.y = pk2(o2[2], o2[3]); w2.z = pk2(o2[4], o2[5]); w2.w = pk2(o2[6], o2[7]);
                        *(u32x4*)rp = w1; *(u32x4*)(rp + 32) = w2; }
            }
        }
    }
};
__device__ __forceinline__ void unpack8(const u32x4 g, float (&f)[8]) { f[0] = bflo(g.x); f[1] = bfhi(g.x); f[2] = bflo(g.y); f[3] = bfhi(g.y); f[4] = bflo(g.z); f[5] = bfhi(g.z); f[6] = bflo(g.w); f[7] = bfhi(g.w); }
template <int PASS> struct EpiGate {
    static constexpr bool PERM = true, AFTER_DRAIN = false, MIDK = false;
    const bf16* SG; bf16* MG;
    __device__ __forceinline__ void operator()(const f32x4 (&acc)[2][2][4][2], const pg8::Unit& u, int wr, int wc, int fr, int fq) const {
        const int row0 = u.pm * 256 + wr * 64 + fr, col0 = u.pn * 256 + wc * 32 + 8 * fq;
#pragma unroll
        for (int ai = 0; ai < 2; ++ai)
#pragma unroll
            for (int m = 0; m < 4; ++m) { const size_t off = (size_t)(row0 + ai * 128 + m * 16) * 1024 + col0;
#pragma unroll
                for (int bj = 0; bj < 2; ++bj) { const size_t o = off + bj * 128; const f32x4 v0 = acc[ai][bj][m][0], v1 = acc[ai][bj][m][1];
                    float g[8]; unpack8(*(const u32x4*)(SG + o), g);
                    float r[8] = {v0[0] * g[0], v0[1] * g[1], v0[2] * g[2], v0[3] * g[3], v1[0] * g[4], v1[1] * g[5], v1[2] * g[6], v1[3] * g[7]};
                    if (PASS == 1) { float p[8]; unpack8(*(const u32x4*)(MG + o), p);
#pragma unroll
                        for (int j = 0; j < 8; ++j) r[j] += p[j]; }
                    u32x4 w; w.x = pk2(r[0], r[1]); w.y = pk2(r[2], r[3]); w.z = pk2(r[4], r[5]); w.w = pk2(r[6], r[7]); *(u32x4*)(MG + o) = w; } }
    }
};
__device__ __forceinline__ void unpack8u(const u32x2 g, float (&f)[8]) {
    f[0] = (float)(g.x & 0xffu); f[1] = (float)((g.x >> 8) & 0xffu); f[2] = (float)((g.x >> 16) & 0xffu); f[3] = (float)(g.x >> 24);
    f[4] = (float)(g.y & 0xffu); f[5] = (float)((g.y >> 8) & 0xffu); f[6] = (float)((g.y >> 16) & 0xffu); f[7] = (float)(g.y >> 24);
}
struct EpiGate2 {
    static constexpr bool PERM = true, AFTER_DRAIN = false, MIDK = true;
    const unsigned char* SGA_; const unsigned char* SGB_; bf16* MG;
    __device__ __forceinline__ void mid(f32x4 (&acc)[2][2][4][2], const pg8::Unit& u, int wr, int wc, int fr, int fq) const {
        int row0 = u.pm * 256 + wr * 64 + fr, col0 = u.pn * 256 + wc * 32 + 8 * fq;
        asm volatile("" : "+v"(row0), "+v"(col0));
#pragma unroll
        for (int ai = 0; ai < 2; ++ai)
#pragma unroll
            for (int m = 0; m < 4; ++m) { const size_t off = (size_t)(row0 + ai * 128 + m * 16) * 1024 + col0;
#pragma unroll
                for (int bj = 0; bj < 2; ++bj) { const size_t o = off + bj * 128; float ga[8], gb[8]; unpack8u(*(const u32x2*)(SGA_ + o), ga); unpack8u(*(const u32x2*)(SGB_ + o), gb);
#pragma unroll
                    for (int j = 0; j < 8; ++j) acc[ai][bj][m][j >> 2][j & 3] *= ga[j] * __builtin_amdgcn_rcpf(gb[j]);
                    asm volatile("" ::: "memory"); } }
    }
    __device__ __forceinline__ void operator()(const f32x4 (&acc)[2][2][4][2], const pg8::Unit& u, int wr, int wc, int fr, int fq) const {
        const int row0 = u.pm * 256 + wr * 64 + fr, col0 = u.pn * 256 + wc * 32 + 8 * fq;
#pragma unroll
        for (int ai = 0; ai < 2; ++ai)
#pragma unroll
            for (int m = 0; m < 4; ++m) { const size_t off = (size_t)(row0 + ai * 128 + m * 16) * 1024 + col0;
#pragma unroll
                for (int bj = 0; bj < 2; ++bj) { const size_t o = off + bj * 128; const f32x4 v0 = acc[ai][bj][m][0] * (1.0f / 255.0f), v1 = acc[ai][bj][m][1] * (1.0f / 255.0f);
                    float g[8]; unpack8u(*(const u32x2*)(SGB_ + o), g);
                    u32x4 w; w.x = pk2(v0[0] * g[0], v0[1] * g[1]); w.y = pk2(v0[2] * g[2], v0[3] * g[3]); w.z = pk2(v1[0] * g[4], v1[1] * g[5]); w.w = pk2(v1[2] * g[6], v1[3] * g[7]); *(u32x4*)(MG + o) = w; } }
    }
};
struct EpiRes1 {
    static constexpr bool PERM = true, AFTER_DRAIN = false, MIDK = false;
    const float* xi; bf16* xb; float* ssq;
    __device__ __forceinline__ void operator()(const f32x4 (&acc)[2][2][4][2], const pg8::Unit& u, int wr, int wc, int fr, int fq) const {
        const int row0 = u.pm * 256 + wr * 64 + fr, col0 = u.pn * 256 + wc * 32 + 8 * fq;
#pragma unroll
        for (int ai = 0; ai < 2; ++ai)
#pragma unroll
            for (int m = 0; m < 4; ++m) { const int row = row0 + ai * 128 + m * 16; const size_t off = (size_t)row * 1024 + col0; float ss = 0.f;
#pragma unroll
                for (int bj = 0; bj < 2; ++bj) { const size_t o = off + bj * 128;
                    const f32x4 v0 = *(const f32x4*)(xi + o) + acc[ai][bj][m][0], v1 = *(const f32x4*)(xi + o + 4) + acc[ai][bj][m][1];
                    ss += (v0[0] * v0[0] + v0[1] * v0[1]) + (v0[2] * v0[2] + v0[3] * v0[3]) + (v1[0] * v1[0] + v1[1] * v1[1]) + (v1[2] * v1[2] + v1[3] * v1[3]);
                    u32x4 w; w.x = pk2(v0[0], v0[1]); w.y = pk2(v0[2], v0[3]); w.z = pk2(v1[0], v1[1]); w.w = pk2(v1[2], v1[3]); *(u32x4*)(xb + o) = w; }
                ss += __shfl_xor(ss, 16); ss += __shfl_xor(ss, 32);
                if (fq == 0) ssq[(size_t)row * 16 + u.pn * 4 + wc] = ss; }
    }
};
struct EpiFF1 {
    static constexpr bool PERM = true, AFTER_DRAIN = false, MIDK = false;
    bf16* H;
    __device__ __forceinline__ void operator()(const f32x4 (&acc)[2][2][4][2], const pg8::Unit& u, int wr, int wc, int fr, int fq) const {
        const int row0 = u.pm * 256 + wr * 64 + fr, col0 = u.pn * 256 + wc * 32 + 8 * fq;
#pragma unroll
        for (int ai = 0; ai < 2; ++ai)
#pragma unroll
            for (int m = 0; m < 4; ++m) { bf16* rp = H + (size_t)(row0 + ai * 128 + m * 16) * DFF + col0;
#pragma unroll
                for (int bj = 0; bj < 2; ++bj) { f32x4 v0 = acc[ai][bj][m][0], v1 = acc[ai][bj][m][1];
#pragma unroll
                    for (int j = 0; j < 4; ++j) { const float t0 = fmaxf(v0[j], 0.f), t1 = fmaxf(v1[j], 0.f); v0[j] = t0 * t0; v1[j] = t1 * t1; }
                    u32x4 w; w.x = pk2(v0[0], v0[1]); w.y = pk2(v0[2], v0[3]); w.z = pk2(v1[0], v1[1]); w.w = pk2(v1[2], v1[3]); *(u32x4*)(rp + bj * 128) = w; } }
    }
};
struct EpiRes2 {
    static constexpr bool PERM = true, AFTER_DRAIN = false, MIDK = false;
    const bf16* xb; const float* ssq1; float* xo; float* ssq2;
    __device__ __forceinline__ void operator()(const f32x4 (&acc)[2][2][4][2], const pg8::Unit& u, int wr, int wc, int fr, int fq) const {
        const int row0 = u.pm * 256 + wr * 64 + fr, col0 = u.pn * 256 + wc * 32 + 8 * fq;
#pragma unroll
        for (int ai = 0; ai < 2; ++ai)
#pragma unroll
            for (int m = 0; m < 4; ++m) { const int row = row0 + ai * 128 + m * 16; const size_t off = (size_t)row * 1024 + col0;
                const f32x4 pt = *(const f32x4*)(ssq1 + (size_t)row * 16 + 4 * fq); float s = (pt[0] + pt[1]) + (pt[2] + pt[3]);
                s += __shfl_xor(s, 16); s += __shfl_xor(s, 32);
                const float r2 = 1.0f / (s * (1.0f / DM) + 1e-6f);
                float ss = 0.f;
#pragma unroll
                for (int bj = 0; bj < 2; ++bj) { const size_t o = off + bj * 128; float x1[8]; unpack8(*(const u32x4*)(xb + o), x1);
                    const f32x4 a0 = acc[ai][bj][m][0], a1 = acc[ai][bj][m][1];
                    const f32x4 v0 = {x1[0] + r2 * a0[0], x1[1] + r2 * a0[1], x1[2] + r2 * a0[2], x1[3] + r2 * a0[3]}, v1 = {x1[4] + r2 * a1[0], x1[5] + r2 * a1[1], x1[6] + r2 * a1[2], x1[7] + r2 * a1[3]};
                    ss += (v0[0] * v0[0] + v0[1] * v0[1]) + (v0[2] * v0[2] + v0[3] * v0[3]) + (v1[0] * v1[0] + v1[1] * v1[1]) + (v1[2] * v1[2] + v1[3] * v1[3]);
                    *(f32x4*)(xo + o) = v0; *(f32x4*)(xo + o + 4) = v1; }
                ss += __shfl_xor(ss, 16); ss += __shfl_xor(ss, 32);
                if (fq == 0) ssq2[(size_t)row * 16 + u.pn * 4 + wc] = ss; }
    }
};

struct EpiFinal {
    static constexpr bool PERM = true, AFTER_DRAIN = false, MIDK = false;
    const bf16* xb; const float* ssq1; float* out; const float* gfin; float* slot; unsigned* cnt; LAS unsigned char* xl;
    __device__ __forceinline__ void operator()(const f32x4 (&acc_)[2][2][4][2], const pg8::Unit& u, int wr, int wc, int fr, int fq) const {
        f32x4 (&acc)[2][2][4][2] = const_cast<f32x4 (&)[2][2][4][2]>(acc_);
        const int tid = threadIdx.x, lane = tid & 63, wid = tid >> 6;
        const int row0 = u.pm * 256 + wr * 64 + fr, col0 = u.pn * 256 + wc * 32 + 8 * fq;
        LAS float* P = (LAS float*)xl; LAS float* S = (LAS float*)(xl + 4096); LAS unsigned* flag = (LAS unsigned*)(xl + 5120);
#pragma unroll
        for (int ai = 0; ai < 2; ++ai)
#pragma unroll
            for (int m = 0; m < 4; ++m) { const int rl = ai * 128 + wr * 64 + m * 16 + fr, row = u.pm * 256 + rl;
                const f32x4 pt = *(const f32x4*)(ssq1 + (size_t)row * 16 + 4 * fq); float s = (pt[0] + pt[1]) + (pt[2] + pt[3]);
                s += __shfl_xor(s, 16); s += __shfl_xor(s, 32);
                const float r2 = 1.0f / (s * (1.0f / DM) + 1e-6f);
                float ss = 0.f;
#pragma unroll
                for (int bj = 0; bj < 2; ++bj) { float x1[8]; unpack8(*(const u32x4*)(xb + (size_t)row * 1024 + col0 + bj * 128), x1);
#pragma unroll
                    for (int j = 0; j < 8; ++j) { const float v = x1[j] + r2 * acc[ai][bj][m][j >> 2][j & 3]; acc[ai][bj][m][j >> 2][j & 3] = v; ss += v * v; } }
                ss += __shfl_xor(ss, 16); ss += __shfl_xor(ss, 32);
                if (fq == 0) P[rl * 4 + wc] = ss; }
        asm volatile("s_waitcnt lgkmcnt(0)" ::: "memory"); __builtin_amdgcn_s_barrier(); asm volatile("" ::: "memory");
        const int prow = wid * 32 + (lane & 31);
        if (lane < 32) { const float t = (P[prow * 4 + 0] + P[prow * 4 + 1]) + (P[prow * 4 + 2] + P[prow * 4 + 3]);
            __hip_atomic_store(slot + ((size_t)(u.pm * 256 + prow) * 4 + u.pn), t, __ATOMIC_RELAXED, __HIP_MEMORY_SCOPE_AGENT); }
        asm volatile("s_waitcnt vmcnt(0)" ::: "memory");
        if (lane == 0) __hip_atomic_fetch_add(cnt + 64 * u.pm, 1u, __ATOMIC_RELAXED, __HIP_MEMORY_SCOPE_AGENT);
        if (wid == 0) { unsigned sp = 0;
            while ((unsigned)__builtin_amdgcn_readfirstlane(__hip_atomic_load(cnt + 64 * u.pm, __ATOMIC_RELAXED, __HIP_MEMORY_SCOPE_AGENT)) < 32u) { __builtin_amdgcn_s_sleep(2); if (++sp > (1u << 12)) break; }
            __builtin_amdgcn_fence(__ATOMIC_ACQUIRE, "agent");
            if (lane == 0) flag[0] = 1u; }
        asm volatile("s_waitcnt vmcnt(0) lgkmcnt(0)" ::: "memory"); __builtin_amdgcn_s_barrier(); asm volatile("" ::: "memory");
        if (lane < 32) { const float* sl = slot + (size_t)(u.pm * 256 + prow) * 4; float t = 0.f;
#pragma unroll
            for (int k = 0; k < 4; ++k) t += __hip_atomic_load(sl + k, __ATOMIC_RELAXED, __HIP_MEMORY_SCOPE_AGENT);
            S[prow] = 1.0f / sqrtf(t * (1.0f / DM) + 1e-6f); }
        asm volatile("s_waitcnt vmcnt(0) lgkmcnt(0)" ::: "memory"); __builtin_amdgcn_s_barrier(); asm volatile("" ::: "memory");
#pragma unroll
        for (int bj = 0; bj < 2; ++bj) { const f32x4 g0 = *(const f32x4*)(gfin + col0 + bj * 128), g1 = *(const f32x4*)(gfin + col0 + bj * 128 + 4);
#pragma unroll
            for (int ai = 0; ai < 2; ++ai)
#pragma unroll
                for (int m = 0; m < 4; ++m) { const int rl = ai * 128 + wr * 64 + m * 16 + fr; const float rs = S[rl];
                    float* o = out + (size_t)(u.pm * 256 + rl) * 1024 + col0 + bj * 128;
                    *(f32x4*)o = acc[ai][bj][m][0] * rs * g0; *(f32x4*)(o + 4) = acc[ai][bj][m][1] * rs * g1; } }
        asm volatile("s_waitcnt lgkmcnt(0)" ::: "memory"); __builtin_amdgcn_s_barrier(); asm volatile("" ::: "memory");
    }
};

constexpr int AK_CH = 384 * 16 + 16, AV_DB = 384 * 64 + 64, AV_OFF = 8 * AK_CH, AV_BUF = 2 * AV_DB;
#define GLDS16(gsrc, ldst) do { unsigned keep_; asm volatile("s_mov_b32 %0, m0\n\ts_mov_b32 m0, %2\n\ts_nop 0\n\tglobal_load_lds_dwordx4 %1, off\n\ts_mov_b32 m0, %0" : "=&s"(keep_) : "v"(gsrc), "s"((unsigned)__builtin_amdgcn_readfirstlane(ldst)) : "memory"); } while (0)
struct AUnit { int p, sh, ls, ph, t0, head; size_t rowb; };
__device__ __forceinline__ AUnit attnA_decode(int unit) {
    AUnit a; const int u16 = unit & 15; a.p = (unit >> 4) % 3; a.head = (unit / 48) & 7; a.rowb = (size_t)(unit / 384) * SEQ;
    a.sh = 2 * a.p; a.ls = SEQ >> a.sh; a.ph = u16 & ((1 << a.sh) - 1); a.t0 = 256 * (u16 >> a.sh); return a;
}
__device__ __forceinline__ void attnA_dma(LAS unsigned char* lds, const unsigned char* ws, int unit, int vbuf, int wid, int lane) {
    const AUnit a = attnA_decode(unit);
    const bf16* KA = (const bf16*)(ws + WS_KA); const bf16* VA = (const bf16*)(ws + WS_VA);
    const unsigned ldsb = (unsigned)(unsigned long)lds;
#pragma unroll
    for (int k = 0; k < 6; ++k) { const int idx = wid * 6 + k, lr = 8 * idx + (lane >> 3); int t = a.t0 - 64 + lr; t = t < 0 ? 0 : (t > a.ls - 1 ? a.ls - 1 : t);
        const bf16* g = KA + (a.rowb + ((size_t)t << a.sh) + a.ph) * 512 + a.head * 64 + (((lane & 7) ^ ((lr >> 1) & 7)) * 8); GLDS16(g, ldsb + idx * 1024); }
#pragma unroll
    for (int k = 0; k < 6; ++k) { const int idx = wid * 6 + k, dblk = idx / 24, rg = idx % 24; int t = a.t0 - 64 + rg * 16 + (lane >> 2); t = t < 0 ? 0 : (t > a.ls - 1 ? a.ls - 1 : t);
        const bf16* g = VA + (a.rowb + ((size_t)t << a.sh) + a.ph) * 512 + a.head * 64 + dblk * 32 + (lane & 3) * 8; GLDS16(g, ldsb + vbuf + dblk * AV_DB + rg * 1024); }
}
__device__ __forceinline__ void attnA_phase(LAS unsigned char* lds, const unsigned char* ws, int vcu, int G) {
    const int tid = threadIdx.x, lane = tid & 63, w = __builtin_amdgcn_readfirstlane(tid >> 6), r = lane & 31, h = lane >> 5;
    constexpr int NU = BATCH * 8 * 3 * 16;
    const bf16* QA = (const bf16*)(ws + WS_QA);
    if (vcu < NU) attnA_dma(lds, ws, vcu, AV_OFF, w, lane);
    int it = 0;
    bf16x8 qn[4];
    if (vcu < NU) { const AUnit a = attnA_decode(vcu); const size_t qr = a.rowb + ((size_t)(a.t0 + 32 * w + r) << a.sh) + a.ph;
#pragma unroll
        for (int ks = 0; ks < 4; ++ks) qn[ks] = *(const bf16x8*)(QA + qr * 512 + a.head * 64 + 16 * ks + 8 * h); }
    for (int unit = vcu; unit < NU; unit += G, ++it) {
        const AUnit a = attnA_decode(unit);
        const int vbuf = AV_OFF + (it & 1) * AV_BUF;
        bf16* AO = (bf16*)(ws + (a.p == 0 ? WS_AO0 : a.p == 1 ? WS_AO1 : WS_AO2)); float* LSE = (float*)(ws + WS_LSE) + (size_t)a.p * M * 8;
        const int tq = a.t0 + 32 * w + r; const size_t qrow = a.rowb + ((size_t)tq << a.sh) + a.ph;
        bf16x8 qf[4];
#pragma unroll
        for (int ks = 0; ks < 4; ++ks) qf[ks] = qn[ks];
        asm volatile("s_waitcnt vmcnt(0)" ::: "memory");
        __syncthreads();
        f32x16 s[5];
        {
            bf16x8 kf[2][4];
            const LAS unsigned char* kp = lds + (32 * w + r) * 128;
            int kx[4];
#pragma unroll
            for (int ks = 0; ks < 4; ++ks) kx[ks] = ((2 * ks + h) ^ ((r >> 1) & 7)) * 16;
#pragma unroll
            for (int ks = 0; ks < 4; ++ks) kf[0][ks] = *(const LAS bf16x8*)(kp + kx[ks]);
#pragma unroll
            for (int j = 0; j < 5; ++j) {
                if (j + 1 < 5) {
#pragma unroll
                    for (int ks = 0; ks < 4; ++ks) kf[(j + 1) & 1][ks] = *(const LAS bf16x8*)(kp + kx[ks] + (j + 1) * 4096); }
                __builtin_amdgcn_sched_barrier(0);
                f32x16 acc = {};
#pragma unroll
                for (int ks = 0; ks < 4; ++ks) acc = MFMA32(kf[j & 1][ks], qf[ks], acc);
                s[j] = acc;
                __builtin_amdgcn_sched_barrier(0);
            }
        }
        __syncthreads();
        if (unit + G < NU) { attnA_dma(lds, ws, unit + G, AV_OFF + ((it + 1) & 1) * AV_BUF, w, lane);
            const AUnit an = attnA_decode(unit + G); const size_t qr = an.rowb + ((size_t)(an.t0 + 32 * w + r) << an.sh) + an.ph;
#pragma unroll
            for (int ks = 0; ks < 4; ++ks) qn[ks] = *(const bf16x8*)(QA + qr * 512 + an.head * 64 + 16 * ks + 8 * h); }
        float mx = -INFINITY;
        if ((a.t0 - 64 + 32 * w >= 0) && (a.t0 + 32 * w + 96 <= a.ls)) {
#pragma unroll
            for (int i = 0; i < 16; ++i) { const int cr = crow(i, h);
                s[0][i] = (cr >= r) ? s[0][i] : -INFINITY; s[4][i] = (cr <= r) ? s[4][i] : -INFINITY; }
#pragma unroll
            for (int j = 0; j < 5; ++j)
#pragma unroll
                for (int i = 0; i < 16; ++i) mx = fmaxf(mx, s[j][i]);
        } else {
#pragma unroll
            for (int j = 0; j < 5; ++j)
#pragma unroll
                for (int i = 0; i < 16; ++i) { const int cr = crow(i, h), rel = 32 * j + cr - 64 - r, tk = a.t0 - 64 + 32 * w + 32 * j + cr;
                    const bool valid = (rel >= -64) && (rel <= 64) && (tk >= 0) && (tk < a.ls);
                    const float v = valid ? s[j][i] : -INFINITY; s[j][i] = v; mx = fmaxf(mx, v); }
        }
        mx = fmaxf(mx, xhalf(mx));
        float l = 0.f;
#pragma unroll
        for (int j = 0; j < 5; ++j)
#pragma unroll
            for (int i = 0; i < 16; ++i) { const float e = __builtin_amdgcn_exp2f(s[j][i] - mx); s[j][i] = e; l += e; }
        l += xhalf(l);
        f32x16 o[2] = {};
        const int i16 = lane & 15, qd = i16 >> 2, pp = i16 & 3, blk = (lane >> 4) & 1;
        const LAS unsigned char* vb = lds + vbuf + (32 * w + 4 * h + qd) * 64 + blk * 32 + pp * 8;
#pragma unroll
        for (int j = 0; j < 5; ++j)
#pragma unroll
            for (int sp = 0; sp < 2; ++sp) { const bf16x8 pf = pack8(s[j], sp);
#pragma unroll
                for (int db = 0; db < 2; ++db) { const LAS unsigned char* av = vb + db * AV_DB + (32 * j + 16 * sp) * 64;
                    const bf16x8 vf = cat8(vtr(av), vtr(av + 512)); o[db] = MFMA32(vf, pf, o[db]); } }
        const float rl = 1.0f / l;
        bf16* op = AO + qrow * 512 + a.head * 64 + 8 * h;
#pragma unroll
        for (int db = 0; db < 2; ++db)
#pragma unroll
            for (int gp = 0; gp < 2; ++gp) {
                unsigned a0 = pk2(o[db][8 * gp] * rl, o[db][8 * gp + 1] * rl), a1 = pk2(o[db][8 * gp + 2] * rl, o[db][8 * gp + 3] * rl);
                unsigned b0 = pk2(o[db][8 * gp + 4] * rl, o[db][8 * gp + 5] * rl), b1 = pk2(o[db][8 * gp + 6] * rl, o[db][8 * gp + 7] * rl);
                const auto s0 = __builtin_amdgcn_permlane32_swap(a0, b0, false, false); const auto s1 = __builtin_amdgcn_permlane32_swap(a1, b1, false, false);
                u32x4 wv; wv.x = s0[0]; wv.y = s1[0]; wv.z = s0[1]; wv.w = s1[1];
                *(u32x4*)(op + 32 * db + 16 * gp) = wv; }
        if (h == 0) LSE[qrow * 8 + a.head] = mx + __builtin_amdgcn_logf(l);
    }
    __syncthreads();
}

__device__ __forceinline__ void attnA_combine(const unsigned char* ws, int vcu, int G) {
    const bf16* A0 = (const bf16*)(ws + WS_AO0); const bf16* A1 = (const bf16*)(ws + WS_AO1); const bf16* A2 = (const bf16*)(ws + WS_AO2);
    const float* LSE = (const float*)(ws + WS_LSE); bf16* O = (bf16*)(ws + WS_ATTA);
    for (size_t it = (size_t)vcu * 512 + threadIdx.x; it < (size_t)M * 64; it += (size_t)G * 512) {
        const size_t rh = it >> 3;
        const float l0 = LSE[rh], l1 = LSE[(size_t)M * 8 + rh], l2 = LSE[(size_t)2 * M * 8 + rh];
        const float mx = fmaxf(l0, fmaxf(l1, l2));
        float w0 = __builtin_amdgcn_exp2f(l0 - mx), w1 = __builtin_amdgcn_exp2f(l1 - mx), w2 = __builtin_amdgcn_exp2f(l2 - mx);
        const float inv = 1.0f / (w0 + w1 + w2); w0 *= inv; w1 *= inv; w2 *= inv;
        const u32x4 a = *(const u32x4*)(A0 + it * 8), bq = *(const u32x4*)(A1 + it * 8), c = *(const u32x4*)(A2 + it * 8);
        u32x4 o;
#pragma unroll
        for (int k = 0; k < 4; ++k) o[k] = pk2(w0 * bflo(a[k]) + w1 * bflo(bq[k]) + w2 * bflo(c[k]), w0 * bfhi(a[k]) + w1 * bfhi(bq[k]) + w2 * bfhi(c[k]));
        *(u32x4*)(O + (it >> 6) * 1024 + (it & 63) * 8) = o;
    }
}

constexpr int BK_CH = 64 * 16 + 16, BK_IMG = 8 * BK_CH, BV_DB = 64 * 64 + 64, BV_IMG = 4 * BV_DB, BBUF = 2 * BK_IMG + BV_IMG;
__device__ __forceinline__ void attnB_unit(LAS unsigned char* lds, const unsigned char* ws, int unit, float lam, const float* subln_g) {
    const int tid = threadIdx.x, lane = tid & 63, wid = __builtin_amdgcn_readfirstlane(tid >> 6), w = wid & 3, c = wid >> 2, r = lane & 31, h = lane >> 5;
    const int qb = unit & 31, hd = (unit >> 5) & 3, b = unit >> 7, q0 = qb * 128;
    const bf16* QB = (const bf16*)(ws + WS_QB); const bf16* KB = (const bf16*)(ws + WS_KB); const bf16* VB = (const bf16*)(ws + WS_VB); bf16* OB = (bf16*)(ws + WS_ATTA);
    const size_t rowb = (size_t)b * SEQ;
    const size_t qrow = rowb + q0 + 32 * w + r;
    bf16x8 qf[4];
#pragma unroll
    for (int ks = 0; ks < 4; ++ks) qf[ks] = *(const bf16x8*)(QB + qrow * 512 + hd * 128 + c * 64 + 16 * ks + 8 * h);
    const int rot = (qb * 2) & 63;
    const bf16* kg = KB + (rowb + lane) * 512 + hd * 128 + wid * 8;
    const bf16* vg0 = VB + (rowb + (wid & 3) * 16 + (lane >> 2)) * 512 + hd * 128 + (wid >> 2) * 32 + (lane & 3) * 8;
    const unsigned ldsb = (unsigned)(unsigned long)lds;
    const unsigned kd = ldsb + wid * BK_CH, vd0 = ldsb + 2 * BK_IMG + (wid >> 2) * BV_DB + (wid & 3) * 1024;
#define B_DMA(t, boff) do { const size_t go = (size_t)(((t) + rot) & 63) * 64 * 512; \
        GLDS16(kg + go, kd + (boff)); GLDS16(kg + go + 64, kd + BK_IMG + (boff)); GLDS16(vg0 + go, vd0 + (boff)); GLDS16(vg0 + go + 64, vd0 + 2 * BV_DB + (boff)); } while (0)
#define B_WAITBAR() do { asm volatile("s_waitcnt vmcnt(0)" ::: "memory"); __syncthreads(); } while (0)
#define B_QK(boff, S0, S1) do { const LAS unsigned char* kb_ = lds + (boff) + koff; _Pragma("unroll") for (int ks = 0; ks < 4; ++ks) { \
        const bf16x8 a0 = *(const LAS bf16x8*)(kb_ + 2 * ks * BK_CH), a1 = *(const LAS bf16x8*)(kb_ + 2 * ks * BK_CH + 512); \
        S0 = MFMA32(a0, qf[ks], S0); S1 = MFMA32(a1, qf[ks], S1); } } while (0)
    const int i16 = lane & 15, qd = i16 >> 2, pp = i16 & 3, blk = (lane >> 4) & 1;
    const int voff = 2 * BK_IMG + (4 * h + qd) * 64 + blk * 32 + pp * 8, koff = c * BK_IMG + h * BK_CH + r * 16;
    constexpr int NT = SEQ / 64;
    B_DMA(0, 0); B_DMA(1, BBUF);
    B_WAITBAR();
    f32x16 n0 = {}, n1 = {};
    B_QK(0, n0, n1);
    float mrow = fmaxf(n0[0], n1[0]);
#pragma unroll
    for (int i = 1; i < 16; ++i) mrow = fmaxf(mrow, fmaxf(n0[i], n1[i]));
    mrow = fmaxf(mrow, xhalf(mrow));
    f32x16 negm;
#pragma unroll
    for (int i = 0; i < 16; ++i) { negm[i] = -mrow; n0[i] -= mrow; n1[i] -= mrow; }
    f32x16 o[4] = {}; float l = 0.f;
#define SB() __builtin_amdgcn_sched_barrier(0)
#define B_ITER(t, bcur, bnext, bnn) do { \
        if ((t) + 2 < NT) B_DMA((t) + 2, bnn); \
        f32x16 s0 = n0, s1 = n1; bf16x8 kf[8]; \
        if ((t) + 1 < NT) { const LAS unsigned char* kb_ = lds + (bnext) + koff; \
            _Pragma("unroll") for (int ks = 0; ks < 4; ++ks) { kf[2 * ks] = *(const LAS bf16x8*)(kb_ + 2 * ks * BK_CH); kf[2 * ks + 1] = *(const LAS bf16x8*)(kb_ + 2 * ks * BK_CH + 512); } } \
        SB(); \
        float lsum = 0.f; bf16x8 pf[4]; \
        _Pragma("unroll") for (int i = 0; i < 16; ++i) { s0[i] = __builtin_amdgcn_exp2f(s0[i]); lsum += s0[i]; } \
        pf[0] = pack8(s0, 0); pf[1] = pack8(s0, 1); \
        SB(); \
        if ((t) + 1 < NT) { n0 = negm; n1 = negm; \
            _Pragma("unroll") for (int ks = 0; ks < 4; ++ks) { n0 = MFMA32(kf[2 * ks], qf[ks], n0); n1 = MFMA32(kf[2 * ks + 1], qf[ks], n1); } } \
        _Pragma("unroll") for (int i = 0; i < 16; ++i) { s1[i] = __builtin_amdgcn_exp2f(s1[i]); lsum += s1[i]; } \
        pf[2] = pack8(s1, 0); pf[3] = pack8(s1, 1); \
        l += lsum; \
        const LAS unsigned char* vb_ = lds + (bcur) + voff; \
        _Pragma("unroll") for (int kk = 0; kk < 4; ++kk) \
        _Pragma("unroll") for (int db = 0; db < 4; ++db) { const LAS unsigned char* a = vb_ + db * BV_DB + kk * 1024; \
                const bf16x8 vf = cat8(vtr(a), vtr(a + 512)); o[db] = MFMA32(vf, pf[kk], o[db]); } \
        if (__any(lsum > 0x1p40f)) { float ls2 = lsum + xhalf(lsum); const float d = ls2 > 0x1p40f ? floorf(__builtin_amdgcn_logf(ls2)) : 0.f, f = __builtin_amdgcn_exp2f(-d); l *= f; \
            _Pragma("unroll") for (int i = 0; i < 16; ++i) { negm[i] -= d; n0[i] -= d; n1[i] -= d; } \
            _Pragma("unroll") for (int db = 0; db < 4; ++db) _Pragma("unroll") for (int i = 0; i < 16; ++i) o[db][i] *= f; } \
        B_WAITBAR(); } while (0)
    for (int t3 = 0; t3 < NT - 1; t3 += 3) {
        B_ITER(t3, 0, BBUF, 2 * BBUF);
        B_ITER(t3 + 1, BBUF, 2 * BBUF, 0);
        B_ITER(t3 + 2, 2 * BBUF, 0, BBUF);
    }
    B_ITER(NT - 1, 0, BBUF, 2 * BBUF);
#undef B_ITER
#undef B_QK
#undef B_DMA
    l += xhalf(l);
    const float rl = 1.0f / l;
    LAS float* ex = (LAS float*)lds + w * 4096 + lane;
    if (c == 1) {
#pragma unroll
        for (int db = 0; db < 4; ++db)
#pragma unroll
            for (int i = 0; i < 16; ++i) ex[(db * 16 + i) * 64] = o[db][i] * rl;
    }
    __syncthreads();
    if (c == 0) {
        float ss = 0.f;
#pragma unroll
        for (int db = 0; db < 4; ++db)
#pragma unroll
            for (int i = 0; i < 16; ++i) { const float v = o[db][i] * rl - lam * ex[(db * 16 + i) * 64]; o[db][i] = v; ss += v * v; }
        ss += xhalf(ss);
        const float rs = 0.8f / sqrtf(ss * (1.0f / 128.0f) + 1e-5f);
        bf16* op = OB + qrow * 1024 + 512 + hd * 128 + 8 * h;
#pragma unroll
        for (int db = 0; db < 4; ++db)
#pragma unroll
            for (int gp = 0; gp < 2; ++gp) {
                const f32x4 ga = *(const f32x4*)(subln_g + 32 * db + 16 * gp + 4 * h), gb = *(const f32x4*)(subln_g + 32 * db + 16 * gp + 8 + 4 * h);
                unsigned a0 = pk2(o[db][8 * gp] * rs * ga[0], o[db][8 * gp + 1] * rs * ga[1]), a1 = pk2(o[db][8 * gp + 2] * rs * ga[2], o[db][8 * gp + 3] * rs * ga[3]);
                unsigned b0 = pk2(o[db][8 * gp + 4] * rs * gb[0], o[db][8 * gp + 5] * rs * gb[1]), b1 = pk2(o[db][8 * gp + 6] * rs * gb[2], o[db][8 * gp + 7] * rs * gb[3]);
                const auto s0 = __builtin_amdgcn_permlane32_swap(a0, b0, false, false); const auto s1 = __builtin_amdgcn_permlane32_swap(a1, b1, false, false);
                u32x4 wv; wv.x = s0[0]; wv.y = s1[0]; wv.z = s0[1]; wv.w = s1[1];
                *(u32x4*)(op + 32 * db + 16 * gp) = wv; }
    }
    __syncthreads();
}

#define XB_TMO      128
#define XB_XCNT(j)  (256  + 64 * (j))
#define XB_XSUB(j)  (1280 + 64 * (j))
#define XB_XGEN(j)  (2304 + 64 * (j))
#define XB_TOP      3328
#define XB_TOPGEN   3392
#define XCD_BAR_WORDS 3456
#define XB_SPIN_CAP (1u << 18)

__device__ __forceinline__ unsigned xb_ld(unsigned* p)              { return __hip_atomic_load(p, __ATOMIC_RELAXED, __HIP_MEMORY_SCOPE_AGENT); }
__device__ __forceinline__ unsigned xb_add(unsigned* p, unsigned v) { return __hip_atomic_fetch_add(p, v, __ATOMIC_RELAXED, __HIP_MEMORY_SCOPE_AGENT); }
__device__ __forceinline__ unsigned xb_xcc_id() { return (unsigned)__builtin_amdgcn_s_getreg((3 << 11) | 20) & 0xFu; }
#define XB_SPIN(cond, bar) do { unsigned _sp = 0; while (cond) { __builtin_amdgcn_s_sleep(1); \
    if ((++_sp & 255u) == 0u) { if (xb_ld(&(bar)[XB_TMO])) break; if (_sp > XB_SPIN_CAP) { atomicAdd(&(bar)[XB_TMO], 1u); break; } } } } while (0)

struct XcdBarrier {
    unsigned* bar; unsigned x;
    volatile LAS unsigned* st;
};

__device__ __forceinline__ XcdBarrier xcd_barrier_post(unsigned* bar, volatile LAS unsigned* st) {
    XcdBarrier b; b.bar = bar; b.x = xb_xcc_id(); b.st = st;
    if (threadIdx.x == 0) (void)xb_add(&bar[XB_XCNT(b.x)], 1u);
    return b;
}
__device__ __forceinline__ void xcd_barrier_complete(unsigned* bar, unsigned x, unsigned& nloc, unsigned& nx) {
    const unsigned G = gridDim.x * gridDim.y * gridDim.z;
    unsigned sum, cnt, mine, sp = 0u;
    for (;;) {
        sum = 0u; cnt = 0u; mine = 0u;
#pragma unroll
        for (unsigned j = 0; j < 16; ++j) { const unsigned c = xb_ld(&bar[XB_XCNT(j)]); sum += c; cnt += (c > 0u) ? 1u : 0u; mine = (j == x) ? c : mine; }
        if (sum == G) break;
        __builtin_amdgcn_s_sleep(1);
        if ((++sp & 255u) == 0u) { if (xb_ld(&bar[XB_TMO])) break; if (sp > XB_SPIN_CAP) { atomicAdd(&bar[XB_TMO], 1u); break; } }
    }
    nloc = mine > 0u ? mine : 1u; nx = cnt > 0u ? cnt : 1u;
}

__device__ __forceinline__ void xcd_barrier(const XcdBarrier& b) {
    asm volatile("s_waitcnt vmcnt(0)" ::: "memory");
    __syncthreads();
    if (threadIdx.x == 0) {
        unsigned* bar = b.bar;
        __builtin_amdgcn_s_waitcnt(0);
        unsigned nloc = b.st[0], nx = b.st[1];
        if (nloc == 0u) { xcd_barrier_complete(bar, b.x, nloc, nx); b.st[0] = nloc; b.st[1] = nx; }
        const unsigned old = xb_add(&bar[XB_XSUB(b.x)], 1u);
        const unsigned gen = old / nloc;
        if (old + 1u == (gen + 1u) * nloc) {
            __builtin_amdgcn_fence(__ATOMIC_RELEASE, "agent");
            asm volatile("s_waitcnt vmcnt(0)" ::: "memory");
            const unsigned og = xb_add(&bar[XB_TOP], 1u);
            const unsigned tg = og / nx;
            if (og + 1u == (tg + 1u) * nx) xb_add(&bar[XB_TOPGEN], 1u);
            else XB_SPIN(xb_ld(&bar[XB_TOPGEN]) == tg, bar);
            __builtin_amdgcn_fence(__ATOMIC_ACQUIRE, "agent");
            xb_add(&bar[XB_XGEN(b.x)], 1u);
            asm volatile("s_waitcnt vmcnt(0)" ::: "memory");
        } else {
            XB_SPIN(xb_ld(&bar[XB_XGEN(b.x)]) == gen, bar);
            __builtin_amdgcn_fence(__ATOMIC_ACQUIRE, "agent");
            asm volatile("s_waitcnt vmcnt(0)" ::: "memory");
        }
    }
    __syncthreads();
}


__global__ void __launch_bounds__(512, 2) fwd_kernel(Args A) {
    extern __shared__ __attribute__((aligned(16))) unsigned char lds_raw[];
    LAS unsigned char* lds = (LAS unsigned char*)lds_raw;
    const int G = gridDim.x, bx = blockIdx.x, tid = threadIdx.x;
    const int vcu = (G % 8 == 0) ? (bx % 8) * (G / 8) + bx / 8 : bx;
    unsigned char* ws = A.ws;
    const int lo = A.ph_lo, hi = A.ph_hi;
    volatile LAS unsigned* MISC = (volatile LAS unsigned*)(lds + 151552);
    if (tid < 16) MISC[tid] = 0u;
    __syncthreads();
    if (lo == -12345) cg::this_grid().sync();
    XcdBarrier bar = xcd_barrier_post((unsigned*)(ws + WS_CTL), MISC + 8);
#define IN(k) (lo <= (k) && (k) < hi)
#define SEAM(k) do { if (IN(k) && IN((k) + 1)) xcd_barrier(bar); } while (0)
    if (IN(0)) p0_prologue(A, lds, vcu, G);
    SEAM(0);
    if (IN(1)) {
        pg8::Gemm g{(const bf16*)(ws + WS_XN), (const bf16*)(ws + WS_WIN), M, INW, 1024}; pg8::StaticOrder S; S.init(M, INW, G, bx, 4);
        EpiIn E{ws};
        pg8::gemm_phase<EpiIn, pg8::StaticOrder, true, true>(lds, g, S, E);
    }
    SEAM(1);
    if (IN(2)) attnA_phase(lds, ws, vcu, G);
    SEAM(2);
    if (IN(3)) {
        attnA_combine(ws, vcu, G);
        float d1 = 0.f, d2 = 0.f;
        for (int i = 0; i < 64; ++i) { d1 += A.lq1[i] * A.lk1[i]; d2 += A.lq2[i] * A.lk2[i]; }
        const float lam = expf(d1) - expf(d2) + 0.2f;
        if (tid >= 256) __builtin_amdgcn_s_setprio(1);
        for (int u = vcu; u < BATCH * 4 * 32; u += G) attnB_unit(lds, ws, u, lam, A.subln_g);
        __builtin_amdgcn_s_setprio(0);
    }
    SEAM(3);
    if (IN(4)) {
        pg8::Gemm g{(const bf16*)(ws + WS_ATTA), (const bf16*)(ws + WS_WA), M, 1024, 1024}; pg8::StaticOrder S; S.init(M, 1024, G, bx);
        EpiGate2 E{(const unsigned char*)(ws + WS_SGA), (const unsigned char*)(ws + WS_SGB), (bf16*)(ws + WS_MERGED)};
        pg8::gemm_phase<EpiGate2, pg8::StaticOrder, true, true>(lds, g, S, E);
    }
    SEAM(4);
    if (IN(5)) {
        pg8::Gemm g{(const bf16*)(ws + WS_MERGED), (const bf16*)(ws + WS_WOUT), M, 1024, 1024}; pg8::StaticOrder S; S.init(M, 1024, G, bx);
        EpiRes1 E{A.x, (bf16*)(ws + WS_X1B), (float*)(ws + WS_SSQ1)};
        pg8::gemm_phase<EpiRes1, pg8::StaticOrder, true, true>(lds, g, S, E);
    }
    SEAM(5);
    if (IN(6)) {
        pg8::Gemm g{(const bf16*)(ws + WS_X1B), (const bf16*)(ws + WS_W1), M, DFF, 1024}; pg8::StaticOrder S; S.init(M, DFF, G, bx);
        EpiFF1 E{(bf16*)(ws + WS_H)};
        pg8::gemm_phase<EpiFF1, pg8::StaticOrder, true, true>(lds, g, S, E);
    }
    SEAM(6);
    if (IN(7)) {
        pg8::Gemm g{(const bf16*)(ws + WS_H), (const bf16*)(ws + WS_W2), M, 1024, DFF}; pg8::StaticOrder S; S.init(M, 1024, G, bx);
        EpiFinal E{(const bf16*)(ws + WS_X1B), (const float*)(ws + WS_SSQ1), A.out, A.g_final, (float*)(ws + WS_SSQ2), (unsigned*)(ws + WS_CTL + 65536), lds + 131072};
        pg8::gemm_phase<EpiFinal, pg8::StaticOrder, true, true>(lds, g, S, E);
    }
#undef IN
#undef SEAM
}

#ifndef MK_PER_PHASE
#define MK_PER_PHASE 0
#endif
extern "C" void kernel_launch(void* const* d_in, const int* in_sizes, int n_in, void* d_out, int out_size, void* d_ws, size_t ws_size, hipStream_t stream) {
    static int grid = 0;
    if (grid == 0) {
        if (n_in != 15 || in_sizes[0] != M * DM || out_size != M * DM || ws_size < WS_END) { fprintf(stderr, "kernel_launch: unexpected shapes / workspace (%d inputs, ws %zu)\n", n_in, ws_size); grid = -1; return; }
        int dev = 0, cus = 0, per_cu = 0;
        (void)hipGetDevice(&dev); (void)hipDeviceGetAttribute(&cus, hipDeviceAttributeMultiprocessorCount, dev);
        (void)hipFuncSetAttribute((const void*)fwd_kernel, hipFuncAttributeMaxDynamicSharedMemorySize, LDS_BYTES);
        (void)hipOccupancyMaxActiveBlocksPerMultiprocessor(&per_cu, (const void*)fwd_kernel, 512, LDS_BYTES);
        if (per_cu < 1) per_cu = 1;
        grid = cus * per_cu;
        fprintf(stderr, "kernel_launch: %d CUs x %d = grid %d\n", cus, per_cu, grid);
    }
    if (grid < 0) return;
    (void)hipMemsetAsync((unsigned char*)d_ws + WS_CTL, 0, 131072, stream);
    Args a{};
    a.x = (const float*)d_in[0]; a.w_in = (const float*)d_in[1]; a.w_a = (const float*)d_in[2]; a.w_b = (const float*)d_in[3]; a.w_out = (const float*)d_in[4];
    a.lq1 = (const float*)d_in[5]; a.lk1 = (const float*)d_in[6]; a.lq2 = (const float*)d_in[7]; a.lk2 = (const float*)d_in[8]; a.subln_g = (const float*)d_in[9];
    a.g_mix = (const float*)d_in[10]; a.g_mlp = (const float*)d_in[11]; a.w_ff1 = (const float*)d_in[12]; a.w_ff2 = (const float*)d_in[13]; a.g_final = (const float*)d_in[14];
    a.out = (float*)d_out; a.ws = (unsigned char*)d_ws;
#if MK_PER_PHASE
    for (int ph = 0; ph < NPHASE - 1; ++ph) { a.ph_lo = ph; a.ph_hi = ph + 1; hipLaunchKernelGGL(fwd_kernel, dim3(grid), dim3(512), LDS_BYTES, stream, a); }
#else
    a.ph_lo = 0; a.ph_hi = NPHASE;
    void* args[] = {&a};
    hipError_t e = hipLaunchCooperativeKernel((const void*)fwd_kernel, dim3(grid), dim3(512), args, LDS_BYTES, stream);
    if (e != hipSuccess) fprintf(stderr, "cooperative launch failed: %s (grid %d)\n", hipGetErrorString(e), grid);
#endif
}
```

```cpp
#include <hip/hip_runtime.h>
#include <hip/hip_cooperative_groups.h>
#include <cstdio>
#include <cstdint>
namespace cg = cooperative_groups;
namespace pg8 {
#define PG8_LAS __attribute__((address_space(3)))
typedef unsigned short bf16_t;
typedef short bf16x8 __attribute__((ext_vector_type(8)));
typedef float f32x4 __attribute__((ext_vector_type(4)));
typedef unsigned u32x4 __attribute__((ext_vector_type(4)));
constexpr int BM = 256, BK = 64, HALF = 128, HTB = HALF * BK * 2  , STAGE_BYTES = 8 * HTB, NXCD = 8, WGM = 8;

__host__ __device__ __forceinline__ int lds_byte(int r, int c) { const int st = (r >> 4) * 2 + (c >> 5), rr = r & 15, cc = c & 31, ob = rr * 64 + cc * 2; return st * 1024 + (ob ^ (((ob >> 9) & 1) << 5)); }
__host__ __device__ __forceinline__ void stage_rc(int b, int& R, int& C) { const int st = b / 1024, sb = b % 1024, swz = sb ^ (((sb >> 9) & 1) << 5); R = (st >> 1) * 16 + swz / 64; C = (st & 1) * 32 + (swz % 64) / 2; }
__host__ __device__ __forceinline__ int perm32(int rho) { const int n = rho >> 4, i = rho & 15; return 8 * (i >> 2) + 4 * n + (i & 3); }

struct Unit { int pm, pn; };
struct Gemm { const bf16_t* A; const bf16_t* Bt; int M, N, K; };

struct StaticOrder {
    int nM, nN, nwg, G, c, wgm;
    __host__ __device__ void init(int M, int N, int G_, int c_, int wgm_ = WGM) { nM = M / BM; nN = N / BM; nwg = nM * nN; G = G_; c = c_; wgm = wgm_; }
    __host__ __device__ bool next(int i, Unit& u) const {
        const long L = (long)i * G + c; if (L >= nwg) return false;
        int wgid = (int)L; { const int q = nwg / NXCD, r = nwg % NXCD, xcd = wgid % NXCD, off = wgid / NXCD; wgid = (xcd < r ? xcd * (q + 1) : r * (q + 1) + (xcd - r) * q) + off; }
        const int nig = wgm * nN, gid = wgid / nig, fm = gid * wgm, gsz = (nM - fm) < wgm ? (nM - fm) : wgm;
        u.pm = fm + ((wgid % nig) % gsz); u.pn = (wgid % nig) / gsz; return true;
    }
    __device__ __forceinline__ void a_ready(const Unit&) const {}
    __device__ __forceinline__ void done(const Unit&) const {}
};

__device__ __forceinline__ unsigned cvt_pk_bf16(float lo, float hi) { unsigned r; asm volatile("v_cvt_pk_bf16_f32 %0, %1, %2" : "=v"(r) : "v"(lo), "v"(hi)); return r; }
template <class Epi, class Sched, bool ALIGN_EPI = false, bool SP2 = false>
__device__ __forceinline__ void gemm_phase(PG8_LAS unsigned char* lds, const Gemm g, const Sched& S, const Epi& E) {
    const int tid = threadIdx.x, wid = __builtin_amdgcn_readfirstlane(tid >> 6), lane = tid & 63, wr = wid >> 2, wc = wid & 3, fr = lane & 15, fq = lane >> 4;
    const int K = g.K, nt = K / BK;
    unsigned voffA[2], voffB[2];
#pragma unroll
    for (int i = 0; i < 2; ++i) { int R, C; stage_rc(tid * 16 + i * 8192, R, C); const int Rb = Epi::PERM ? ((R & ~31) + perm32(R & 31)) : R;
        voffA[i] = (unsigned)(R * K + C) * 2u; voffB[i] = (unsigned)(Rb * K + C) * 2u; }
    const size_t kstep = (size_t)(BK * 2);
    const size_t hstep = (size_t)HALF * K * 2;
    const size_t tstep = 2 * hstep;
    const unsigned ldsw = (unsigned)wid * 1024u;
    const int aoff = lds_byte(wr * 64 + fr, fq * 8), boff = lds_byte(wc * 32 + fr, fq * 8);
#define PG8_SA(b, h) (((b) * 2 + (h)) * HTB)
#define PG8_SB(b, h) ((4 + (b) * 2 + (h)) * HTB)
#define PG8_STAGE(bufoff, gbase, voff) do { _Pragma("unroll") for (int _i = 0; _i < 2; ++_i) \
        __builtin_amdgcn_global_load_lds((const unsigned*)((const char*)(gbase) + (voff)[_i]), (PG8_LAS unsigned*)(lds + (bufoff) + ldsw + _i * 8192), 16, 0, 0); } while (0)
#define PG8_LDA(dst, b, h) do { _Pragma("unroll") for (int m = 0; m < 4; ++m) _Pragma("unroll") for (int k = 0; k < 2; ++k) dst[m][k] = *(const PG8_LAS bf16x8*)(lds + PG8_SA(b, h) + aoff + m * 2048 + k * 1024); } while (0)
#define PG8_LDB(dst, b, h) do { _Pragma("unroll") for (int n = 0; n < 2; ++n) _Pragma("unroll") for (int k = 0; k < 2; ++k) dst[n][k] = *(const PG8_LAS bf16x8*)(lds + PG8_SB(b, h) + boff + n * 2048 + k * 1024); } while (0)
#define PG8_MMA(ai, bj, At, Bt) do { __builtin_amdgcn_s_setprio(1); _Pragma("unroll") for (int m = 0; m < 4; ++m) _Pragma("unroll") for (int n = 0; n < 2; ++n) _Pragma("unroll") for (int k = 0; k < 2; ++k) \
        acc[ai][bj][m][n] = __builtin_amdgcn_mfma_f32_16x16x32_bf16(Bt[n][k], At[m][k], acc[ai][bj][m][n], 0, 0, 0); __builtin_amdgcn_s_setprio(0); } while (0)
#define PG8_WAIT_V(n) asm volatile("s_waitcnt vmcnt(" #n ")" ::: "memory")
#define PG8_WAIT_L(n) asm volatile("s_waitcnt lgkmcnt(" #n ")" ::: "memory")
#define PG8_BAR __builtin_amdgcn_s_barrier()
#define PG8_SCHED __builtin_amdgcn_sched_barrier(0)
    Unit cur, nxt; int ui = 0;
    if (!S.next(0, cur)) return;
    f32x4 acc[2][2][4][2];
#pragma unroll
    for (int a = 0; a < 2; ++a)
#pragma unroll
        for (int b = 0; b < 2; ++b)
#pragma unroll
            for (int m = 0; m < 4; ++m)
#pragma unroll
                for (int n = 0; n < 2; ++n) acc[a][b][m][n] = (f32x4){0.f, 0.f, 0.f, 0.f};
    bf16x8 At[4][2], B0[2][2], B1[2][2];
    const char* cA = (const char*)g.A + (size_t)cur.pm * tstep; const char* cB = (const char*)g.Bt + (size_t)cur.pn * tstep;
    S.a_ready(cur);
    if constexpr (SP2) {
        PG8_STAGE(PG8_SB(0, 0), cB, voffB); PG8_STAGE(PG8_SB(0, 1), cB + hstep, voffB); PG8_STAGE(PG8_SA(0, 0), cA, voffA); PG8_STAGE(PG8_SA(0, 1), cA + hstep, voffA);
        if (wr == 1) PG8_BAR;
        PG8_WAIT_V(2); PG8_BAR;
        PG8_STAGE(PG8_SB(1, 0), cB + kstep, voffB); PG8_STAGE(PG8_SA(1, 0), cA + kstep, voffA); PG8_STAGE(PG8_SB(1, 1), cB + hstep + kstep, voffB);
        PG8_WAIT_V(6); PG8_BAR;
    } else {
        PG8_STAGE(PG8_SB(0, 0), cB, voffB); PG8_STAGE(PG8_SA(0, 0), cA, voffA); PG8_STAGE(PG8_SB(0, 1), cB + hstep, voffB); PG8_STAGE(PG8_SA(0, 1), cA + hstep, voffA);
        if (wr == 1) PG8_BAR;
        PG8_WAIT_V(4); PG8_BAR;
        PG8_STAGE(PG8_SB(1, 0), cB + kstep, voffB); PG8_STAGE(PG8_SA(1, 0), cA + kstep, voffA); PG8_STAGE(PG8_SB(1, 1), cB + hstep + kstep, voffB);
        PG8_WAIT_V(6); PG8_BAR;
    }
    for (;;) {
        const bool has_next = S.next(ui + 1, nxt);
        const char* nA = has_next ? (const char*)g.A + (size_t)nxt.pm * tstep : cA; const char* nB = has_next ? (const char*)g.Bt + (size_t)nxt.pn * tstep : cB;
        for (int t = 0; t < nt; t += 2) {
            if constexpr (Epi::MIDK) { if (t == (nt >> 1)) E.mid(acc, cur, wr, wc, fr, fq); }
            const bool last = (t == nt - 2);
            const char* a1 = cA + (size_t)(t + 1) * kstep;
            const char* a2 = last ? nA : cA + (size_t)(t + 2) * kstep; const char* b2 = last ? nB : cB + (size_t)(t + 2) * kstep;
            const char* a3 = a2 + kstep; const char* b3 = b2 + kstep;
            if (last && has_next) S.a_ready(nxt);
            if constexpr (SP2) {
            PG8_LDB(B0, 0, 0); PG8_LDB(B1, 0, 1); PG8_SCHED; PG8_LDA(At, 0, 0); PG8_STAGE(PG8_SA(1, 1), a1 + hstep, voffA);
            PG8_WAIT_V(8); PG8_WAIT_L(0); PG8_BAR; PG8_MMA(0, 0, At, B0); PG8_MMA(0, 1, At, B1); PG8_BAR; PG8_SCHED;
            PG8_LDA(At, 0, 1); PG8_STAGE(PG8_SB(0, 0), b2, voffB); PG8_STAGE(PG8_SB(0, 1), b2 + hstep, voffB); PG8_STAGE(PG8_SA(0, 0), a2, voffA);
            PG8_WAIT_V(8); PG8_WAIT_L(0); PG8_BAR; PG8_MMA(1, 0, At, B0); PG8_MMA(1, 1, At, B1); PG8_BAR; PG8_SCHED;
            PG8_LDB(B0, 1, 0); PG8_LDB(B1, 1, 1); PG8_SCHED; PG8_LDA(At, 1, 0); PG8_STAGE(PG8_SA(0, 1), a2 + hstep, voffA);
            PG8_WAIT_V(8); PG8_WAIT_L(0); PG8_BAR; PG8_MMA(0, 0, At, B0); PG8_MMA(0, 1, At, B1); PG8_BAR; PG8_SCHED;
            PG8_LDA(At, 1, 1); PG8_STAGE(PG8_SB(1, 0), b3, voffB); PG8_STAGE(PG8_SB(1, 1), b3 + hstep, voffB); PG8_STAGE(PG8_SA(1, 0), a3, voffA);
            PG8_WAIT_V(8); PG8_WAIT_L(0); PG8_BAR; PG8_MMA(1, 0, At, B0); PG8_MMA(1, 1, At, B1); PG8_BAR; PG8_SCHED;
            } else {
            PG8_LDB(B0, 0, 0); PG8_SCHED; PG8_LDA(At, 0, 0); PG8_STAGE(PG8_SA(1, 1), a1 + hstep, voffA);
            PG8_WAIT_L(8); PG8_BAR; PG8_WAIT_L(0); PG8_MMA(0, 0, At, B0); PG8_BAR; PG8_SCHED;
            PG8_LDB(B1, 0, 1); PG8_STAGE(PG8_SB(0, 0), b2, voffB);
            PG8_BAR; PG8_WAIT_L(0); PG8_MMA(0, 1, At, B1); PG8_BAR;
            PG8_LDA(At, 0, 1); PG8_STAGE(PG8_SA(0, 0), a2, voffA);
            PG8_BAR; PG8_WAIT_L(0); PG8_MMA(1, 0, At, B0); PG8_BAR; PG8_SCHED;
            PG8_STAGE(PG8_SB(0, 1), b2 + hstep, voffB);
            PG8_WAIT_V(6); PG8_BAR; PG8_MMA(1, 1, At, B1); PG8_BAR;
            PG8_LDB(B0, 1, 0); PG8_SCHED; PG8_LDA(At, 1, 0); PG8_STAGE(PG8_SA(0, 1), a2 + hstep, voffA);
            PG8_WAIT_L(8); PG8_BAR; PG8_WAIT_L(0); PG8_MMA(0, 0, At, B0); PG8_BAR; PG8_SCHED;
            PG8_LDB(B1, 1, 1); PG8_STAGE(PG8_SB(1, 0), b3, voffB);
            PG8_BAR; PG8_WAIT_L(0); PG8_MMA(0, 1, At, B1); PG8_BAR;
            PG8_LDA(At, 1, 1); PG8_STAGE(PG8_SA(1, 0), a3, voffA);
            PG8_BAR; PG8_WAIT_L(0); PG8_MMA(1, 0, At, B0); PG8_BAR; PG8_SCHED;
            PG8_STAGE(PG8_SB(1, 1), b3 + hstep, voffB);
            PG8_WAIT_V(6); PG8_BAR; PG8_MMA(1, 1, At, B1); PG8_BAR;
            }
        }
        if constexpr (ALIGN_EPI) { if (wr == 0) PG8_BAR; }
        if constexpr (!Epi::AFTER_DRAIN) { E(acc, cur, wr, wc, fr, fq); S.done(cur); }
        if (!has_next) break;
#pragma unroll
        for (int a = 0; a < 2; ++a)
#pragma unroll
            for (int b = 0; b < 2; ++b)
#pragma unroll
                for (int m = 0; m < 4; ++m)
#pragma unroll
                    for (int n = 0; n < 2; ++n) acc[a][b][m][n] = (f32x4){0.f, 0.f, 0.f, 0.f};
        cur = nxt; cA = nA; cB = nB; ++ui;
        if constexpr (ALIGN_EPI) { if (wr == 1) PG8_BAR; }
    }
    PG8_WAIT_V(0);
    if constexpr (!ALIGN_EPI) { if (wr == 0) PG8_BAR; }
    PG8_BAR;
    if constexpr (Epi::AFTER_DRAIN) { E.fused(acc, cur, wr, wc, fr, fq, lds, wid, lane); S.done(cur); }
#undef PG8_SA
#undef PG8_SB
#undef PG8_STAGE
#undef PG8_LDA
#undef PG8_LDB
#undef PG8_MMA
#undef PG8_WAIT_V
#undef PG8_WAIT_L
#undef PG8_BAR
#undef PG8_SCHED
}
}

#define LAS __attribute__((address_space(3)))
typedef unsigned short bf16;
typedef short bf16x8 __attribute__((ext_vector_type(8)));
typedef short s16x4 __attribute__((ext_vector_type(4)));
typedef float f32x4 __attribute__((ext_vector_type(4)));
typedef float f32x2 __attribute__((ext_vector_type(2)));
typedef float f32x16 __attribute__((ext_vector_type(16)));
typedef unsigned u32x4 __attribute__((ext_vector_type(4)));
typedef unsigned u32x2 __attribute__((ext_vector_type(2)));

constexpr int BATCH = 16, SEQ = 4096, DM = 1024, M = BATCH * SEQ, INW = 5120, DFF = 4096;
constexpr float QSCALE = 0.125f * 1.4426950408889634f;
constexpr size_t MiB = 1u << 20;
constexpr size_t WS_XN = 0, WS_QA = 128 * MiB, WS_KA = 192 * MiB, WS_VA = 256 * MiB, WS_QB = 320 * MiB, WS_KB = 384 * MiB, WS_VB = 448 * MiB;
constexpr size_t WS_SGA = 512 * MiB, WS_SGB = 640 * MiB, WS_AO2 = 768 * MiB, WS_ATTA = 832 * MiB, WS_ATTB = 896 * MiB;
constexpr size_t WS_WIN = 960 * MiB, WS_WA = 970 * MiB, WS_WB = 971 * MiB, WS_WOUT = 972 * MiB, WS_W1 = 974 * MiB, WS_W2 = 982 * MiB;
constexpr size_t WS_LSE = 990 * MiB, WS_SSQ1 = 996 * MiB, WS_SSQ2 = 1000 * MiB, WS_ROPE = 1004 * MiB, WS_CTL = 1005 * MiB, WS_END = 1006 * MiB;
constexpr size_t WS_AO0 = 0, WS_AO1 = 64 * MiB, WS_MERGED = 0, WS_X1B = WS_SGA, WS_H = 0;
constexpr int LDS_BYTES = 152576;
constexpr int NPHASE = 10;

#define MFMA32(a, b, c) __builtin_amdgcn_mfma_f32_32x32x16_bf16((a), (b), (c), 0, 0, 0)
__device__ __forceinline__ int crow(int r, int hi) { return (r & 3) + 8 * (r >> 2) + 4 * hi; }
typedef __bf16 bf16x2_t __attribute__((ext_vector_type(2)));
__device__ __forceinline__ unsigned pk2(float lo, float hi) { f32x2 v = {lo, hi}; bf16x2_t b = __builtin_convertvector(v, bf16x2_t); return __builtin_bit_cast(unsigned, b); }
__device__ __forceinline__ float bflo(unsigned w) { return __uint_as_float(w << 16); }
__device__ __forceinline__ float bfhi(unsigned w) { return __uint_as_float(w & 0xffff0000u); }
__device__ __forceinline__ float wave_sum(float v) {
#pragma unroll
    for (int o = 1; o < 64; o <<= 1) v += __shfl_xor(v, o);
    return v;
}
__device__ __forceinline__ s16x4 vtr(const LAS unsigned char* p) {
    typedef short v4i16_t __attribute__((ext_vector_type(4)));
    return __builtin_bit_cast(s16x4, __builtin_amdgcn_ds_read_tr16_b64_v4i16((LAS v4i16_t*)p));
}
__device__ __forceinline__ bf16x8 cat8(s16x4 lo, s16x4 hi) { return (bf16x8){lo[0], lo[1], lo[2], lo[3], hi[0], hi[1], hi[2], hi[3]}; }
__device__ __forceinline__ bf16x8 pack8(const f32x16& x, int s) {
    u32x4 p; p.x = pk2(x[8 * s], x[8 * s + 1]); p.y = pk2(x[8 * s + 2], x[8 * s + 3]); p.z = pk2(x[8 * s + 4], x[8 * s + 5]); p.w = pk2(x[8 * s + 6], x[8 * s + 7]);
    return __builtin_bit_cast(bf16x8, p);
}
__device__ __forceinline__ float xhalf(float v) { return __shfl_xor(v, 32); }

struct Args {
    const float* x; const float* w_in; const float* w_a; const float* w_b; const float* w_out;
    const float* lq1; const float* lk1; const float* lq2; const float* lk2; const float* subln_g;
    const float* g_mix; const float* g_mlp; const float* w_ff1; const float* w_ff2; const float* g_final;
    float* out; unsigned char* ws; int ph_lo, ph_hi;
};

__device__ __forceinline__ void p0_transpose_item(const float* W, int K, int N, bf16* WT, const float* g, bool perm, LAS float* scr, int item, int lane, int pitch = 0) {
    if (pitch == 0) pitch = K;
    const int nblk = N / 32, kb = item / nblk, nb = item % nblk, k0 = 64 * kb, n0 = 32 * nb, l = lane & 31;
    int sc = n0 + l;
    if (perm) sc = (n0 & ~255) + 64 * ((n0 >> 5) & 3) + 32 * ((n0 >> 7) & 1) + l;
#pragma unroll 8
    for (int i = 0; i < 32; ++i) { const int kk = 2 * i + (lane >> 5); float v = W[(size_t)(k0 + kk) * N + sc]; if (g) v *= g[k0 + kk]; scr[kk * 33 + l] = v; }
    asm volatile("s_waitcnt lgkmcnt(0)" ::: "memory");
    const int c = lane & 7;
#pragma unroll
    for (int j = 0; j < 4; ++j) { const int n = (lane >> 3) + 8 * j; const LAS float* s = scr + (8 * c) * 33 + n;
        u32x4 o; o.x = pk2(s[0 * 33], s[1 * 33]); o.y = pk2(s[2 * 33], s[3 * 33]); o.z = pk2(s[4 * 33], s[5 * 33]); o.w = pk2(s[6 * 33], s[7 * 33]);
        *(u32x4*)(WT + (size_t)(n0 + n) * pitch + k0 + 8 * c) = o; }
    asm volatile("s_waitcnt lgkmcnt(0)" ::: "memory");
}
__device__ __forceinline__ void p0_prologue(const Args& A, LAS unsigned char* lds, int vcu, int G) {
    const int tid = threadIdx.x, lane = tid & 63, wave = tid >> 6;
    unsigned char* ws = A.ws;
    LAS float* scr = (LAS float*)(lds + wave * 8704);
    const int gw = vcu * 8 + wave, NGW = G * 8;
    constexpr int I_IN = 16 * 160, I_A = 8 * 32, I_B = 8 * 32, I_O = 16 * 32, I_1 = 16 * 128, I_2 = 64 * 32, NITEMS = I_IN + I_A + I_B + I_O + I_1 + I_2;
    for (int it = gw; it < NITEMS; it += NGW) {
        int r = it;
        if (r < I_IN) { const int n0 = 32 * (r % 160); const bool perm = (n0 < 1024) || (n0 >= 1536 && n0 < 2560);
            p0_transpose_item(A.w_in, 1024, INW, (bf16*)(ws + WS_WIN), nullptr, perm, scr, r, lane); continue; } r -= I_IN;
        if (r < I_A) { p0_transpose_item(A.w_a, 512, 1024, (bf16*)(ws + WS_WA), nullptr, false, scr, r, lane, 1024); continue; } r -= I_A;
        if (r < I_B) { p0_transpose_item(A.w_b, 512, 1024, (bf16*)(ws + WS_WA) + 512, nullptr, false, scr, r, lane, 1024); continue; } r -= I_B;
        if (r < I_O) { p0_transpose_item(A.w_out, 1024, 1024, (bf16*)(ws + WS_WOUT), nullptr, false, scr, r, lane); continue; } r -= I_O;
        if (r < I_1) { p0_transpose_item(A.w_ff1, 1024, DFF, (bf16*)(ws + WS_W1), A.g_mlp, false, scr, r, lane); continue; } r -= I_1;
        p0_transpose_item(A.w_ff2, DFF, 1024, (bf16*)(ws + WS_W2), nullptr, false, scr, r, lane);
    }
    for (int idx = (vcu * 512 + tid); idx < SEQ * 32; idx += G * 512) {
        const int pos = idx >> 5, i = idx & 31;
        const float inv = powf(10000.0f, -(float)(2 * i) / 64.0f);
        const float ang = (float)pos * inv;
        const double a = (double)ang;
        const double kq = rint(a * 0.63661977236758134308);
        const double r = fma(-kq, 1.57079632679489661923, a);
        const double r2 = r * r;
        double sp = 1.0 / 6227020800.0; sp = sp * r2 - 1.0 / 39916800.0; sp = sp * r2 + 1.0 / 362880.0; sp = sp * r2 - 1.0 / 5040.0; sp = sp * r2 + 1.0 / 120.0; sp = sp * r2 - 1.0 / 6.0; sp = sp * r2 + 1.0; sp *= r;
        double cp = 1.0 / 479001600.0; cp = cp * r2 - 1.0 / 3628800.0; cp = cp * r2 + 1.0 / 40320.0; cp = cp * r2 - 1.0 / 720.0; cp = cp * r2 + 1.0 / 24.0; cp = cp * r2 - 0.5; cp = cp * r2 + 1.0;
        const int q = ((int)kq) & 3;
        const double sv = (q == 0) ? sp : (q == 1) ? cp : (q == 2) ? -sp : -cp;
        const double cv = (q == 0) ? cp : (q == 1) ? -sp : (q == 2) ? -cp : sp;
        ((f32x2*)(ws + WS_ROPE))[idx] = (f32x2){(float)cv, (float)sv};
    }
    bf16* XN = (bf16*)(ws + WS_XN);
    f32x4 gv[4];
#pragma unroll
    for (int j = 0; j < 4; ++j) gv[j] = ((const f32x4*)A.g_mix)[lane + 64 * j];
    for (int m = gw; m < M; m += NGW) {
        const f32x4* xr = (const f32x4*)(A.x + (size_t)m * DM) + lane;
        f32x4 v[4]; float s = 0.f;
#pragma unroll
        for (int j = 0; j < 4; ++j) { v[j] = xr[64 * j]; s += (v[j].x * v[j].x + v[j].y * v[j].y) + (v[j].z * v[j].z + v[j].w * v[j].w); }
        const float rstd = 1.0f / sqrtf(wave_sum(s) * (1.0f / DM) + 1e-6f);
        u32x2* o8 = (u32x2*)(XN + (size_t)m * DM) + lane;
#pragma unroll
        for (int j = 0; j < 4; ++j) { u32x2 w; w.x = pk2(v[j].x * rstd * gv[j].x, v[j].y * rstd * gv[j].y); w.y = pk2(v[j].z * rstd * gv[j].z, v[j].w * rstd * gv[j].w); o8[64 * j] = w; }
    }
}

struct EpiIn {
    static constexpr bool PERM = true, AFTER_DRAIN = false, MIDK = false;
    unsigned char* ws;
    __device__ __forceinline__ void operator()(const f32x4 (&acc)[2][2][4][2], const pg8::Unit& u, int wr, int wc, int fr, int fq) const {
        const int pn = u.pn, row0 = u.pm * 256 + wr * 64 + fr;
        if (pn >= 12) {
            unsigned char* dst = (unsigned char*)(ws + (pn >= 16 ? WS_SGB : WS_SGA)); const int colt = ((pn - 12) & 3) * 256 + wc * 32 + 8 * fq;
#pragma unroll
            for (int ai = 0; ai < 2; ++ai)
#pragma unroll
                for (int m = 0; m < 4; ++m) { unsigned char* rp = dst + (size_t)(row0 + ai * 128 + m * 16) * 1024 + colt;
#pragma unroll
                    for (int bj = 0; bj < 2; ++bj) { float sg[8];
#pragma unroll
                        for (int j = 0; j < 8; ++j) sg[j] = fmaxf(255.0f * __builtin_amdgcn_rcpf(1.0f + __builtin_amdgcn_exp2f(-1.4426950408889634f * acc[ai][bj][m][j >> 2][j & 3])), 1.0f);
                        u32x2 w; w.x = 0u; w.y = 0u;
                        w.x = __builtin_amdgcn_cvt_pk_u8_f32(sg[0], 0, w.x); w.x = __builtin_amdgcn_cvt_pk_u8_f32(sg[1], 1, w.x); w.x = __builtin_amdgcn_cvt_pk_u8_f32(sg[2], 2, w.x); w.x = __builtin_amdgcn_cvt_pk_u8_f32(sg[3], 3, w.x);
                        w.y = __builtin_amdgcn_cvt_pk_u8_f32(sg[4], 0, w.y); w.y = __builtin_amdgcn_cvt_pk_u8_f32(sg[5], 1, w.y); w.y = __builtin_amdgcn_cvt_pk_u8_f32(sg[6], 2, w.y); w.y = __builtin_amdgcn_cvt_pk_u8_f32(sg[7], 3, w.y);
                        *(u32x2*)(rp + bj * 128) = w; } }
        } else {
            const int reg = pn >> 1;
            bf16* dst = (bf16*)(ws + WS_QA + (size_t)reg * 64 * MiB);
            if (reg == 2 || reg == 5) {
                const int colt = (pn & 1) * 256 + wc * 32 + 8 * fq;
#pragma unroll
                for (int ai = 0; ai < 2; ++ai)
#pragma unroll
                    for (int m = 0; m < 4; ++m) { bf16* rp = dst + (size_t)(row0 + ai * 128 + m * 16) * 512 + colt;
#pragma unroll
                        for (int bj = 0; bj < 2; ++bj) { const f32x4 v0 = acc[ai][bj][m][0], v1 = acc[ai][bj][m][1];
                            u32x4 w; w.x = pk2(v0[0], v0[1]); w.y = pk2(v0[2], v0[3]); w.z = pk2(v1[0], v1[1]); w.w = pk2(v1[2], v1[3]); *(u32x4*)(rp + bj * 128) = w; } }
            } else {
                const float sc = (reg == 0 || reg == 3) ? QSCALE : 1.0f;
                const f32x4* rope = (const f32x4*)(ws + WS_ROPE);
                const int head = 4 * (pn & 1) + wc;
#pragma unroll
                for (int ai = 0; ai < 2; ++ai)
#pragma unroll
                    for (int m = 0; m < 4; ++m) { const int row = row0 + ai * 128 + m * 16, pos = row & (SEQ - 1);
                        const f32x4* tp = rope + ((pos * 32 + 8 * fq) >> 1);
                        const f32x4 t0 = tp[0], t1 = tp[1], t2 = tp[2], t3 = tp[3];
                        const float cs[8] = {t0[0], t0[2], t1[0], t1[2], t2[0], t2[2], t3[0], t3[2]}, sn[8] = {t0[1], t0[3], t1[1], t1[3], t2[1], t2[3], t3[1], t3[3]};
                        float o1[8], o2[8];
#pragma unroll
                        for (int j = 0; j < 8; ++j) { const float x1 = acc[ai][0][m][j >> 2][j & 3], x2 = acc[ai][1][m][j >> 2][j & 3];
                            o1[j] = (x1 * cs[j] - x2 * sn[j]) * sc; o2[j] = (x2 * cs[j] + x1 * sn[j]) * sc; }
                        bf16* rp = dst + (size_t)row * 512 + head * 64 + 8 * fq;
                        u32x4 w1, w2; w1.x = pk2(o1[0], o1[1]); w1.y = pk2(o1[2], o1[3]); w1.z = pk2(o1[4], o1[5]); w1.w = pk2(o1[6], o1[7]);
                        w2.x = pk2(o2[0], o2[1]); w2.y = pk2(o2[2], o2[3]); w2.z = pk2(o2[4], o2[5]); w2.w = pk2(o2[6], o2[7]);
                        *(u32x4*)rp = w1; *(u32x4*)(rp + 32) = w2; }
            }
        }
    }
};
__device__ __forceinline__ void unpack8(const u32x4 g, float (&f)[8]) { f[0] = bflo(g.x); f[1] = bfhi(g.x); f[2] = bflo(g.y); f[3] = bfhi(g.y); f[4] = bflo(g.z); f[5] = bfhi(g.z); f[6] = bflo(g.w); f[7] = bfhi(g.w); }
template <int PASS> struct EpiGate {
    static constexpr bool PERM = true, AFTER_DRAIN = false, MIDK = false;
    const bf16* SG; bf16* MG;
    __device__ __forceinline__ void operator()(const f32x4 (&acc)[2][2][4][2], const pg8::Unit& u, int wr, int wc, int fr, int fq) const {
        const int row0 = u.pm * 256 + wr * 64 + fr, col0 = u.pn * 256 + wc * 32 + 8 * fq;
#pragma unroll
        for (int ai = 0; ai < 2; ++ai)
#pragma unroll
            for (int m = 0; m < 4; ++m) { const size_t off = (size_t)(row0 + ai * 128 + m * 16) * 1024 + col0;
#pragma unroll
                for (int bj = 0; bj < 2; ++bj) { const size_t o = off + bj * 128; const f32x4 v0 = acc[ai][bj][m][0], v1 = acc[ai][bj][m][1];
                    float g[8]; unpack8(*(const u32x4*)(SG + o), g);
                    float r[8] = {v0[0] * g[0], v0[1] * g[1], v0[2] * g[2], v0[3] * g[3], v1[0] * g[4], v1[1] * g[5], v1[2] * g[6], v1[3] * g[7]};
                    if (PASS == 1) { float p[8]; unpack8(*(const u32x4*)(MG + o), p);
#pragma unroll
                        for (int j = 0; j < 8; ++j) r[j] += p[j]; }
                    u32x4 w; w.x = pk2(r[0], r[1]); w.y = pk2(r[2], r[3]); w.z = pk2(r[4], r[5]); w.w = pk2(r[6], r[7]); *(u32x4*)(MG + o) = w; } }
    }
};
__device__ __forceinline__ void unpack8u(const u32x2 g, float (&f)[8]) {
    f[0] = (float)(g.x & 0xffu); f[1] = (float)((g.x >> 8) & 0xffu); f[2] = (float)((g.x >> 16) & 0xffu); f[3] = (float)(g.x >> 24);
    f[4] = (float)(g.y & 0xffu); f[5] = (float)((g.y >> 8) & 0xffu); f[6] = (float)((g.y >> 16) & 0xffu); f[7] = (float)(g.y >> 24);
}
struct EpiGate2 {
    static constexpr bool PERM = true, AFTER_DRAIN = false, MIDK = true;
    const unsigned char* SGA_; const unsigned char* SGB_; bf16* MG;
    __device__ __forceinline__ void mid(f32x4 (&acc)[2][2][4][2], const pg8::Unit& u, int wr, int wc, int fr, int fq) const {
        int row0 = u.pm * 256 + wr * 64 + fr, col0 = u.pn * 256 + wc * 32 + 8 * fq;
        asm volatile("" : "+v"(row0), "+v"(col0));
#pragma unroll
        for (int ai = 0; ai < 2; ++ai)
#pragma unroll
            for (int m = 0; m < 4; ++m) { const size_t off = (size_t)(row0 + ai * 128 + m * 16) * 1024 + col0;
#pragma unroll
                for (int bj = 0; bj < 2; ++bj) { const size_t o = off + bj * 128; float ga[8], gb[8]; unpack8u(*(const u32x2*)(SGA_ + o), ga); unpack8u(*(const u32x2*)(SGB_ + o), gb);
#pragma unroll
                    for (int j = 0; j < 8; ++j) acc[ai][bj][m][j >> 2][j & 3] *= ga[j] * __builtin_amdgcn_rcpf(gb[j]);
                    asm volatile("" ::: "memory"); } }
    }
    __device__ __forceinline__ void operator()(const f32x4 (&acc)[2][2][4][2], const pg8::Unit& u, int wr, int wc, int fr, int fq) const {
        const int row0 = u.pm * 256 + wr * 64 + fr, col0 = u.pn * 256 + wc * 32 + 8 * fq;
#pragma unroll
        for (int ai = 0; ai < 2; ++ai)
#pragma unroll
            for (int m = 0; m < 4; ++m) { const size_t off = (size_t)(row0 + ai * 128 + m * 16) * 1024 + col0;
#pragma unroll
                for (int bj = 0; bj < 2; ++bj) { const size_t o = off + bj * 128; const f32x4 v0 = acc[ai][bj][m][0] * (1.0f / 255.0f), v1 = acc[ai][bj][m][1] * (1.0f / 255.0f);
                    float g[8]; unpack8u(*(const u32x2*)(SGB_ + o), g);
                    u32x4 w; w.x = pk2(v0[0] * g[0], v0[1] * g[1]); w.y = pk2(v0[2] * g[2], v0[3] * g[3]); w.z = pk2(v1[0] * g[4], v1[1] * g[5]); w.w = pk2(v1[2] * g[6], v1[3] * g[7]); *(u32x4*)(MG + o) = w; } }
    }
};
struct EpiRes1 {
    static constexpr bool PERM = true, AFTER_DRAIN = false, MIDK = false;
    const float* xi; bf16* xb; float* ssq;
    __device__ __forceinline__ void operator()(const f32x4 (&acc)[2][2][4][2], const pg8::Unit& u, int wr, int wc, int fr, int fq) const {
        const int row0 = u.pm * 256 + wr * 64 + fr, col0 = u.pn * 256 + wc * 32 + 8 * fq;
#pragma unroll
        for (int ai = 0; ai < 2; ++ai)
#pragma unroll
            for (int m = 0; m < 4; ++m) { const int row = row0 + ai * 128 + m * 16; const size_t off = (size_t)row * 1024 + col0; float ss = 0.f;
#pragma unroll
                for (int bj = 0; bj < 2; ++bj) { const size_t o = off + bj * 128;
                    const f32x4 v0 = *(const f32x4*)(xi + o) + acc[ai][bj][m][0], v1 = *(const f32x4*)(xi + o + 4) + acc[ai][bj][m][1];
                    ss += (v0[0] * v0[0] + v0[1] * v0[1]) + (v0[2] * v0[2] + v0[3] * v0[3]) + (v1[0] * v1[0] + v1[1] * v1[1]) + (v1[2] * v1[2] + v1[3] * v1[3]);
                    u32x4 w; w.x = pk2(v0[0], v0[1]); w.y = pk2(v0[2], v0[3]); w.z = pk2(v1[0], v1[1]); w.w = pk2(v1[2], v1[3]); *(u32x4*)(xb + o) = w; }
                ss += __shfl_xor(ss, 16); ss += __shfl_xor(ss, 32);
                if (fq == 0) ssq[(size_t)row * 16 + u.pn * 4 + wc] = ss; }
    }
};
struct EpiFF1 {
    static constexpr bool PERM = true, AFTER_DRAIN = false, MIDK = false;
    bf16* H;
    __device__ __forceinline__ void operator()(const f32x4 (&acc)[2][2][4][2], const pg8::Unit& u, int wr, int wc, int fr, int fq) const {
        const int row0 = u.pm * 256 + wr * 64 + fr, col0 = u.pn * 256 + wc * 32 + 8 * fq;
#pragma unroll
        for (int ai = 0; ai < 2; ++ai)
#pragma unroll
            for (int m = 0; m < 4; ++m) { bf16* rp = H + (size_t)(row0 + ai * 128 + m * 16) * DFF + col0;
#pragma unroll
                for (int bj = 0; bj < 2; ++bj) { f32x4 v0 = acc[ai][bj][m][0], v1 = acc[ai][bj][m][1];
#pragma unroll
                    for (int j = 0; j < 4; ++j) { const float t0 = fmaxf(v0[j], 0.f), t1 = fmaxf(v1[j], 0.f); v0[j] = t0 * t0; v1[j] = t1 * t1; }
                    u32x4 w; w.x = pk2(v0[0], v0[1]); w.y = pk2(v0[2], v0[3]); w.z = pk2(v1[0], v1[1]); w.w = pk2(v1[2], v1[3]); *(u32x4*)(rp + bj * 128) = w; } }
    }
};
struct EpiRes2 {
    static constexpr bool PERM = true, AFTER_DRAIN = false, MIDK = false;
    const bf16* xb; const float* ssq1; float* xo; float* ssq2;
    __device__ __forceinline__ void operator()(const f32x4 (&acc)[2][2][4][2], const pg8::Unit& u, int wr, int wc, int fr, int fq) const {
        const int row0 = u.pm * 256 + wr * 64 + fr, col0 = u.pn * 256 + wc * 32 + 8 * fq;
#pragma unroll
        for (int ai = 0; ai < 2; ++ai)
#pragma unroll
            for (int m = 0; m < 4; ++m) { const int row = row0 + ai * 128 + m * 16; const size_t off = (size_t)row * 1024 + col0;
                const f32x4 pt = *(const f32x4*)(ssq1 + (size_t)row * 16 + 4 * fq); float s = (pt[0] + pt[1]) + (pt[2] + pt[3]);
                s += __shfl_xor(s, 16); s += __shfl_xor(s, 32);
                const float r2 = 1.0f / (s * (1.0f / DM) + 1e-6f);
                float ss = 0.f;
#pragma unroll
                for (int bj = 0; bj < 2; ++bj) { const size_t o = off + bj * 128; float x1[8]; unpack8(*(const u32x4*)(xb + o), x1);
                    const f32x4 a0 = acc[ai][bj][m][0], a1 = acc[ai][bj][m][1];
                    const f32x4 v0 = {x1[0] + r2 * a0[0], x1[1] + r2 * a0[1], x1[2] + r2 * a0[2], x1[3] + r2 * a0[3]}, v1 = {x1[4] + r2 * a1[0], x1[5] + r2 * a1[1], x1[6] + r2 * a1[2], x1[7] + r2 * a1[3]};
                    ss += (v0[0] * v0[0] + v0[1] * v0[1]) + (v0[2] * v0[2] + v0[3] * v0[3]) + (v1[0] * v1[0] + v1[1] * v1[1]) + (v1[2] * v1[2] + v1[3] * v1[3]);
                    *(f32x4*)(xo + o) = v0; *(f32x4*)(xo + o + 4) = v1; }
                ss += __shfl_xor(ss, 16); ss += __shfl_xor(ss, 32);
                if (fq == 0) ssq2[(size_t)row * 16 + u.pn * 4 + wc] = ss; }
    }
};

struct EpiFinal {
    static constexpr bool PERM = true, AFTER_DRAIN = false, MIDK = false;
    const bf16* xb; const float* ssq1; float* out; const float* gfin; float* slot; unsigned* cnt; LAS unsigned char* xl;
    __device__ __forceinline__ void operator()(const f32x4 (&acc_)[2][2][4][2], const pg8::Unit& u, int wr, int wc, int fr, int fq) const {
        f32x4 (&acc)[2][2][4][2] = const_cast<f32x4 (&)[2][2][4][2]>(acc_);
        const int tid = threadIdx.x, lane = tid & 63, wid = tid >> 6;
        const int row0 = u.pm * 256 + wr * 64 + fr, col0 = u.pn * 256 + wc * 32 + 8 * fq;
        LAS float* P = (LAS float*)xl; LAS float* S = (LAS float*)(xl + 4096); LAS unsigned* flag = (LAS unsigned*)(xl + 5120);
#pragma unroll
        for (int ai = 0; ai < 2; ++ai)
#pragma unroll
            for (int m = 0; m < 4; ++m) { const int rl = ai * 128 + wr * 64 + m * 16 + fr, row = u.pm * 256 + rl;
                const f32x4 pt = *(const f32x4*)(ssq1 + (size_t)row * 16 + 4 * fq); float s = (pt[0] + pt[1]) + (pt[2] + pt[3]);
                s += __shfl_xor(s, 16); s += __shfl_xor(s, 32);
                const float r2 = 1.0f / (s * (1.0f / DM) + 1e-6f);
                float ss = 0.f;
#pragma unroll
                for (int bj = 0; bj < 2; ++bj) { float x1[8]; unpack8(*(const u32x4*)(xb + (size_t)row * 1024 + col0 + bj * 128), x1);
#pragma unroll
                    for (int j = 0; j < 8; ++j) { const float v = x1[j] + r2 * acc[ai][bj][m][j >> 2][j & 3]; acc[ai][bj][m][j >> 2][j & 3] = v; ss += v * v; } }
                ss += __shfl_xor(ss, 16); ss += __shfl_xor(ss, 32);
                if (fq == 0) P[rl * 4 + wc] = ss; }
        asm volatile("s_waitcnt lgkmcnt(0)" ::: "memory"); __builtin_amdgcn_s_barrier(); asm volatile("" ::: "memory");
        const int prow = wid * 32 + (lane & 31);
        if (lane < 32) { const float t = (P[prow * 4 + 0] + P[prow * 4 + 1]) + (P[prow * 4 + 2] + P[prow * 4 + 3]);
            __hip_atomic_store(slot + ((size_t)(u.pm * 256 + prow) * 4 + u.pn), t, __ATOMIC_RELAXED, __HIP_MEMORY_SCOPE_AGENT); }
        asm volatile("s_waitcnt vmcnt(0)" ::: "memory");
        if (lane == 0) __hip_atomic_fetch_add(cnt + 64 * u.pm, 1u, __ATOMIC_RELAXED, __HIP_MEMORY_SCOPE_AGENT);
        if (wid == 0) { unsigned sp = 0;
            while ((unsigned)__builtin_amdgcn_readfirstlane(__hip_atomic_load(cnt + 64 * u.pm, __ATOMIC_RELAXED, __HIP_MEMORY_SCOPE_AGENT)) < 32u) { __builtin_amdgcn_s_sleep(2); if (++sp > (1u << 12)) break; }
            __builtin_amdgcn_fence(__ATOMIC_ACQUIRE, "agent");
            if (lane == 0) flag[0] = 1u; }
        asm volatile("s_waitcnt vmcnt(0) lgkmcnt(0)" ::: "memory"); __builtin_amdgcn_s_barrier(); asm volatile("" ::: "memory");
        if (lane < 32) { const float* sl = slot + (size_t)(u.pm * 256 + prow) * 4; float t = 0.f;
#pragma unroll
            for (int k = 0; k < 4; ++k) t += __hip_atomic_load(sl + k, __ATOMIC_RELAXED, __HIP_MEMORY_SCOPE_AGENT);
            S[prow] = 1.0f / sqrtf(t * (1.0f / DM) + 1e-6f); }
        asm volatile("s_waitcnt vmcnt(0) lgkmcnt(0)" ::: "memory"); __builtin_amdgcn_s_barrier(); asm volatile("" ::: "memory");
#pragma unroll
        for (int bj = 0; bj < 2; ++bj) { const f32x4 g0 = *(const f32x4*)(gfin + col0 + bj * 128), g1 = *(const f32x4*)(gfin + col0 + bj * 128 + 4);
#pragma unroll
            for (int ai = 0; ai < 2; ++ai)
#pragma unroll
                for (int m = 0; m < 4; ++m) { const int rl = ai * 128 + wr * 64 + m * 16 + fr; const float rs = S[rl];
                    float* o = out + (size_t)(u.pm * 256 + rl) * 1024 + col0 + bj * 128;
                    *(f32x4*)o = acc[ai][bj][m][0] * rs * g0; *(f32x4*)(o + 4) = acc[ai][bj][m][1] * rs * g1; } }
        asm volatile("s_waitcnt lgkmcnt(0)" ::: "memory"); __builtin_amdgcn_s_barrier(); asm volatile("" ::: "memory");
    }
};

constexpr int AK_CH = 384 * 16 + 16, AV_DB = 384 * 64 + 64, AV_OFF = 8 * AK_CH, AV_BUF = 2 * AV_DB;
#define GLDS16(gsrc, ldst) do { unsigned keep_; asm volatile("s_mov_b32 %0, m0\n\ts_mov_b32 m0, %2\n\ts_nop 0\n\tglobal_load_lds_dwordx4 %1, off\n\ts_mov_b32 m0, %0" : "=&s"(keep_) : "v"(gsrc), "s"((unsigned)__builtin_amdgcn_readfirstlane(ldst)) : "memory"); } while (0)
struct AUnit { int p, sh, ls, ph, t0, head; size_t rowb; };
__device__ __forceinline__ AUnit attnA_decode(int unit) {
    AUnit a; const int u16 = unit & 15; a.p = (unit >> 4) % 3; a.head = (unit / 48) & 7; a.rowb = (size_t)(unit / 384) * SEQ;
    a.sh = 2 * a.p; a.ls = SEQ >> a.sh; a.ph = u16 & ((1 << a.sh) - 1); a.t0 = 256 * (u16 >> a.sh); return a;
}
__device__ __forceinline__ void attnA_dma(LAS unsigned char* lds, const unsigned char* ws, int unit, int vbuf, int wid, int lane) {
    const AUnit a = attnA_decode(unit);
    const bf16* KA = (const bf16*)(ws + WS_KA); const bf16* VA = (const bf16*)(ws + WS_VA);
    const unsigned ldsb = (unsigned)(unsigned long)lds;
#pragma unroll
    for (int k = 0; k < 6; ++k) { const int idx = wid * 6 + k, lr = 8 * idx + (lane >> 3); int t = a.t0 - 64 + lr; t = t < 0 ? 0 : (t > a.ls - 1 ? a.ls - 1 : t);
        const bf16* g = KA + (a.rowb + ((size_t)t << a.sh) + a.ph) * 512 + a.head * 64 + (((lane & 7) ^ ((lr >> 1) & 7)) * 8); GLDS16(g, ldsb + idx * 1024); }
#pragma unroll
    for (int k = 0; k < 6; ++k) { const int idx = wid * 6 + k, dblk = idx / 24, rg = idx % 24; int t = a.t0 - 64 + rg * 16 + (lane >> 2); t = t < 0 ? 0 : (t > a.ls - 1 ? a.ls - 1 : t);
        const bf16* g = VA + (a.rowb + ((size_t)t << a.sh) + a.ph) * 512 + a.head * 64 + dblk * 32 + (lane & 3) * 8; GLDS16(g, ldsb + vbuf + dblk * AV_DB + rg * 1024); }
}
__device__ __forceinline__ void attnA_phase(LAS unsigned char* lds, const unsigned char* ws, int vcu, int G) {
    const int tid = threadIdx.x, lane = tid & 63, w = __builtin_amdgcn_readfirstlane(tid >> 6), r = lane & 31, h = lane >> 5;
    constexpr int NU = BATCH * 8 * 3 * 16;
    const bf16* QA = (const bf16*)(ws + WS_QA);
    if (vcu < NU) attnA_dma(lds, ws, vcu, AV_OFF, w, lane);
    int it = 0;
    bf16x8 qn[4];
    if (vcu < NU) { const AUnit a = attnA_decode(vcu); const size_t qr = a.rowb + ((size_t)(a.t0 + 32 * w + r) << a.sh) + a.ph;
#pragma unroll
        for (int ks = 0; ks < 4; ++ks) qn[ks] = *(const bf16x8*)(QA + qr * 512 + a.head * 64 + 16 * ks + 8 * h); }
    for (int unit = vcu; unit < NU; unit += G, ++it) {
        const AUnit a = attnA_decode(unit);
        const int vbuf = AV_OFF + (it & 1) * AV_BUF;
        bf16* AO = (bf16*)(ws + (a.p == 0 ? WS_AO0 : a.p == 1 ? WS_AO1 : WS_AO2)); float* LSE = (float*)(ws + WS_LSE) + (size_t)a.p * M * 8;
        const int tq = a.t0 + 32 * w + r; const size_t qrow = a.rowb + ((size_t)tq << a.sh) + a.ph;
        bf16x8 qf[4];
#pragma unroll
        for (int ks = 0; ks < 4; ++ks) qf[ks] = qn[ks];
        asm volatile("s_waitcnt vmcnt(0)" ::: "memory");
        __syncthreads();
        f32x16 s[5];
        {
            bf16x8 kf[2][4];
            const LAS unsigned char* kp = lds + (32 * w + r) * 128;
            int kx[4];
#pragma unroll
            for (int ks = 0; ks < 4; ++ks) kx[ks] = ((2 * ks + h) ^ ((r >> 1) & 7)) * 16;
#pragma unroll
            for (int ks = 0; ks < 4; ++ks) kf[0][ks] = *(const LAS bf16x8*)(kp + kx[ks]);
#pragma unroll
            for (int j = 0; j < 5; ++j) {
                if (j + 1 < 5) {
#pragma unroll
                    for (int ks = 0; ks < 4; ++ks) kf[(j + 1) & 1][ks] = *(const LAS bf16x8*)(kp + kx[ks] + (j + 1) * 4096); }
                __builtin_amdgcn_sched_barrier(0);
                f32x16 acc = {};
#pragma unroll
                for (int ks = 0; ks < 4; ++ks) acc = MFMA32(kf[j & 1][ks], qf[ks], acc);
                s[j] = acc;
                __builtin_amdgcn_sched_barrier(0);
            }
        }
        __syncthreads();
        if (unit + G < NU) { attnA_dma(lds, ws, unit + G, AV_OFF + ((it + 1) & 1) * AV_BUF, w, lane);
            const AUnit an = attnA_decode(unit + G); const size_t qr = an.rowb + ((size_t)(an.t0 + 32 * w + r) << an.sh) + an.ph;
#pragma unroll
            for (int ks = 0; ks < 4; ++ks) qn[ks] = *(const bf16x8*)(QA + qr * 512 + an.head * 64 + 16 * ks + 8 * h); }
        float mx = -INFINITY;
        if ((a.t0 - 64 + 32 * w >= 0) && (a.t0 + 32 * w + 96 <= a.ls)) {
#pragma unroll
            for (int i = 0; i < 16; ++i) { const int cr = crow(i, h);
                s[0][i] = (cr >= r) ? s[0][i] : -INFINITY; s[4][i] = (cr <= r) ? s[4][i] : -INFINITY; }
#pragma unroll
            for (int j = 0; j < 5; ++j)
#pragma unroll
                for (int i = 0; i < 16; ++i) mx = fmaxf(mx, s[j][i]);
        } else {
#pragma unroll
            for (int j = 0; j < 5; ++j)
#pragma unroll
                for (int i = 0; i < 16; ++i) { const int cr = crow(i, h), rel = 32 * j + cr - 64 - r, tk = a.t0 - 64 + 32 * w + 32 * j + cr;
                    const bool valid = (rel >= -64) && (rel <= 64) && (tk >= 0) && (tk < a.ls);
                    const float v = valid ? s[j][i] : -INFINITY; s[j][i] = v; mx = fmaxf(mx, v); }
        }
        mx = fmaxf(mx, xhalf(mx));
        float l = 0.f;
#pragma unroll
        for (int j = 0; j < 5; ++j)
#pragma unroll
            for (int i = 0; i < 16; ++i) { const float e = __builtin_amdgcn_exp2f(s[j][i] - mx); s[j][i] = e; l += e; }
        l += xhalf(l);
        f32x16 o[2] = {};
        const int i16 = lane & 15, qd = i16 >> 2, pp = i16 & 3, blk = (lane >> 4) & 1;
        const LAS unsigned char* vb = lds + vbuf + (32 * w + 4 * h + qd) * 64 + blk * 32 + pp * 8;
#pragma unroll
        for (int j = 0; j < 5; ++j)
#pragma unroll
            for (int sp = 0; sp < 2; ++sp) { const bf16x8 pf = pack8(s[j], sp);
#pragma unroll
                for (int db = 0; db < 2; ++db) { const LAS unsigned char* av = vb + db * AV_DB + (32 * j + 16 * sp) * 64;
                    const bf16x8 vf = cat8(vtr(av), vtr(av + 512)); o[db] = MFMA32(vf, pf, o[db]); } }
        const float rl = 1.0f / l;
        bf16* op = AO + qrow * 512 + a.head * 64 + 8 * h;
#pragma unroll
        for (int db = 0; db < 2; ++db)
#pragma unroll
            for (int gp = 0; gp < 2; ++gp) {
                unsigned a0 = pk2(o[db][8 * gp] * rl, o[db][8 * gp + 1] * rl), a1 = pk2(o[db][8 * gp + 2] * rl, o[db][8 * gp + 3] * rl);
                unsigned b0 = pk2(o[db][8 * gp + 4] * rl, o[db][8 * gp + 5] * rl), b1 = pk2(o[db][8 * gp + 6] * rl, o[db][8 * gp + 7] * rl);
                const auto s0 = __builtin_amdgcn_permlane32_swap(a0, b0, false, false); const auto s1 = __builtin_amdgcn_permlane32_swap(a1, b1, false, false);
                u32x4 wv; wv.x = s0[0]; wv.y = s1[0]; wv.z = s0[1]; wv.w = s1[1];
                *(u32x4*)(op + 32 * db + 16 * gp) = wv; }
        if (h == 0) LSE[qrow * 8 + a.head] = mx + __builtin_amdgcn_logf(l);
    }
    __syncthreads();
}

__device__ __forceinline__ void attnA_combine(const unsigned char* ws, int vcu, int G) {
    const bf16* A0 = (const bf16*)(ws + WS_AO0); const bf16* A1 = (const bf16*)(ws + WS_AO1); const bf16* A2 = (const bf16*)(ws + WS_AO2);
    const float* LSE = (const float*)(ws + WS_LSE); bf16* O = (bf16*)(ws + WS_ATTA);
    for (size_t it = (size_t)vcu * 512 + threadIdx.x; it < (size_t)M * 64; it += (size_t)G * 512) {
        const size_t rh = it >> 3;
        const float l0 = LSE[rh], l1 = LSE[(size_t)M * 8 + rh], l2 = LSE[(size_t)2 * M * 8 + rh];
        const float mx = fmaxf(l0, fmaxf(l1, l2));
        float w0 = __builtin_amdgcn_exp2f(l0 - mx), w1 = __builtin_amdgcn_exp2f(l1 - mx), w2 = __builtin_amdgcn_exp2f(l2 - mx);
        const float inv = 1.0f / (w0 + w1 + w2); w0 *= inv; w1 *= inv; w2 *= inv;
        const u32x4 a = *(const u32x4*)(A0 + it * 8), bq = *(const u32x4*)(A1 + it * 8), c = *(const u32x4*)(A2 + it * 8);
        u32x4 o;
#pragma unroll
        for (int k = 0; k < 4; ++k) o[k] = pk2(w0 * bflo(a[k]) + w1 * bflo(bq[k]) + w2 * bflo(c[k]), w0 * bfhi(a[k]) + w1 * bfhi(bq[k]) + w2 * bfhi(c[k]));
        *(u32x4*)(O + (it >> 6) * 1024 + (it & 63) * 8) = o;
    }
}

constexpr int BK_CH = 64 * 16 + 16, BK_IMG = 8 * BK_CH, BV_DB = 64 * 64 + 64, BV_IMG = 4 * BV_DB, BBUF = 2 * BK_IMG + BV_IMG;
__device__ __forceinline__ void attnB_unit(LAS unsigned char* lds, const unsigned char* ws, int unit, float lam, const float* subln_g, bool prefetched, int next_unit) {
    const int tid = threadIdx.x, lane = tid & 63, wid = __builtin_amdgcn_readfirstlane(tid >> 6), w = wid & 3, c = wid >> 2, r = lane & 31, h = lane >> 5;
    const int qb = unit & 31, hd = (unit >> 5) & 3, b = unit >> 7, q0 = qb * 128;
    const bf16* QB = (const bf16*)(ws + WS_QB); const bf16* KB = (const bf16*)(ws + WS_KB); const bf16* VB = (const bf16*)(ws + WS_VB); bf16* OB = (bf16*)(ws + WS_ATTA);
    const size_t rowb = (size_t)b * SEQ;
    const size_t qrow = rowb + q0 + 32 * w + r;
    bf16x8 qf[4];
#pragma unroll
    for (int ks = 0; ks < 4; ++ks) qf[ks] = *(const bf16x8*)(QB + qrow * 512 + hd * 128 + c * 64 + 16 * ks + 8 * h);
    const int rot = (qb * 2) & 63;
    const bf16* kg = KB + (rowb + lane) * 512 + hd * 128 + wid * 8;
    const bf16* vg0 = VB + (rowb + (wid & 3) * 16 + (lane >> 2)) * 512 + hd * 128 + (wid >> 2) * 32 + (lane & 3) * 8;
    const unsigned ldsb = (unsigned)(unsigned long)lds;
    const unsigned kd = ldsb + wid * BK_CH, vd0 = ldsb + 2 * BK_IMG + (wid >> 2) * BV_DB + (wid & 3) * 1024;
#define B_DMA(t, boff) do { const size_t go = (size_t)(((t) + rot) & 63) * 64 * 512; \
        GLDS16(kg + go, kd + (boff)); GLDS16(kg + go + 64, kd + BK_IMG + (boff)); GLDS16(vg0 + go, vd0 + (boff)); GLDS16(vg0 + go + 64, vd0 + 2 * BV_DB + (boff)); } while (0)
#define B_WAITBAR() do { asm volatile("s_waitcnt vmcnt(0)" ::: "memory"); __syncthreads(); } while (0)
#define B_QK(boff, S0, S1) do { const LAS unsigned char* kb_ = lds + (boff) + koff; _Pragma("unroll") for (int ks = 0; ks < 4; ++ks) { \
        const bf16x8 a0 = *(const LAS bf16x8*)(kb_ + 2 * ks * BK_CH), a1 = *(const LAS bf16x8*)(kb_ + 2 * ks * BK_CH + 512); \
        S0 = MFMA32(a0, qf[ks], S0); S1 = MFMA32(a1, qf[ks], S1); } } while (0)
    const int i16 = lane & 15, qd = i16 >> 2, pp = i16 & 3, blk = (lane >> 4) & 1;
    const int voff = 2 * BK_IMG + (4 * h + qd) * 64 + blk * 32 + pp * 8, koff = c * BK_IMG + h * BK_CH + r * 16;
    constexpr int NT = SEQ / 64;
    if (!prefetched) { B_DMA(0, 0); B_DMA(1, BBUF); }
    B_WAITBAR();
    f32x16 n0 = {}, n1 = {};
    B_QK(0, n0, n1);
    float mrow = fmaxf(n0[0], n1[0]);
#pragma unroll
    for (int i = 1; i < 16; ++i) mrow = fmaxf(mrow, fmaxf(n0[i], n1[i]));
    mrow = fmaxf(mrow, xhalf(mrow));
    f32x16 negm;
#pragma unroll
    for (int i = 0; i < 16; ++i) { negm[i] = -mrow; n0[i] -= mrow; n1[i] -= mrow; }
    f32x16 o[4] = {}; float l = 0.f;
#define SB() __builtin_amdgcn_sched_barrier(0)
#define B_ITER(t, bcur, bnext, bnn) do { \
        if ((t) + 2 < NT) B_DMA((t) + 2, bnn); \
        f32x16 s0 = n0, s1 = n1; bf16x8 kf[8]; \
        if ((t) + 1 < NT) { const LAS unsigned char* kb_ = lds + (bnext) + koff; \
            _Pragma("unroll") for (int ks = 0; ks < 4; ++ks) { kf[2 * ks] = *(const LAS bf16x8*)(kb_ + 2 * ks * BK_CH); kf[2 * ks + 1] = *(const LAS bf16x8*)(kb_ + 2 * ks * BK_CH + 512); } } \
        SB(); \
        float lsum = 0.f; bf16x8 pf[4]; \
        _Pragma("unroll") for (int i = 0; i < 16; ++i) { s0[i] = __builtin_amdgcn_exp2f(s0[i]); lsum += s0[i]; } \
        pf[0] = pack8(s0, 0); pf[1] = pack8(s0, 1); \
        SB(); \
        if ((t) + 1 < NT) { n0 = negm; n1 = negm; \
            _Pragma("unroll") for (int ks = 0; ks < 4; ++ks) { n0 = MFMA32(kf[2 * ks], qf[ks], n0); n1 = MFMA32(kf[2 * ks + 1], qf[ks], n1); } } \
        _Pragma("unroll") for (int i = 0; i < 16; ++i) { s1[i] = __builtin_amdgcn_exp2f(s1[i]); lsum += s1[i]; } \
        pf[2] = pack8(s1, 0); pf[3] = pack8(s1, 1); \
        l += lsum; \
        const LAS unsigned char* vb_ = lds + (bcur) + voff; \
        _Pragma("unroll") for (int kk = 0; kk < 4; ++kk) \
        _Pragma("unroll") for (int db = 0; db < 4; ++db) { const LAS unsigned char* a = vb_ + db * BV_DB + kk * 1024; \
                const bf16x8 vf = cat8(vtr(a), vtr(a + 512)); o[db] = MFMA32(vf, pf[kk], o[db]); } \
        if (__any(lsum > 0x1p40f)) { float ls2 = lsum + xhalf(lsum); const float d = ls2 > 0x1p40f ? floorf(__builtin_amdgcn_logf(ls2)) : 0.f, f = __builtin_amdgcn_exp2f(-d); l *= f; \
            _Pragma("unroll") for (int i = 0; i < 16; ++i) { negm[i] -= d; n0[i] -= d; n1[i] -= d; } \
            _Pragma("unroll") for (int db = 0; db < 4; ++db) _Pragma("unroll") for (int i = 0; i < 16; ++i) o[db][i] *= f; } \
        B_WAITBAR(); } while (0)
    for (int t3 = 0; t3 < NT - 1; t3 += 3) {
        B_ITER(t3, 0, BBUF, 2 * BBUF);
        B_ITER(t3 + 1, BBUF, 2 * BBUF, 0);
        B_ITER(t3 + 2, 2 * BBUF, 0, BBUF);
    }
    B_ITER(NT - 1, 0, BBUF, 2 * BBUF);
#undef B_ITER
#undef B_QK
#undef B_DMA
    if (next_unit >= 0) {
        const int qbn = next_unit & 31, hdn = (next_unit >> 5) & 3, rotn = (qbn * 2) & 63; const size_t rowbn = (size_t)(next_unit >> 7) * SEQ;
        const bf16* kgn = KB + (rowbn + lane) * 512 + hdn * 128 + wid * 8;
        const bf16* vgn = VB + (rowbn + (wid & 3) * 16 + (lane >> 2)) * 512 + hdn * 128 + (wid >> 2) * 32 + (lane & 3) * 8;
#pragma unroll
        for (int tt = 0; tt < 2; ++tt) { const size_t go = (size_t)((tt + rotn) & 63) * 64 * 512; const unsigned bo = tt * BBUF;
            GLDS16(kgn + go, kd + bo); GLDS16(kgn + go + 64, kd + BK_IMG + bo); GLDS16(vgn + go, vd0 + bo); GLDS16(vgn + go + 64, vd0 + 2 * BV_DB + bo); }
    }
    l += xhalf(l);
    const float rl = 1.0f / l;
    LAS float* ex = (LAS float*)(lds + 2 * BBUF) + w * 4096 + lane;
    if (c == 1) {
#pragma unroll
        for (int db = 0; db < 4; ++db)
#pragma unroll
            for (int i = 0; i < 16; ++i) ex[(db * 16 + i) * 64] = o[db][i] * rl;
    }
    __syncthreads();
    if (c == 0) {
        float ss = 0.f;
#pragma unroll
        for (int db = 0; db < 4; ++db)
#pragma unroll
            for (int i = 0; i < 16; ++i) { const float v = o[db][i] * rl - lam * ex[(db * 16 + i) * 64]; o[db][i] = v; ss += v * v; }
        ss += xhalf(ss);
        const float rs = 0.8f / sqrtf(ss * (1.0f / 128.0f) + 1e-5f);
        bf16* op = OB + qrow * 1024 + 512 + hd * 128 + 8 * h;
#pragma unroll
        for (int db = 0; db < 4; ++db)
#pragma unroll
            for (int gp = 0; gp < 2; ++gp) {
                const f32x4 ga = *(const f32x4*)(subln_g + 32 * db + 16 * gp + 4 * h), gb = *(const f32x4*)(subln_g + 32 * db + 16 * gp + 8 + 4 * h);
                unsigned a0 = pk2(o[db][8 * gp] * rs * ga[0], o[db][8 * gp + 1] * rs * ga[1]), a1 = pk2(o[db][8 * gp + 2] * rs * ga[2], o[db][8 * gp + 3] * rs * ga[3]);
                unsigned b0 = pk2(o[db][8 * gp + 4] * rs * gb[0], o[db][8 * gp + 5] * rs * gb[1]), b1 = pk2(o[db][8 * gp + 6] * rs * gb[2], o[db][8 * gp + 7] * rs * gb[3]);
                const auto s0 = __builtin_amdgcn_permlane32_swap(a0, b0, false, false); const auto s1 = __builtin_amdgcn_permlane32_swap(a1, b1, false, false);
                u32x4 wv; wv.x = s0[0]; wv.y = s1[0]; wv.z = s0[1]; wv.w = s1[1];
                *(u32x4*)(op + 32 * db + 16 * gp) = wv; }
    }
    __syncthreads();
}

#define XB_TMO      128
#define XB_XCNT(j)  (256  + 64 * (j))
#define XB_XSUB(j)  (1280 + 64 * (j))
#define XB_XGEN(j)  (2304 + 64 * (j))
#define XB_TOP      3328
#define XB_TOPGEN   3392
#define XCD_BAR_WORDS 3456
#define XB_SPIN_CAP (1u << 18)

__device__ __forceinline__ unsigned xb_ld(unsigned* p)              { return __hip_atomic_load(p, __ATOMIC_RELAXED, __HIP_MEMORY_SCOPE_AGENT); }
__device__ __forceinline__ unsigned xb_add(unsigned* p, unsigned v) { return __hip_atomic_fetch_add(p, v, __ATOMIC_RELAXED, __HIP_MEMORY_SCOPE_AGENT); }
__device__ __forceinline__ unsigned xb_xcc_id() { return (unsigned)__builtin_amdgcn_s_getreg((3 << 11) | 20) & 0xFu; }
#define XB_SPIN(cond, bar) do { unsigned _sp = 0; while (cond) { __builtin_amdgcn_s_sleep(1); \
    if ((++_sp & 255u) == 0u) { if (xb_ld(&(bar)[XB_TMO])) break; if (_sp > XB_SPIN_CAP) { atomicAdd(&(bar)[XB_TMO], 1u); break; } } } } while (0)

struct XcdBarrier {
    unsigned* bar; unsigned x;
    volatile LAS unsigned* st;
};

__device__ __forceinline__ XcdBarrier xcd_barrier_post(unsigned* bar, volatile LAS unsigned* st) {
    XcdBarrier b; b.bar = bar; b.x = xb_xcc_id(); b.st = st;
    if (threadIdx.x == 0) (void)xb_add(&bar[XB_XCNT(b.x)], 1u);
    return b;
}
__device__ __forceinline__ void xcd_barrier_complete(unsigned* bar, unsigned x, unsigned& nloc, unsigned& nx) {
    const unsigned G = gridDim.x * gridDim.y * gridDim.z;
    unsigned sum, cnt, mine, sp = 0u;
    for (;;) {
        sum = 0u; cnt = 0u; mine = 0u;
#pragma unroll
        for (unsigned j = 0; j < 16; ++j) { const unsigned c = xb_ld(&bar[XB_XCNT(j)]); sum += c; cnt += (c > 0u) ? 1u : 0u; mine = (j == x) ? c : mine; }
        if (sum == G) break;
        __builtin_amdgcn_s_sleep(1);
        if ((++sp & 255u) == 0u) { if (xb_ld(&bar[XB_TMO])) break; if (sp > XB_SPIN_CAP) { atomicAdd(&bar[XB_TMO], 1u); break; } }
    }
    nloc = mine > 0u ? mine : 1u; nx = cnt > 0u ? cnt : 1u;
}

__device__ __forceinline__ void xcd_barrier(const XcdBarrier& b) {
    asm volatile("s_waitcnt vmcnt(0)" ::: "memory");
    __syncthreads();
    if (threadIdx.x == 0) {
        unsigned* bar = b.bar;
        __builtin_amdgcn_s_waitcnt(0);
        unsigned nloc = b.st[0], nx = b.st[1];
        if (nloc == 0u) { xcd_barrier_complete(bar, b.x, nloc, nx); b.st[0] = nloc; b.st[1] = nx; }
        const unsigned old = xb_add(&bar[XB_XSUB(b.x)], 1u);
        const unsigned gen = old / nloc;
        if (old + 1u == (gen + 1u) * nloc) {
            __builtin_amdgcn_fence(__ATOMIC_RELEASE, "agent");
            asm volatile("s_waitcnt vmcnt(0)" ::: "memory");
            const unsigned og = xb_add(&bar[XB_TOP], 1u);
            const unsigned tg = og / nx;
            if (og + 1u == (tg + 1u) * nx) xb_add(&bar[XB_TOPGEN], 1u);
            else XB_SPIN(xb_ld(&bar[XB_TOPGEN]) == tg, bar);
            __builtin_amdgcn_fence(__ATOMIC_ACQUIRE, "agent");
            xb_add(&bar[XB_XGEN(b.x)], 1u);
            asm volatile("s_waitcnt vmcnt(0)" ::: "memory");
        } else {
            XB_SPIN(xb_ld(&bar[XB_XGEN(b.x)]) == gen, bar);
            __builtin_amdgcn_fence(__ATOMIC_ACQUIRE, "agent");
            asm volatile("s_waitcnt vmcnt(0)" ::: "memory");
        }
    }
    __syncthreads();
}


__global__ void __launch_bounds__(512, 2) fwd_kernel(Args A) {
    extern __shared__ __attribute__((aligned(16))) unsigned char lds_raw[];
    LAS unsigned char* lds = (LAS unsigned char*)lds_raw;
    const int G = gridDim.x, bx = blockIdx.x, tid = threadIdx.x;
    const int vcu = (G % 8 == 0) ? (bx % 8) * (G / 8) + bx / 8 : bx;
    unsigned char* ws = A.ws;
    const int lo = A.ph_lo, hi = A.ph_hi;
    volatile LAS unsigned* MISC = (volatile LAS unsigned*)(lds + 151552);
    if (tid < 16) MISC[tid] = 0u;
    __syncthreads();
    if (lo == -12345) cg::this_grid().sync();
    XcdBarrier bar = xcd_barrier_post((unsigned*)(ws + WS_CTL), MISC + 8);
#define IN(k) (lo <= (k) && (k) < hi)
#define SEAM(k) do { if (IN(k) && IN((k) + 1)) xcd_barrier(bar); } while (0)
    if (IN(0)) p0_prologue(A, lds, vcu, G);
    SEAM(0);
    if (IN(1)) {
        pg8::Gemm g{(const bf16*)(ws + WS_XN), (const bf16*)(ws + WS_WIN), M, INW, 1024}; pg8::StaticOrder S; S.init(M, INW, G, bx, 4);
        EpiIn E{ws};
        pg8::gemm_phase<EpiIn, pg8::StaticOrder, true, true>(lds, g, S, E);
    }
    SEAM(1);
    if (IN(2)) attnA_phase(lds, ws, vcu, G);
    SEAM(2);
    if (IN(3)) {
        attnA_combine(ws, vcu, G);
        float d1 = 0.f, d2 = 0.f;
        for (int i = 0; i < 64; ++i) { d1 += A.lq1[i] * A.lk1[i]; d2 += A.lq2[i] * A.lk2[i]; }
        const float lam = expf(d1) - expf(d2) + 0.2f;
        if (tid >= 256) __builtin_amdgcn_s_setprio(1);
        for (int u = vcu; u < BATCH * 4 * 32; u += G) attnB_unit(lds, ws, u, lam, A.subln_g, u != vcu, (u + G < BATCH * 4 * 32) ? u + G : -1);
        __builtin_amdgcn_s_setprio(0);
    }
    SEAM(3);
    if (IN(4)) {
        pg8::Gemm g{(const bf16*)(ws + WS_ATTA), (const bf16*)(ws + WS_WA), M, 1024, 1024}; pg8::StaticOrder S; S.init(M, 1024, G, bx);
        EpiGate2 E{(const unsigned char*)(ws + WS_SGA), (const unsigned char*)(ws + WS_SGB), (bf16*)(ws + WS_MERGED)};
        pg8::gemm_phase<EpiGate2, pg8::StaticOrder, true, true>(lds, g, S, E);
    }
    SEAM(4);
    if (IN(5)) {
        pg8::Gemm g{(const bf16*)(ws + WS_MERGED), (const bf16*)(ws + WS_WOUT), M, 1024, 1024}; pg8::StaticOrder S; S.init(M, 1024, G, bx);
        EpiRes1 E{A.x, (bf16*)(ws + WS_X1B), (float*)(ws + WS_SSQ1)};
        pg8::gemm_phase<EpiRes1, pg8::StaticOrder, true, true>(lds, g, S, E);
    }
    SEAM(5);
    if (IN(6)) {
        pg8::Gemm g{(const bf16*)(ws + WS_X1B), (const bf16*)(ws + WS_W1), M, DFF, 1024}; pg8::StaticOrder S; S.init(M, DFF, G, bx);
        EpiFF1 E{(bf16*)(ws + WS_H)};
        pg8::gemm_phase<EpiFF1, pg8::StaticOrder, true, true>(lds, g, S, E);
    }
    SEAM(6);
    if (IN(7)) {
        pg8::Gemm g{(const bf16*)(ws + WS_H), (const bf16*)(ws + WS_W2), M, 1024, DFF}; pg8::StaticOrder S; S.init(M, 1024, G, bx);
        EpiFinal E{(const bf16*)(ws + WS_X1B), (const float*)(ws + WS_SSQ1), A.out, A.g_final, (float*)(ws + WS_SSQ2), (unsigned*)(ws + WS_CTL + 65536), lds + 131072};
        pg8::gemm_phase<EpiFinal, pg8::StaticOrder, true, true>(lds, g, S, E);
    }
#undef IN
#undef SEAM
}

#ifndef MK_PER_PHASE
#define MK_PER_PHASE 0
#endif
extern "C" void kernel_launch(void* const* d_in, const int* in_sizes, int n_in, void* d_out, int out_size, void* d_ws, size_t ws_size, hipStream_t stream) {
    static int grid = 0;
    if (grid == 0) {
        if (n_in != 15 || in_sizes[0] != M * DM || out_size != M * DM || ws_size < WS_END) { fprintf(stderr, "kernel_launch: unexpected shapes / workspace (%d inputs, ws %zu)\n", n_in, ws_size); grid = -1; return; }
        int dev = 0, cus = 0, per_cu = 0;
        (void)hipGetDevice(&dev); (void)hipDeviceGetAttribute(&cus, hipDeviceAttributeMultiprocessorCount, dev);
        (void)hipFuncSetAttribute((const void*)fwd_kernel, hipFuncAttributeMaxDynamicSharedMemorySize, LDS_BYTES);
        (void)hipOccupancyMaxActiveBlocksPerMultiprocessor(&per_cu, (const void*)fwd_kernel, 512, LDS_BYTES);
        if (per_cu < 1) per_cu = 1;
        grid = cus * per_cu;
        fprintf(stderr, "kernel_launch: %d CUs x %d = grid %d\n", cus, per_cu, grid);
    }
    if (grid < 0) return;
    (void)hipMemsetAsync((unsigned char*)d_ws + WS_CTL, 0, 131072, stream);
    Args a{};
    a.x = (const float*)d_in[0]; a.w_in = (const float*)d_in[1]; a.w_a = (const float*)d_in[2]; a.w_b = (const float*)d_in[3]; a.w_out = (const float*)d_in[4];
    a.lq1 = (const float*)d_in[5]; a.lk1 = (const float*)d_in[6]; a.lq2 = (const float*)d_in[7]; a.lk2 = (const float*)d_in[8]; a.subln_g = (const float*)d_in[9];
    a.g_mix = (const float*)d_in[10]; a.g_mlp = (const float*)d_in[11]; a.w_ff1 = (const float*)d_in[12]; a.w_ff2 = (const float*)d_in[13]; a.g_final = (const float*)d_in[14];
    a.out = (float*)d_out; a.ws = (unsigned char*)d_ws;
#if MK_PER_PHASE
    for (int ph = 0; ph < NPHASE - 1; ++ph) { a.ph_lo = ph; a.ph_hi = ph + 1; hipLaunchKernelGGL(fwd_kernel, dim3(grid), dim3(512), LDS_BYTES, stream, a); }
#else
    a.ph_lo = 0; a.ph_hi = NPHASE;
    void* args[] = {&a};
    hipError_t e = hipLaunchCooperativeKernel((const void*)fwd_kernel, dim3(grid), dim3(512), args, LDS_BYTES, stream);
    if (e != hipSuccess) fprintf(stderr, "cooperative launch failed: %s (grid %d)\n", hipGetErrorString(e), grid);
#endif
}
```

```cpp
#include <hip/hip_runtime.h>
#include <hip/hip_cooperative_groups.h>
#include <cstdio>
#include <cstdint>
namespace cg = cooperative_groups;
namespace pg8 {
#define PG8_LAS __attribute__((address_space(3)))
typedef unsigned short bf16_t;
typedef short bf16x8 __attribute__((ext_vector_type(8)));
typedef float f32x4 __attribute__((ext_vector_type(4)));
typedef unsigned u32x4 __attribute__((ext_vector_type(4)));
constexpr int BM = 256, BK = 64, HALF = 128, HTB = HALF * BK * 2  , STAGE_BYTES = 8 * HTB, NXCD = 8, WGM = 8;

__host__ __device__ __forceinline__ int lds_byte(int r, int c) { const int st = (r >> 4) * 2 + (c >> 5), rr = r & 15, cc = c & 31, ob = rr * 64 + cc * 2; return st * 1024 + (ob ^ (((ob >> 9) & 1) << 5)); }
__host__ __device__ __forceinline__ void stage_rc(int b, int& R, int& C) { const int st = b / 1024, sb = b % 1024, swz = sb ^ (((sb >> 9) & 1) << 5); R = (st >> 1) * 16 + swz / 64; C = (st & 1) * 32 + (swz % 64) / 2; }
__host__ __device__ __forceinline__ int perm32(int rho) { const int n = rho >> 4, i = rho & 15; return 8 * (i >> 2) + 4 * n + (i & 3); }

struct Unit { int pm, pn; };
struct Gemm { const bf16_t* A; const bf16_t* Bt; int M, N, K; };

struct StaticOrder {
    int nM, nN, nwg, G, c, wgm;
    __host__ __device__ void init(int M, int N, int G_, int c_, int wgm_ = WGM) { nM = M / BM; nN = N / BM; nwg = nM * nN; G = G_; c = c_; wgm = wgm_; }
    __host__ __device__ bool next(int i, Unit& u) const {
        const long L = (long)i * G + c; if (L >= nwg) return false;
        int wgid = (int)L; { const int q = nwg / NXCD, r = nwg % NXCD, xcd = wgid % NXCD, off = wgid / NXCD; wgid = (xcd < r ? xcd * (q + 1) : r * (q + 1) + (xcd - r) * q) + off; }
        const int nig = wgm * nN, gid = wgid / nig, fm = gid * wgm, gsz = (nM - fm) < wgm ? (nM - fm) : wgm;
        u.pm = fm + ((wgid % nig) % gsz); u.pn = (wgid % nig) / gsz; return true;
    }
    __device__ __forceinline__ void a_ready(const Unit&) const {}
    __device__ __forceinline__ void done(const Unit&) const {}
};

__device__ __forceinline__ unsigned cvt_pk_bf16(float lo, float hi) { unsigned r; asm volatile("v_cvt_pk_bf16_f32 %0, %1, %2" : "=v"(r) : "v"(lo), "v"(hi)); return r; }
template <class Epi, class Sched, bool ALIGN_EPI = false, bool SP2 = false>
__device__ __forceinline__ void gemm_phase(PG8_LAS unsigned char* lds, const Gemm g, const Sched& S, const Epi& E) {
    const int tid = threadIdx.x, wid = __builtin_amdgcn_readfirstlane(tid >> 6), lane = tid & 63, wr = wid >> 2, wc = wid & 3, fr = lane & 15, fq = lane >> 4;
    const int K = g.K, nt = K / BK;
    unsigned voffA[2], voffB[2];
#pragma unroll
    for (int i = 0; i < 2; ++i) { int R, C; stage_rc(tid * 16 + i * 8192, R, C); const int Rb = Epi::PERM ? ((R & ~31) + perm32(R & 31)) : R;
        voffA[i] = (unsigned)(R * K + C) * 2u; voffB[i] = (unsigned)(Rb * K + C) * 2u; }
    const size_t kstep = (size_t)(BK * 2);
    const size_t hstep = (size_t)HALF * K * 2;
    const size_t tstep = 2 * hstep;
    const unsigned ldsw = (unsigned)wid * 1024u;
    const int aoff = lds_byte(wr * 64 + fr, fq * 8), boff = lds_byte(wc * 32 + fr, fq * 8);
#define PG8_SA(b, h) (((b) * 2 + (h)) * HTB)
#define PG8_SB(b, h) ((4 + (b) * 2 + (h)) * HTB)
#define PG8_STAGE(bufoff, gbase, voff) do { _Pragma("unroll") for (int _i = 0; _i < 2; ++_i) \
        __builtin_amdgcn_global_load_lds((const unsigned*)((const char*)(gbase) + (voff)[_i]), (PG8_LAS unsigned*)(lds + (bufoff) + ldsw + _i * 8192), 16, 0, 0); } while (0)
#define PG8_LDA(dst, b, h) do { _Pragma("unroll") for (int m = 0; m < 4; ++m) _Pragma("unroll") for (int k = 0; k < 2; ++k) dst[m][k] = *(const PG8_LAS bf16x8*)(lds + PG8_SA(b, h) + aoff + m * 2048 + k * 1024); } while (0)
#define PG8_LDB(dst, b, h) do { _Pragma("unroll") for (int n = 0; n < 2; ++n) _Pragma("unroll") for (int k = 0; k < 2; ++k) dst[n][k] = *(const PG8_LAS bf16x8*)(lds + PG8_SB(b, h) + boff + n * 2048 + k * 1024); } while (0)
#define PG8_MMA(ai, bj, At, Bt) do { __builtin_amdgcn_s_setprio(1); _Pragma("unroll") for (int m = 0; m < 4; ++m) _Pragma("unroll") for (int n = 0; n < 2; ++n) _Pragma("unroll") for (int k = 0; k < 2; ++k) \
        acc[ai][bj][m][n] = __builtin_amdgcn_mfma_f32_16x16x32_bf16(Bt[n][k], At[m][k], acc[ai][bj][m][n], 0, 0, 0); __builtin_amdgcn_s_setprio(0); } while (0)
#define PG8_WAIT_V(n) asm volatile("s_waitcnt vmcnt(" #n ")" ::: "memory")
#define PG8_WAIT_L(n) asm volatile("s_waitcnt lgkmcnt(" #n ")" ::: "memory")
#define PG8_BAR __builtin_amdgcn_s_barrier()
#define PG8_SCHED __builtin_amdgcn_sched_barrier(0)
    Unit cur, nxt; int ui = 0;
    if (!S.next(0, cur)) return;
    f32x4 acc[2][2][4][2];
#pragma unroll
    for (int a = 0; a < 2; ++a)
#pragma unroll
        for (int b = 0; b < 2; ++b)
#pragma unroll
            for (int m = 0; m < 4; ++m)
#pragma unroll
                for (int n = 0; n < 2; ++n) acc[a][b][m][n] = (f32x4){0.f, 0.f, 0.f, 0.f};
    bf16x8 At[4][2], B0[2][2], B1[2][2];
    const char* cA = (const char*)g.A + (size_t)cur.pm * tstep; const char* cB = (const char*)g.Bt + (size_t)cur.pn * tstep;
    S.a_ready(cur);
    if constexpr (SP2) {
        PG8_STAGE(PG8_SB(0, 0), cB, voffB); PG8_STAGE(PG8_SB(0, 1), cB + hstep, voffB); PG8_STAGE(PG8_SA(0, 0), cA, voffA); PG8_STAGE(PG8_SA(0, 1), cA + hstep, voffA);
        if (wr == 1) PG8_BAR;
        PG8_WAIT_V(2); PG8_BAR;
        PG8_STAGE(PG8_SB(1, 0), cB + kstep, voffB); PG8_STAGE(PG8_SA(1, 0), cA + kstep, voffA); PG8_STAGE(PG8_SB(1, 1), cB + hstep + kstep, voffB);
        PG8_WAIT_V(6); PG8_BAR;
    } else {
        PG8_STAGE(PG8_SB(0, 0), cB, voffB); PG8_STAGE(PG8_SA(0, 0), cA, voffA); PG8_STAGE(PG8_SB(0, 1), cB + hstep, voffB); PG8_STAGE(PG8_SA(0, 1), cA + hstep, voffA);
        if (wr == 1) PG8_BAR;
        PG8_WAIT_V(4); PG8_BAR;
        PG8_STAGE(PG8_SB(1, 0), cB + kstep, voffB); PG8_STAGE(PG8_SA(1, 0), cA + kstep, voffA); PG8_STAGE(PG8_SB(1, 1), cB + hstep + kstep, voffB);
        PG8_WAIT_V(6); PG8_BAR;
    }
    for (;;) {
        const bool has_next = S.next(ui + 1, nxt);
        const char* nA = has_next ? (const char*)g.A + (size_t)nxt.pm * tstep : cA; const char* nB = has_next ? (const char*)g.Bt + (size_t)nxt.pn * tstep : cB;
        int t_first = 0;
        if constexpr (SP2 && Epi::RELAX) { if (ui > 0) {
            size_t ks_ = kstep; asm volatile("" : "+s"(ks_));
            PG8_LDB(B0, 0, 0); PG8_LDB(B1, 0, 1); PG8_SCHED; PG8_LDA(At, 0, 0); PG8_STAGE(PG8_SA(1, 1), cA + ks_ + hstep, voffA);
            PG8_WAIT_V(24); PG8_WAIT_L(0); PG8_BAR; PG8_MMA(0, 0, At, B0); PG8_MMA(0, 1, At, B1); PG8_BAR; PG8_SCHED;
            PG8_LDA(At, 0, 1); PG8_STAGE(PG8_SB(0, 0), cB + 2 * ks_, voffB); PG8_STAGE(PG8_SB(0, 1), cB + 2 * ks_ + hstep, voffB); PG8_STAGE(PG8_SA(0, 0), cA + 2 * ks_, voffA);
            PG8_WAIT_V(24); PG8_WAIT_L(0); PG8_BAR; PG8_MMA(1, 0, At, B0); PG8_MMA(1, 1, At, B1); PG8_BAR; PG8_SCHED;
            PG8_LDB(B0, 1, 0); PG8_LDB(B1, 1, 1); PG8_SCHED; PG8_LDA(At, 1, 0); PG8_STAGE(PG8_SA(0, 1), cA + 2 * ks_ + hstep, voffA);
            PG8_WAIT_V(8); PG8_WAIT_L(0); PG8_BAR; PG8_MMA(0, 0, At, B0); PG8_MMA(0, 1, At, B1); PG8_BAR; PG8_SCHED;
            PG8_LDA(At, 1, 1); PG8_STAGE(PG8_SB(1, 0), cB + 3 * ks_, voffB); PG8_STAGE(PG8_SB(1, 1), cB + 3 * ks_ + hstep, voffB); PG8_STAGE(PG8_SA(1, 0), cA + 3 * ks_, voffA);
            PG8_WAIT_V(8); PG8_WAIT_L(0); PG8_BAR; PG8_MMA(1, 0, At, B0); PG8_MMA(1, 1, At, B1); PG8_BAR; PG8_SCHED;
            t_first = 2; } }
        for (int t = t_first; t < nt; t += 2) {
            if constexpr (Epi::MIDK) { if (t == (nt >> 1)) E.mid(acc, cur, wr, wc, fr, fq); }
            const bool last = (t == nt - 2);
            const char* a1 = cA + (size_t)(t + 1) * kstep;
            const char* a2 = last ? nA : cA + (size_t)(t + 2) * kstep; const char* b2 = last ? nB : cB + (size_t)(t + 2) * kstep;
            const char* a3 = a2 + kstep; const char* b3 = b2 + kstep;
            if (last && has_next) S.a_ready(nxt);
            if constexpr (SP2) {
            PG8_LDB(B0, 0, 0); PG8_LDB(B1, 0, 1); PG8_SCHED; PG8_LDA(At, 0, 0); PG8_STAGE(PG8_SA(1, 1), a1 + hstep, voffA);
            PG8_WAIT_V(8); PG8_WAIT_L(0); PG8_BAR; PG8_MMA(0, 0, At, B0); PG8_MMA(0, 1, At, B1); PG8_BAR; PG8_SCHED;
            PG8_LDA(At, 0, 1); PG8_STAGE(PG8_SB(0, 0), b2, voffB); PG8_STAGE(PG8_SB(0, 1), b2 + hstep, voffB); PG8_STAGE(PG8_SA(0, 0), a2, voffA);
            PG8_WAIT_V(8); PG8_WAIT_L(0); PG8_BAR; PG8_MMA(1, 0, At, B0); PG8_MMA(1, 1, At, B1); PG8_BAR; PG8_SCHED;
            PG8_LDB(B0, 1, 0); PG8_LDB(B1, 1, 1); PG8_SCHED; PG8_LDA(At, 1, 0); PG8_STAGE(PG8_SA(0, 1), a2 + hstep, voffA);
            PG8_WAIT_V(8); PG8_WAIT_L(0); PG8_BAR; PG8_MMA(0, 0, At, B0); PG8_MMA(0, 1, At, B1); PG8_BAR; PG8_SCHED;
            PG8_LDA(At, 1, 1); PG8_STAGE(PG8_SB(1, 0), b3, voffB); PG8_STAGE(PG8_SB(1, 1), b3 + hstep, voffB); PG8_STAGE(PG8_SA(1, 0), a3, voffA);
            PG8_WAIT_V(8); PG8_WAIT_L(0); PG8_BAR; PG8_MMA(1, 0, At, B0); PG8_MMA(1, 1, At, B1); PG8_BAR; PG8_SCHED;
            } else {
            PG8_LDB(B0, 0, 0); PG8_SCHED; PG8_LDA(At, 0, 0); PG8_STAGE(PG8_SA(1, 1), a1 + hstep, voffA);
            PG8_WAIT_L(8); PG8_BAR; PG8_WAIT_L(0); PG8_MMA(0, 0, At, B0); PG8_BAR; PG8_SCHED;
            PG8_LDB(B1, 0, 1); PG8_STAGE(PG8_SB(0, 0), b2, voffB);
            PG8_BAR; PG8_WAIT_L(0); PG8_MMA(0, 1, At, B1); PG8_BAR;
            PG8_LDA(At, 0, 1); PG8_STAGE(PG8_SA(0, 0), a2, voffA);
            PG8_BAR; PG8_WAIT_L(0); PG8_MMA(1, 0, At, B0); PG8_BAR; PG8_SCHED;
            PG8_STAGE(PG8_SB(0, 1), b2 + hstep, voffB);
            PG8_WAIT_V(6); PG8_BAR; PG8_MMA(1, 1, At, B1); PG8_BAR;
            PG8_LDB(B0, 1, 0); PG8_SCHED; PG8_LDA(At, 1, 0); PG8_STAGE(PG8_SA(0, 1), a2 + hstep, voffA);
            PG8_WAIT_L(8); PG8_BAR; PG8_WAIT_L(0); PG8_MMA(0, 0, At, B0); PG8_BAR; PG8_SCHED;
            PG8_LDB(B1, 1, 1); PG8_STAGE(PG8_SB(1, 0), b3, voffB);
            PG8_BAR; PG8_WAIT_L(0); PG8_MMA(0, 1, At, B1); PG8_BAR;
            PG8_LDA(At, 1, 1); PG8_STAGE(PG8_SA(1, 0), a3, voffA);
            PG8_BAR; PG8_WAIT_L(0); PG8_MMA(1, 0, At, B0); PG8_BAR; PG8_SCHED;
            PG8_STAGE(PG8_SB(1, 1), b3 + hstep, voffB);
            PG8_WAIT_V(6); PG8_BAR; PG8_MMA(1, 1, At, B1); PG8_BAR;
            }
        }
        if constexpr (ALIGN_EPI) { if (wr == 0) PG8_BAR; }
        if constexpr (!Epi::AFTER_DRAIN) { E(acc, cur, wr, wc, fr, fq); S.done(cur); }
        if (!has_next) break;
#pragma unroll
        for (int a = 0; a < 2; ++a)
#pragma unroll
            for (int b = 0; b < 2; ++b)
#pragma unroll
                for (int m = 0; m < 4; ++m)
#pragma unroll
                    for (int n = 0; n < 2; ++n) acc[a][b][m][n] = (f32x4){0.f, 0.f, 0.f, 0.f};
        cur = nxt; cA = nA; cB = nB; ++ui;
        if constexpr (ALIGN_EPI) { if (wr == 1) PG8_BAR; }
    }
    PG8_WAIT_V(0);
    if constexpr (!ALIGN_EPI) { if (wr == 0) PG8_BAR; }
    PG8_BAR;
    if constexpr (Epi::AFTER_DRAIN) { E.fused(acc, cur, wr, wc, fr, fq, lds, wid, lane); S.done(cur); }
#undef PG8_SA
#undef PG8_SB
#undef PG8_STAGE
#undef PG8_LDA
#undef PG8_LDB
#undef PG8_MMA
#undef PG8_WAIT_V
#undef PG8_WAIT_L
#undef PG8_BAR
#undef PG8_SCHED
}
}

#define LAS __attribute__((address_space(3)))
typedef unsigned short bf16;
typedef short bf16x8 __attribute__((ext_vector_type(8)));
typedef short s16x4 __attribute__((ext_vector_type(4)));
typedef float f32x4 __attribute__((ext_vector_type(4)));
typedef float f32x2 __attribute__((ext_vector_type(2)));
typedef float f32x16 __attribute__((ext_vector_type(16)));
typedef unsigned u32x4 __attribute__((ext_vector_type(4)));
typedef unsigned u32x2 __attribute__((ext_vector_type(2)));

constexpr int BATCH = 16, SEQ = 4096, DM = 1024, M = BATCH * SEQ, INW = 5120, DFF = 4096;
constexpr float QSCALE = 0.125f * 1.4426950408889634f;
constexpr size_t MiB = 1u << 20;
constexpr size_t WS_XN = 0, WS_QA = 128 * MiB, WS_KA = 192 * MiB, WS_VA = 256 * MiB, WS_QB = 320 * MiB, WS_KB = 384 * MiB, WS_VB = 448 * MiB;
constexpr size_t WS_SGA = 512 * MiB, WS_SGB = 640 * MiB, WS_AO2 = 768 * MiB, WS_ATTA = 832 * MiB, WS_ATTB = 896 * MiB;
constexpr size_t WS_WIN = 960 * MiB, WS_WA = 970 * MiB, WS_WB = 971 * MiB, WS_WOUT = 972 * MiB, WS_W1 = 974 * MiB, WS_W2 = 982 * MiB;
constexpr size_t WS_LSE = 990 * MiB, WS_SSQ1 = 996 * MiB, WS_SSQ2 = 1000 * MiB, WS_ROPE = 1004 * MiB, WS_CTL = 1005 * MiB, WS_END = 1006 * MiB;
constexpr size_t WS_AO0 = 0, WS_AO1 = 64 * MiB, WS_MERGED = 0, WS_X1B = WS_SGA, WS_H = 0;
constexpr int LDS_BYTES = 152576;
constexpr int NPHASE = 10;

#define MFMA32(a, b, c) __builtin_amdgcn_mfma_f32_32x32x16_bf16((a), (b), (c), 0, 0, 0)
__device__ __forceinline__ int crow(int r, int hi) { return (r & 3) + 8 * (r >> 2) + 4 * hi; }
typedef __bf16 bf16x2_t __attribute__((ext_vector_type(2)));
__device__ __forceinline__ unsigned pk2(float lo, float hi) { f32x2 v = {lo, hi}; bf16x2_t b = __builtin_convertvector(v, bf16x2_t); return __builtin_bit_cast(unsigned, b); }
__device__ __forceinline__ float bflo(unsigned w) { return __uint_as_float(w << 16); }
__device__ __forceinline__ float bfhi(unsigned w) { return __uint_as_float(w & 0xffff0000u); }
__device__ __forceinline__ float wave_sum(float v) {
#pragma unroll
    for (int o = 1; o < 64; o <<= 1) v += __shfl_xor(v, o);
    return v;
}
__device__ __forceinline__ s16x4 vtr(const LAS unsigned char* p) {
    typedef short v4i16_t __attribute__((ext_vector_type(4)));
    return __builtin_bit_cast(s16x4, __builtin_amdgcn_ds_read_tr16_b64_v4i16((LAS v4i16_t*)p));
}
__device__ __forceinline__ bf16x8 cat8(s16x4 lo, s16x4 hi) { return (bf16x8){lo[0], lo[1], lo[2], lo[3], hi[0], hi[1], hi[2], hi[3]}; }
__device__ __forceinline__ bf16x8 pack8(const f32x16& x, int s) {
    u32x4 p; p.x = pk2(x[8 * s], x[8 * s + 1]); p.y = pk2(x[8 * s + 2], x[8 * s + 3]); p.z = pk2(x[8 * s + 4], x[8 * s + 5]); p.w = pk2(x[8 * s + 6], x[8 * s + 7]);
    return __builtin_bit_cast(bf16x8, p);
}
__device__ __forceinline__ float xhalf(float v) { return __shfl_xor(v, 32); }

struct Args {
    const float* x; const float* w_in; const float* w_a; const float* w_b; const float* w_out;
    const float* lq1; const float* lk1; const float* lq2; const float* lk2; const float* subln_g;
    const float* g_mix; const float* g_mlp; const float* w_ff1; const float* w_ff2; const float* g_final;
    float* out; unsigned char* ws; int ph_lo, ph_hi;
};

__device__ __forceinline__ void p0_transpose_item(const float* W, int K, int N, bf16* WT, const float* g, bool perm, LAS float* scr, int item, int lane, int pitch = 0) {
    if (pitch == 0) pitch = K;
    const int nblk = N / 32, kb = item / nblk, nb = item % nblk, k0 = 64 * kb, n0 = 32 * nb, l = lane & 31;
    int sc = n0 + l;
    if (perm) sc = (n0 & ~255) + 64 * ((n0 >> 5) & 3) + 32 * ((n0 >> 7) & 1) + l;
#pragma unroll 8
    for (int i = 0; i < 32; ++i) { const int kk = 2 * i + (lane >> 5); float v = W[(size_t)(k0 + kk) * N + sc]; if (g) v *= g[k0 + kk]; scr[kk * 33 + l] = v; }
    asm volatile("s_waitcnt lgkmcnt(0)" ::: "memory");
    const int c = lane & 7;
#pragma unroll
    for (int j = 0; j < 4; ++j) { const int n = (lane >> 3) + 8 * j; const LAS float* s = scr + (8 * c) * 33 + n;
        u32x4 o; o.x = pk2(s[0 * 33], s[1 * 33]); o.y = pk2(s[2 * 33], s[3 * 33]); o.z = pk2(s[4 * 33], s[5 * 33]); o.w = pk2(s[6 * 33], s[7 * 33]);
        *(u32x4*)(WT + (size_t)(n0 + n) * pitch + k0 + 8 * c) = o; }
    asm volatile("s_waitcnt lgkmcnt(0)" ::: "memory");
}
__device__ __forceinline__ void p0_prologue(const Args& A, LAS unsigned char* lds, int vcu, int G) {
    const int tid = threadIdx.x, lane = tid & 63, wave = tid >> 6;
    unsigned char* ws = A.ws;
    LAS float* scr = (LAS float*)(lds + wave * 8704);
    const int gw = vcu * 8 + wave, NGW = G * 8;
    constexpr int I_IN = 16 * 160, I_A = 8 * 32, I_B = 8 * 32, I_O = 16 * 32, I_1 = 16 * 128, I_2 = 64 * 32, NITEMS = I_IN + I_A + I_B + I_O + I_1 + I_2;
    for (int it = gw; it < NITEMS; it += NGW) {
        int r = it;
        if (r < I_IN) { const int n0 = 32 * (r % 160); const bool perm = (n0 < 1024) || (n0 >= 1536 && n0 < 2560);
            p0_transpose_item(A.w_in, 1024, INW, (bf16*)(ws + WS_WIN), nullptr, perm, scr, r, lane); continue; } r -= I_IN;
        if (r < I_A) { p0_transpose_item(A.w_a, 512, 1024, (bf16*)(ws + WS_WA), nullptr, false, scr, r, lane, 1024); continue; } r -= I_A;
        if (r < I_B) { p0_transpose_item(A.w_b, 512, 1024, (bf16*)(ws + WS_WA) + 512, nullptr, false, scr, r, lane, 1024); continue; } r -= I_B;
        if (r < I_O) { p0_transpose_item(A.w_out, 1024, 1024, (bf16*)(ws + WS_WOUT), nullptr, false, scr, r, lane); continue; } r -= I_O;
        if (r < I_1) { p0_transpose_item(A.w_ff1, 1024, DFF, (bf16*)(ws + WS_W1), A.g_mlp, false, scr, r, lane); continue; } r -= I_1;
        p0_transpose_item(A.w_ff2, DFF, 1024, (bf16*)(ws + WS_W2), nullptr, false, scr, r, lane);
    }
    for (int idx = (vcu * 512 + tid); idx < SEQ * 32; idx += G * 512) {
        const int pos = idx >> 5, i = idx & 31;
        const float inv = powf(10000.0f, -(float)(2 * i) / 64.0f);
        const float ang = (float)pos * inv;
        const double a = (double)ang;
        const double kq = rint(a * 0.63661977236758134308);
        const double r = fma(-kq, 1.57079632679489661923, a);
        const double r2 = r * r;
        double sp = 1.0 / 6227020800.0; sp = sp * r2 - 1.0 / 39916800.0; sp = sp * r2 + 1.0 / 362880.0; sp = sp * r2 - 1.0 / 5040.0; sp = sp * r2 + 1.0 / 120.0; sp = sp * r2 - 1.0 / 6.0; sp = sp * r2 + 1.0; sp *= r;
        double cp = 1.0 / 479001600.0; cp = cp * r2 - 1.0 / 3628800.0; cp = cp * r2 + 1.0 / 40320.0; cp = cp * r2 - 1.0 / 720.0; cp = cp * r2 + 1.0 / 24.0; cp = cp * r2 - 0.5; cp = cp * r2 + 1.0;
        const int q = ((int)kq) & 3;
        const double sv = (q == 0) ? sp : (q == 1) ? cp : (q == 2) ? -sp : -cp;
        const double cv = (q == 0) ? cp : (q == 1) ? -sp : (q == 2) ? -cp : sp;
        ((f32x2*)(ws + WS_ROPE))[idx] = (f32x2){(float)cv, (float)sv};
    }
    bf16* XN = (bf16*)(ws + WS_XN);
    f32x4 gv[4];
#pragma unroll
    for (int j = 0; j < 4; ++j) gv[j] = ((const f32x4*)A.g_mix)[lane + 64 * j];
    for (int m = gw; m < M; m += NGW) {
        const f32x4* xr = (const f32x4*)(A.x + (size_t)m * DM) + lane;
        f32x4 v[4]; float s = 0.f;
#pragma unroll
        for (int j = 0; j < 4; ++j) { v[j] = __builtin_nontemporal_load(xr + 64 * j); s += (v[j].x * v[j].x + v[j].y * v[j].y) + (v[j].z * v[j].z + v[j].w * v[j].w); }
        const float rstd = 1.0f / sqrtf(wave_sum(s) * (1.0f / DM) + 1e-6f);
        u32x2* o8 = (u32x2*)(XN + (size_t)m * DM) + lane;
#pragma unroll
        for (int j = 0; j < 4; ++j) { u32x2 w; w.x = pk2(v[j].x * rstd * gv[j].x, v[j].y * rstd * gv[j].y); w.y = pk2(v[j].z * rstd * gv[j].z, v[j].w * rstd * gv[j].w); o8[64 * j] = w; }
    }
}

struct EpiIn {
    static constexpr bool PERM = true, AFTER_DRAIN = false, MIDK = false, RELAX = true;
    unsigned char* ws;
    __device__ __forceinline__ void operator()(const f32x4 (&acc)[2][2][4][2], const pg8::Unit& u, int wr, int wc, int fr, int fq) const {
        const int pn = u.pn, row0 = u.pm * 256 + wr * 64 + fr;
        if (pn >= 12) {
            unsigned char* dst = (unsigned char*)(ws + (pn >= 16 ? WS_SGB : WS_SGA)); const int colt = ((pn - 12) & 3) * 256 + wc * 32 + 8 * fq;
#pragma unroll
            for (int ai = 0; ai < 2; ++ai)
#pragma unroll
                for (int m = 0; m < 4; ++m) { unsigned char* rp = dst + (size_t)(row0 + ai * 128 + m * 16) * 1024 + colt;
#pragma unroll
                    for (int bj = 0; bj < 2; ++bj) { float sg[8];
#pragma unroll
                        for (int j = 0; j < 8; ++j) sg[j] = fmaxf(255.0f * __builtin_amdgcn_rcpf(1.0f + __builtin_amdgcn_exp2f(-1.4426950408889634f * acc[ai][bj][m][j >> 2][j & 3])), 1.0f);
                        u32x2 w; w.x = 0u; w.y = 0u;
                        w.x = __builtin_amdgcn_cvt_pk_u8_f32(sg[0], 0, w.x); w.x = __builtin_amdgcn_cvt_pk_u8_f32(sg[1], 1, w.x); w.x = __builtin_amdgcn_cvt_pk_u8_f32(sg[2], 2, w.x); w.x = __builtin_amdgcn_cvt_pk_u8_f32(sg[3], 3, w.x);
                        w.y = __builtin_amdgcn_cvt_pk_u8_f32(sg[4], 0, w.y); w.y = __builtin_amdgcn_cvt_pk_u8_f32(sg[5], 1, w.y); w.y = __builtin_amdgcn_cvt_pk_u8_f32(sg[6], 2, w.y); w.y = __builtin_amdgcn_cvt_pk_u8_f32(sg[7], 3, w.y);
                        *(u32x2*)(rp + bj * 128) = w; } }
        } else {
            const int reg = pn >> 1;
            bf16* dst = (bf16*)(ws + WS_QA + (size_t)reg * 64 * MiB);
            if (reg == 2 || reg == 5) {
                const int colt = (pn & 1) * 256 + wc * 32 + 8 * fq;
#pragma unroll
                for (int ai = 0; ai < 2; ++ai)
#pragma unroll
                    for (int m = 0; m < 4; ++m) { bf16* rp = dst + (size_t)(row0 + ai * 128 + m * 16) * 512 + colt;
#pragma unroll
                        for (int bj = 0; bj < 2; ++bj) { const f32x4 v0 = acc[ai][bj][m][0], v1 = acc[ai][bj][m][1];
                            u32x4 w; w.x = pk2(v0[0], v0[1]); w.y = pk2(v0[2], v0[3]); w.z = pk2(v1[0], v1[1]); w.w = pk2(v1[2], v1[3]); *(u32x4*)(rp + bj * 128) = w; } }
            } else {
                const float sc = (reg == 0 || reg == 3) ? QSCALE : 1.0f;
                const f32x4* rope = (const f32x4*)(ws + WS_ROPE);
                const int head = 4 * (pn & 1) + wc;
#pragma unroll
                for (int ai = 0; ai < 2; ++ai)
#pragma unroll
                    for (int m = 0; m < 4; ++m) { const int row = row0 + ai * 128 + m * 16, pos = row & (SEQ - 1);
                        const f32x4* tp = rope + ((pos * 32 + 8 * fq) >> 1);
                        const f32x4 t0 = tp[0], t1 = tp[1], t2 = tp[2], t3 = tp[3];
                        const float cs[8] = {t0[0], t0[2], t1[0], t1[2], t2[0], t2[2], t3[0], t3[2]}, sn[8] = {t0[1], t0[3], t1[1], t1[3], t2[1], t2[3], t3[1], t3[3]};
                        float o1[8], o2[8];
#pragma unroll
                        for (int j = 0; j < 8; ++j) { const float x1 = acc[ai][0][m][j >> 2][j & 3], x2 = acc[ai][1][m][j >> 2][j & 3];
                            o1[j] = (x1 * cs[j] - x2 * sn[j]) * sc; o2[j] = (x2 * cs[j] + x1 * sn[j]) * sc; }
                        bf16* rp = dst + (size_t)row * 512 + head * 64 + 8 * fq;
                        u32x4 w1, w2; w1.x = pk2(o1[0], o1[1]); w1.y = pk2(o1[2], o1[3]); w1.z = pk2(o1[4], o1[5]); w1.w = pk2(o1[6], o1[7]);
                        w2.x = pk2(o2[0], o2[1]); w2.y = pk2(o2[2], o2[3]); w2.z = pk2(o2[4], o2[5]); w2.w = pk2(o2[6], o2[7]);
                        *(u32x4*)rp = w1; *(u32x4*)(rp + 32) = w2; }
            }
        }
    }
};
__device__ __forceinline__ void unpack8(const u32x4 g, float (&f)[8]) { f[0] = bflo(g.x); f[1] = bfhi(g.x); f[2] = bflo(g.y); f[3] = bfhi(g.y); f[4] = bflo(g.z); f[5] = bfhi(g.z); f[6] = bflo(g.w); f[7] = bfhi(g.w); }
template <int PASS> struct EpiGate {
    static constexpr bool PERM = true, AFTER_DRAIN = false, MIDK = false, RELAX = false;
    const bf16* SG; bf16* MG;
    __device__ __forceinline__ void operator()(const f32x4 (&acc)[2][2][4][2], const pg8::Unit& u, int wr, int wc, int fr, int fq) const {
        const int row0 = u.pm * 256 + wr * 64 + fr, col0 = u.pn * 256 + wc * 32 + 8 * fq;
#pragma unroll
        for (int ai = 0; ai < 2; ++ai)
#pragma unroll
            for (int m = 0; m < 4; ++m) { const size_t off = (size_t)(row0 + ai * 128 + m * 16) * 1024 + col0;
#pragma unroll
                for (int bj = 0; bj < 2; ++bj) { const size_t o = off + bj * 128; const f32x4 v0 = acc[ai][bj][m][0], v1 = acc[ai][bj][m][1];
                    float g[8]; unpack8(*(const u32x4*)(SG + o), g);
                    float r[8] = {v0[0] * g[0], v0[1] * g[1], v0[2] * g[2], v0[3] * g[3], v1[0] * g[4], v1[1] * g[5], v1[2] * g[6], v1[3] * g[7]};
                    if (PASS == 1) { float p[8]; unpack8(*(const u32x4*)(MG + o), p);
#pragma unroll
                        for (int j = 0; j < 8; ++j) r[j] += p[j]; }
                    u32x4 w; w.x = pk2(r[0], r[1]); w.y = pk2(r[2], r[3]); w.z = pk2(r[4], r[5]); w.w = pk2(r[6], r[7]); *(u32x4*)(MG + o) = w; } }
    }
};
__device__ __forceinline__ void unpack8u(const u32x2 g, float (&f)[8]) {
    f[0] = (float)(g.x & 0xffu); f[1] = (float)((g.x >> 8) & 0xffu); f[2] = (float)((g.x >> 16) & 0xffu); f[3] = (float)(g.x >> 24);
    f[4] = (float)(g.y & 0xffu); f[5] = (float)((g.y >> 8) & 0xffu); f[6] = (float)((g.y >> 16) & 0xffu); f[7] = (float)(g.y >> 24);
}
struct EpiGate2 {
    static constexpr bool PERM = true, AFTER_DRAIN = false, MIDK = true, RELAX = false;
    const unsigned char* SGA_; const unsigned char* SGB_; bf16* MG;
    __device__ __forceinline__ void mid(f32x4 (&acc)[2][2][4][2], const pg8::Unit& u, int wr, int wc, int fr, int fq) const {
        int row0 = u.pm * 256 + wr * 64 + fr, col0 = u.pn * 256 + wc * 32 + 8 * fq;
        asm volatile("" : "+v"(row0), "+v"(col0));
#pragma unroll
        for (int ai = 0; ai < 2; ++ai)
#pragma unroll
            for (int m = 0; m < 4; ++m) { const size_t off = (size_t)(row0 + ai * 128 + m * 16) * 1024 + col0;
#pragma unroll
                for (int bj = 0; bj < 2; ++bj) { const size_t o = off + bj * 128; float ga[8], gb[8]; unpack8u(*(const u32x2*)(SGA_ + o), ga); unpack8u(*(const u32x2*)(SGB_ + o), gb);
#pragma unroll
                    for (int j = 0; j < 8; ++j) acc[ai][bj][m][j >> 2][j & 3] *= ga[j] * __builtin_amdgcn_rcpf(gb[j]);
                    asm volatile("" ::: "memory"); } }
    }
    __device__ __forceinline__ void operator()(const f32x4 (&acc)[2][2][4][2], const pg8::Unit& u, int wr, int wc, int fr, int fq) const {
        const int row0 = u.pm * 256 + wr * 64 + fr, col0 = u.pn * 256 + wc * 32 + 8 * fq;
#pragma unroll
        for (int ai = 0; ai < 2; ++ai)
#pragma unroll
            for (int m = 0; m < 4; ++m) { const size_t off = (size_t)(row0 + ai * 128 + m * 16) * 1024 + col0;
#pragma unroll
                for (int bj = 0; bj < 2; ++bj) { const size_t o = off + bj * 128; const f32x4 v0 = acc[ai][bj][m][0] * (1.0f / 255.0f), v1 = acc[ai][bj][m][1] * (1.0f / 255.0f);
                    float g[8]; unpack8u(*(const u32x2*)(SGB_ + o), g);
                    u32x4 w; w.x = pk2(v0[0] * g[0], v0[1] * g[1]); w.y = pk2(v0[2] * g[2], v0[3] * g[3]); w.z = pk2(v1[0] * g[4], v1[1] * g[5]); w.w = pk2(v1[2] * g[6], v1[3] * g[7]); *(u32x4*)(MG + o) = w; } }
    }
};
struct EpiRes1 {
    static constexpr bool PERM = true, AFTER_DRAIN = false, MIDK = false, RELAX = false;
    const float* xi; bf16* xb; float* ssq;
    __device__ __forceinline__ void operator()(const f32x4 (&acc)[2][2][4][2], const pg8::Unit& u, int wr, int wc, int fr, int fq) const {
        const int row0 = u.pm * 256 + wr * 64 + fr, col0 = u.pn * 256 + wc * 32 + 8 * fq;
#pragma unroll
        for (int ai = 0; ai < 2; ++ai)
#pragma unroll
            for (int m = 0; m < 4; ++m) { const int row = row0 + ai * 128 + m * 16; const size_t off = (size_t)row * 1024 + col0; float ss = 0.f;
#pragma unroll
                for (int bj = 0; bj < 2; ++bj) { const size_t o = off + bj * 128;
                    const f32x4 v0 = *(const f32x4*)(xi + o) + acc[ai][bj][m][0], v1 = *(const f32x4*)(xi + o + 4) + acc[ai][bj][m][1];
                    ss += (v0[0] * v0[0] + v0[1] * v0[1]) + (v0[2] * v0[2] + v0[3] * v0[3]) + (v1[0] * v1[0] + v1[1] * v1[1]) + (v1[2] * v1[2] + v1[3] * v1[3]);
                    u32x4 w; w.x = pk2(v0[0], v0[1]); w.y = pk2(v0[2], v0[3]); w.z = pk2(v1[0], v1[1]); w.w = pk2(v1[2], v1[3]); *(u32x4*)(xb + o) = w; }
                ss += __shfl_xor(ss, 16); ss += __shfl_xor(ss, 32);
                if (fq == 0) ssq[(size_t)row * 16 + u.pn * 4 + wc] = ss; }
    }
};
struct EpiFF1 {
    static constexpr bool PERM = true, AFTER_DRAIN = false, MIDK = false, RELAX = true;
    bf16* H;
    __device__ __forceinline__ void operator()(const f32x4 (&acc)[2][2][4][2], const pg8::Unit& u, int wr, int wc, int fr, int fq) const {
        const int row0 = u.pm * 256 + wr * 64 + fr, col0 = u.pn * 256 + wc * 32 + 8 * fq;
#pragma unroll
        for (int ai = 0; ai < 2; ++ai)
#pragma unroll
            for (int m = 0; m < 4; ++m) { bf16* rp = H + (size_t)(row0 + ai * 128 + m * 16) * DFF + col0;
#pragma unroll
                for (int bj = 0; bj < 2; ++bj) { f32x4 v0 = acc[ai][bj][m][0], v1 = acc[ai][bj][m][1];
#pragma unroll
                    for (int j = 0; j < 4; ++j) { const float t0 = fmaxf(v0[j], 0.f), t1 = fmaxf(v1[j], 0.f); v0[j] = t0 * t0; v1[j] = t1 * t1; }
                    u32x4 w; w.x = pk2(v0[0], v0[1]); w.y = pk2(v0[2], v0[3]); w.z = pk2(v1[0], v1[1]); w.w = pk2(v1[2], v1[3]); *(u32x4*)(rp + bj * 128) = w; } }
    }
};
struct EpiRes2 {
    static constexpr bool PERM = true, AFTER_DRAIN = false, MIDK = false, RELAX = false;
    const bf16* xb; const float* ssq1; float* xo; float* ssq2;
    __device__ __forceinline__ void operator()(const f32x4 (&acc)[2][2][4][2], const pg8::Unit& u, int wr, int wc, int fr, int fq) const {
        const int row0 = u.pm * 256 + wr * 64 + fr, col0 = u.pn * 256 + wc * 32 + 8 * fq;
#pragma unroll
        for (int ai = 0; ai < 2; ++ai)
#pragma unroll
            for (int m = 0; m < 4; ++m) { const int row = row0 + ai * 128 + m * 16; const size_t off = (size_t)row * 1024 + col0;
                const f32x4 pt = *(const f32x4*)(ssq1 + (size_t)row * 16 + 4 * fq); float s = (pt[0] + pt[1]) + (pt[2] + pt[3]);
                s += __shfl_xor(s, 16); s += __shfl_xor(s, 32);
                const float r2 = 1.0f / (s * (1.0f / DM) + 1e-6f);
                float ss = 0.f;
#pragma unroll
                for (int bj = 0; bj < 2; ++bj) { const size_t o = off + bj * 128; float x1[8]; unpack8(*(const u32x4*)(xb + o), x1);
                    const f32x4 a0 = acc[ai][bj][m][0], a1 = acc[ai][bj][m][1];
                    const f32x4 v0 = {x1[0] + r2 * a0[0], x1[1] + r2 * a0[1], x1[2] + r2 * a0[2], x1[3] + r2 * a0[3]}, v1 = {x1[4] + r2 * a1[0], x1[5] + r2 * a1[1], x1[6] + r2 * a1[2], x1[7] + r2 * a1[3]};
                    ss += (v0[0] * v0[0] + v0[1] * v0[1]) + (v0[2] * v0[2] + v0[3] * v0[3]) + (v1[0] * v1[0] + v1[1] * v1[1]) + (v1[2] * v1[2] + v1[3] * v1[3]);
                    *(f32x4*)(xo + o) = v0; *(f32x4*)(xo + o + 4) = v1; }
                ss += __shfl_xor(ss, 16); ss += __shfl_xor(ss, 32);
                if (fq == 0) ssq2[(size_t)row * 16 + u.pn * 4 + wc] = ss; }
    }
};

struct EpiFinal {
    static constexpr bool PERM = true, AFTER_DRAIN = false, MIDK = false, RELAX = false;
    const bf16* xb; const float* ssq1; float* out; const float* gfin; float* slot; unsigned* cnt; LAS unsigned char* xl;
    __device__ __forceinline__ void operator()(const f32x4 (&acc_)[2][2][4][2], const pg8::Unit& u, int wr, int wc, int fr, int fq) const {
        f32x4 (&acc)[2][2][4][2] = const_cast<f32x4 (&)[2][2][4][2]>(acc_);
        const int tid = threadIdx.x, lane = tid & 63, wid = tid >> 6;
        const int row0 = u.pm * 256 + wr * 64 + fr, col0 = u.pn * 256 + wc * 32 + 8 * fq;
        LAS float* P = (LAS float*)xl; LAS float* S = (LAS float*)(xl + 4096); LAS unsigned* flag = (LAS unsigned*)(xl + 5120);
#pragma unroll
        for (int ai = 0; ai < 2; ++ai)
#pragma unroll
            for (int m = 0; m < 4; ++m) { const int rl = ai * 128 + wr * 64 + m * 16 + fr, row = u.pm * 256 + rl;
                const f32x4 pt = *(const f32x4*)(ssq1 + (size_t)row * 16 + 4 * fq); float s = (pt[0] + pt[1]) + (pt[2] + pt[3]);
                s += __shfl_xor(s, 16); s += __shfl_xor(s, 32);
                const float r2 = 1.0f / (s * (1.0f / DM) + 1e-6f);
                float ss = 0.f;
#pragma unroll
                for (int bj = 0; bj < 2; ++bj) { float x1[8]; unpack8(*(const u32x4*)(xb + (size_t)row * 1024 + col0 + bj * 128), x1);
#pragma unroll
                    for (int j = 0; j < 8; ++j) { const float v = x1[j] + r2 * acc[ai][bj][m][j >> 2][j & 3]; acc[ai][bj][m][j >> 2][j & 3] = v; ss += v * v; } }
                ss += __shfl_xor(ss, 16); ss += __shfl_xor(ss, 32);
                if (fq == 0) P[rl * 4 + wc] = ss; }
        asm volatile("s_waitcnt lgkmcnt(0)" ::: "memory"); __builtin_amdgcn_s_barrier(); asm volatile("" ::: "memory");
        const int prow = wid * 32 + (lane & 31);
        if (lane < 32) { const float t = (P[prow * 4 + 0] + P[prow * 4 + 1]) + (P[prow * 4 + 2] + P[prow * 4 + 3]);
            __hip_atomic_store(slot + ((size_t)(u.pm * 256 + prow) * 4 + u.pn), t, __ATOMIC_RELAXED, __HIP_MEMORY_SCOPE_AGENT); }
        asm volatile("s_waitcnt vmcnt(0)" ::: "memory");
        if (lane == 0) __hip_atomic_fetch_add(cnt + 64 * u.pm, 1u, __ATOMIC_RELAXED, __HIP_MEMORY_SCOPE_AGENT);
        if (wid == 0) { unsigned sp = 0;
            while ((unsigned)__builtin_amdgcn_readfirstlane(__hip_atomic_load(cnt + 64 * u.pm, __ATOMIC_RELAXED, __HIP_MEMORY_SCOPE_AGENT)) < 32u) { __builtin_amdgcn_s_sleep(2); if (++sp > (1u << 12)) break; }
            __builtin_amdgcn_fence(__ATOMIC_ACQUIRE, "agent");
            if (lane == 0) flag[0] = 1u; }
        asm volatile("s_waitcnt vmcnt(0) lgkmcnt(0)" ::: "memory"); __builtin_amdgcn_s_barrier(); asm volatile("" ::: "memory");
        if (lane < 32) { const float* sl = slot + (size_t)(u.pm * 256 + prow) * 4; float t = 0.f;
#pragma unroll
            for (int k = 0; k < 4; ++k) t += __hip_atomic_load(sl + k, __ATOMIC_RELAXED, __HIP_MEMORY_SCOPE_AGENT);
            S[prow] = 1.0f / sqrtf(t * (1.0f / DM) + 1e-6f); }
        asm volatile("s_waitcnt vmcnt(0) lgkmcnt(0)" ::: "memory"); __builtin_amdgcn_s_barrier(); asm volatile("" ::: "memory");
#pragma unroll
        for (int bj = 0; bj < 2; ++bj) { const f32x4 g0 = *(const f32x4*)(gfin + col0 + bj * 128), g1 = *(const f32x4*)(gfin + col0 + bj * 128 + 4);
#pragma unroll
            for (int ai = 0; ai < 2; ++ai)
#pragma unroll
                for (int m = 0; m < 4; ++m) { const int rl = ai * 128 + wr * 64 + m * 16 + fr; const float rs = S[rl];
                    float* o = out + (size_t)(u.pm * 256 + rl) * 1024 + col0 + bj * 128;
                    *(f32x4*)o = acc[ai][bj][m][0] * rs * g0; *(f32x4*)(o + 4) = acc[ai][bj][m][1] * rs * g1; } }
        asm volatile("s_waitcnt lgkmcnt(0)" ::: "memory"); __builtin_amdgcn_s_barrier(); asm volatile("" ::: "memory");
    }
};

constexpr int AK_CH = 384 * 16 + 16, AV_DB = 384 * 64 + 64, AV_OFF = 8 * AK_CH, AV_BUF = 2 * AV_DB;
#define GLDS16(gsrc, ldst) do { unsigned keep_; asm volatile("s_mov_b32 %0, m0\n\ts_mov_b32 m0, %2\n\ts_nop 0\n\tglobal_load_lds_dwordx4 %1, off\n\ts_mov_b32 m0, %0" : "=&s"(keep_) : "v"(gsrc), "s"((unsigned)__builtin_amdgcn_readfirstlane(ldst)) : "memory"); } while (0)
struct AUnit { int p, sh, ls, ph, t0, head; size_t rowb; };
__device__ __forceinline__ AUnit attnA_decode(int unit) {
    AUnit a; const int u16 = unit & 15; a.p = (unit >> 4) % 3; a.head = (unit / 48) & 7; a.rowb = (size_t)(unit / 384) * SEQ;
    a.sh = 2 * a.p; a.ls = SEQ >> a.sh; a.ph = u16 & ((1 << a.sh) - 1); a.t0 = 256 * (u16 >> a.sh); return a;
}
__device__ __forceinline__ void attnA_dma(LAS unsigned char* lds, const unsigned char* ws, int unit, int vbuf, int wid, int lane) {
    const AUnit a = attnA_decode(unit);
    const bf16* KA = (const bf16*)(ws + WS_KA); const bf16* VA = (const bf16*)(ws + WS_VA);
    const unsigned ldsb = (unsigned)(unsigned long)lds;
#pragma unroll
    for (int k = 0; k < 6; ++k) { const int idx = wid * 6 + k, lr = 8 * idx + (lane >> 3); int t = a.t0 - 64 + lr; t = t < 0 ? 0 : (t > a.ls - 1 ? a.ls - 1 : t);
        const bf16* g = KA + (a.rowb + ((size_t)t << a.sh) + a.ph) * 512 + a.head * 64 + (((lane & 7) ^ ((lr >> 1) & 7)) * 8); GLDS16(g, ldsb + idx * 1024); }
#pragma unroll
    for (int k = 0; k < 6; ++k) { const int idx = wid * 6 + k, dblk = idx / 24, rg = idx % 24; int t = a.t0 - 64 + rg * 16 + (lane >> 2); t = t < 0 ? 0 : (t > a.ls - 1 ? a.ls - 1 : t);
        const bf16* g = VA + (a.rowb + ((size_t)t << a.sh) + a.ph) * 512 + a.head * 64 + dblk * 32 + (lane & 3) * 8; GLDS16(g, ldsb + vbuf + dblk * AV_DB + rg * 1024); }
}
__device__ __forceinline__ void attnA_phase(LAS unsigned char* lds, const unsigned char* ws, int vcu, int G) {
    const int tid = threadIdx.x, lane = tid & 63, w = __builtin_amdgcn_readfirstlane(tid >> 6), r = lane & 31, h = lane >> 5;
    constexpr int NU = BATCH * 8 * 3 * 16;
    const bf16* QA = (const bf16*)(ws + WS_QA);
    if (vcu < NU) attnA_dma(lds, ws, vcu, AV_OFF, w, lane);
    int it = 0;
    bf16x8 qn[4];
    if (vcu < NU) { const AUnit a = attnA_decode(vcu); const size_t qr = a.rowb + ((size_t)(a.t0 + 32 * w + r) << a.sh) + a.ph;
#pragma unroll
        for (int ks = 0; ks < 4; ++ks) qn[ks] = *(const bf16x8*)(QA + qr * 512 + a.head * 64 + 16 * ks + 8 * h); }
    for (int unit = vcu; unit < NU; unit += G, ++it) {
        const AUnit a = attnA_decode(unit);
        const int vbuf = AV_OFF + (it & 1) * AV_BUF;
        bf16* AO = (bf16*)(ws + (a.p == 0 ? WS_AO0 : a.p == 1 ? WS_AO1 : WS_AO2)); float* LSE = (float*)(ws + WS_LSE) + (size_t)a.p * M * 8;
        const int tq = a.t0 + 32 * w + r; const size_t qrow = a.rowb + ((size_t)tq << a.sh) + a.ph;
        bf16x8 qf[4];
#pragma unroll
        for (int ks = 0; ks < 4; ++ks) qf[ks] = qn[ks];
        asm volatile("s_waitcnt vmcnt(0)" ::: "memory");
        __syncthreads();
        f32x16 s[5];
        {
            bf16x8 kf[2][4];
            const LAS unsigned char* kp = lds + (32 * w + r) * 128;
            int kx[4];
#pragma unroll
            for (int ks = 0; ks < 4; ++ks) kx[ks] = ((2 * ks + h) ^ ((r >> 1) & 7)) * 16;
#pragma unroll
            for (int ks = 0; ks < 4; ++ks) kf[0][ks] = *(const LAS bf16x8*)(kp + kx[ks]);
#pragma unroll
            for (int j = 0; j < 5; ++j) {
                if (j + 1 < 5) {
#pragma unroll
                    for (int ks = 0; ks < 4; ++ks) kf[(j + 1) & 1][ks] = *(const LAS bf16x8*)(kp + kx[ks] + (j + 1) * 4096); }
                __builtin_amdgcn_sched_barrier(0);
                f32x16 acc = {};
#pragma unroll
                for (int ks = 0; ks < 4; ++ks) acc = MFMA32(kf[j & 1][ks], qf[ks], acc);
                s[j] = acc;
                __builtin_amdgcn_sched_barrier(0);
            }
        }
        __syncthreads();
        if (unit + G < NU) { attnA_dma(lds, ws, unit + G, AV_OFF + ((it + 1) & 1) * AV_BUF, w, lane);
            const AUnit an = attnA_decode(unit + G); const size_t qr = an.rowb + ((size_t)(an.t0 + 32 * w + r) << an.sh) + an.ph;
#pragma unroll
            for (int ks = 0; ks < 4; ++ks) qn[ks] = *(const bf16x8*)(QA + qr * 512 + an.head * 64 + 16 * ks + 8 * h); }
        float mx = -INFINITY;
        if ((a.t0 - 64 + 32 * w >= 0) && (a.t0 + 32 * w + 96 <= a.ls)) {
#pragma unroll
            for (int i = 0; i < 16; ++i) { const int cr = crow(i, h);
                s[0][i] = (cr >= r) ? s[0][i] : -INFINITY; s[4][i] = (cr <= r) ? s[4][i] : -INFINITY; }
#pragma unroll
            for (int j = 0; j < 5; ++j)
#pragma unroll
                for (int i = 0; i < 16; ++i) mx = fmaxf(mx, s[j][i]);
        } else {
#pragma unroll
            for (int j = 0; j < 5; ++j)
#pragma unroll
                for (int i = 0; i < 16; ++i) { const int cr = crow(i, h), rel = 32 * j + cr - 64 - r, tk = a.t0 - 64 + 32 * w + 32 * j + cr;
                    const bool valid = (rel >= -64) && (rel <= 64) && (tk >= 0) && (tk < a.ls);
                    const float v = valid ? s[j][i] : -INFINITY; s[j][i] = v; mx = fmaxf(mx, v); }
        }
        mx = fmaxf(mx, xhalf(mx));
        float l = 0.f;
#pragma unroll
        for (int j = 0; j < 5; ++j)
#pragma unroll
            for (int i = 0; i < 16; ++i) { const float e = __builtin_amdgcn_exp2f(s[j][i] - mx); s[j][i] = e; l += e; }
        l += xhalf(l);
        f32x16 o[2] = {};
        const int i16 = lane & 15, qd = i16 >> 2, pp = i16 & 3, blk = (lane >> 4) & 1;
        const LAS unsigned char* vb = lds + vbuf + (32 * w + 4 * h + qd) * 64 + blk * 32 + pp * 8;
#pragma unroll
        for (int j = 0; j < 5; ++j)
#pragma unroll
            for (int sp = 0; sp < 2; ++sp) { const bf16x8 pf = pack8(s[j], sp);
#pragma unroll
                for (int db = 0; db < 2; ++db) { const LAS unsigned char* av = vb + db * AV_DB + (32 * j + 16 * sp) * 64;
                    const bf16x8 vf = cat8(vtr(av), vtr(av + 512)); o[db] = MFMA32(vf, pf, o[db]); } }
        const float rl = 1.0f / l;
        bf16* op = AO + qrow * 512 + a.head * 64 + 8 * h;
#pragma unroll
        for (int db = 0; db < 2; ++db)
#pragma unroll
            for (int gp = 0; gp < 2; ++gp) {
                unsigned a0 = pk2(o[db][8 * gp] * rl, o[db][8 * gp + 1] * rl), a1 = pk2(o[db][8 * gp + 2] * rl, o[db][8 * gp + 3] * rl);
                unsigned b0 = pk2(o[db][8 * gp + 4] * rl, o[db][8 * gp + 5] * rl), b1 = pk2(o[db][8 * gp + 6] * rl, o[db][8 * gp + 7] * rl);
                const auto s0 = __builtin_amdgcn_permlane32_swap(a0, b0, false, false); const auto s1 = __builtin_amdgcn_permlane32_swap(a1, b1, false, false);
                u32x4 wv; wv.x = s0[0]; wv.y = s1[0]; wv.z = s0[1]; wv.w = s1[1];
                *(u32x4*)(op + 32 * db + 16 * gp) = wv; }
        if (h == 0) LSE[qrow * 8 + a.head] = mx + __builtin_amdgcn_logf(l);
    }
    __syncthreads();
}

__device__ __forceinline__ void attnA_combine(const unsigned char* ws, int vcu, int G) {
    const bf16* A0 = (const bf16*)(ws + WS_AO0); const bf16* A1 = (const bf16*)(ws + WS_AO1); const bf16* A2 = (const bf16*)(ws + WS_AO2);
    const float* LSE = (const float*)(ws + WS_LSE); bf16* O = (bf16*)(ws + WS_ATTA);
    for (size_t it = (size_t)vcu * 512 + threadIdx.x; it < (size_t)M * 64; it += (size_t)G * 512) {
        const size_t rh = it >> 3;
        const float l0 = LSE[rh], l1 = LSE[(size_t)M * 8 + rh], l2 = LSE[(size_t)2 * M * 8 + rh];
        const float mx = fmaxf(l0, fmaxf(l1, l2));
        float w0 = __builtin_amdgcn_exp2f(l0 - mx), w1 = __builtin_amdgcn_exp2f(l1 - mx), w2 = __builtin_amdgcn_exp2f(l2 - mx);
        const float inv = 1.0f / (w0 + w1 + w2); w0 *= inv; w1 *= inv; w2 *= inv;
        const u32x4 a = *(const u32x4*)(A0 + it * 8), bq = *(const u32x4*)(A1 + it * 8), c = *(const u32x4*)(A2 + it * 8);
        u32x4 o;
#pragma unroll
        for (int k = 0; k < 4; ++k) o[k] = pk2(w0 * bflo(a[k]) + w1 * bflo(bq[k]) + w2 * bflo(c[k]), w0 * bfhi(a[k]) + w1 * bfhi(bq[k]) + w2 * bfhi(c[k]));
        *(u32x4*)(O + (it >> 6) * 1024 + (it & 63) * 8) = o;
    }
}

constexpr int BK_CH = 64 * 16 + 16, BK_IMG = 8 * BK_CH, BV_DB = 64 * 64 + 64, BV_IMG = 4 * BV_DB, BBUF = 2 * BK_IMG + BV_IMG;
__device__ __forceinline__ void attnB_unit(LAS unsigned char* lds, const unsigned char* ws, int unit, float lam, const float* subln_g, bool prefetched, int next_unit) {
    const int tid = threadIdx.x, lane = tid & 63, wid = __builtin_amdgcn_readfirstlane(tid >> 6), w = wid & 3, c = wid >> 2, r = lane & 31, h = lane >> 5;
    const int qb = unit & 31, hd = (unit >> 5) & 3, b = unit >> 7, q0 = qb * 128;
    const bf16* QB = (const bf16*)(ws + WS_QB); const bf16* KB = (const bf16*)(ws + WS_KB); const bf16* VB = (const bf16*)(ws + WS_VB); bf16* OB = (bf16*)(ws + WS_ATTA);
    const size_t rowb = (size_t)b * SEQ;
    const size_t qrow = rowb + q0 + 32 * w + r;
    bf16x8 qf[4];
#pragma unroll
    for (int ks = 0; ks < 4; ++ks) qf[ks] = *(const bf16x8*)(QB + qrow * 512 + hd * 128 + c * 64 + 16 * ks + 8 * h);
    const int rot = (qb * 2) & 63;
    const bf16* kg = KB + (rowb + lane) * 512 + hd * 128 + wid * 8;
    const bf16* vg0 = VB + (rowb + (wid & 3) * 16 + (lane >> 2)) * 512 + hd * 128 + (wid >> 2) * 32 + (lane & 3) * 8;
    const unsigned ldsb = (unsigned)(unsigned long)lds;
    const unsigned kd = ldsb + wid * BK_CH, vd0 = ldsb + 2 * BK_IMG + (wid >> 2) * BV_DB + (wid & 3) * 1024;
#define B_DMA(t, boff) do { const size_t go = (size_t)(((t) + rot) & 63) * 64 * 512; \
        GLDS16(kg + go, kd + (boff)); GLDS16(kg + go + 64, kd + BK_IMG + (boff)); GLDS16(vg0 + go, vd0 + (boff)); GLDS16(vg0 + go + 64, vd0 + 2 * BV_DB + (boff)); } while (0)
#define B_WAITBAR() do { asm volatile("s_waitcnt vmcnt(0)" ::: "memory"); __syncthreads(); } while (0)
#define B_QK(boff, S0, S1) do { const LAS unsigned char* kb_ = lds + (boff) + koff; _Pragma("unroll") for (int ks = 0; ks < 4; ++ks) { \
        const bf16x8 a0 = *(const LAS bf16x8*)(kb_ + 2 * ks * BK_CH), a1 = *(const LAS bf16x8*)(kb_ + 2 * ks * BK_CH + 512); \
        S0 = MFMA32(a0, qf[ks], S0); S1 = MFMA32(a1, qf[ks], S1); } } while (0)
    const int i16 = lane & 15, qd = i16 >> 2, pp = i16 & 3, blk = (lane >> 4) & 1;
    const int voff = 2 * BK_IMG + (4 * h + qd) * 64 + blk * 32 + pp * 8, koff = c * BK_IMG + h * BK_CH + r * 16;
    constexpr int NT = SEQ / 64;
    if (!prefetched) { B_DMA(0, 0); B_DMA(1, BBUF); }
    B_WAITBAR();
    f32x16 n0 = {}, n1 = {};
    B_QK(0, n0, n1);
    float mrow = fmaxf(n0[0], n1[0]);
#pragma unroll
    for (int i = 1; i < 16; ++i) mrow = fmaxf(mrow, fmaxf(n0[i], n1[i]));
    mrow = fmaxf(mrow, xhalf(mrow));
    f32x16 negm;
#pragma unroll
    for (int i = 0; i < 16; ++i) { negm[i] = -mrow; n0[i] -= mrow; n1[i] -= mrow; }
    f32x16 o[4] = {}; float l = 0.f;
#define SB() __builtin_amdgcn_sched_barrier(0)
#define B_ITER(t, bcur, bnext, bnn) do { \
        if ((t) + 2 < NT) B_DMA((t) + 2, bnn); \
        f32x16 s0 = n0, s1 = n1; bf16x8 kf[8]; \
        if ((t) + 1 < NT) { const LAS unsigned char* kb_ = lds + (bnext) + koff; \
            _Pragma("unroll") for (int ks = 0; ks < 4; ++ks) { kf[2 * ks] = *(const LAS bf16x8*)(kb_ + 2 * ks * BK_CH); kf[2 * ks + 1] = *(const LAS bf16x8*)(kb_ + 2 * ks * BK_CH + 512); } } \
        SB(); \
        float lsum = 0.f; bf16x8 pf[4]; \
        _Pragma("unroll") for (int i = 0; i < 16; ++i) { s0[i] = __builtin_amdgcn_exp2f(s0[i]); lsum += s0[i]; } \
        pf[0] = pack8(s0, 0); pf[1] = pack8(s0, 1); \
        SB(); \
        if ((t) + 1 < NT) { n0 = negm; n1 = negm; \
            _Pragma("unroll") for (int ks = 0; ks < 4; ++ks) { n0 = MFMA32(kf[2 * ks], qf[ks], n0); n1 = MFMA32(kf[2 * ks + 1], qf[ks], n1); } } \
        _Pragma("unroll") for (int i = 0; i < 16; ++i) { s1[i] = __builtin_amdgcn_exp2f(s1[i]); lsum += s1[i]; } \
        pf[2] = pack8(s1, 0); pf[3] = pack8(s1, 1); \
        l += lsum; \
        const LAS unsigned char* vb_ = lds + (bcur) + voff; \
        _Pragma("unroll") for (int kk = 0; kk < 4; ++kk) \
        _Pragma("unroll") for (int db = 0; db < 4; ++db) { const LAS unsigned char* a = vb_ + db * BV_DB + kk * 1024; \
                const bf16x8 vf = cat8(vtr(a), vtr(a + 512)); o[db] = MFMA32(vf, pf[kk], o[db]); } \
        if (__any(lsum > 0x1p40f)) { float ls2 = lsum + xhalf(lsum); const float d = ls2 > 0x1p40f ? floorf(__builtin_amdgcn_logf(ls2)) : 0.f, f = __builtin_amdgcn_exp2f(-d); l *= f; \
            _Pragma("unroll") for (int i = 0; i < 16; ++i) { negm[i] -= d; n0[i] -= d; n1[i] -= d; } \
            _Pragma("unroll") for (int db = 0; db < 4; ++db) _Pragma("unroll") for (int i = 0; i < 16; ++i) o[db][i] *= f; } \
        B_WAITBAR(); } while (0)
    for (int t3 = 0; t3 < NT - 1; t3 += 3) {
        B_ITER(t3, 0, BBUF, 2 * BBUF);
        B_ITER(t3 + 1, BBUF, 2 * BBUF, 0);
        B_ITER(t3 + 2, 2 * BBUF, 0, BBUF);
    }
    B_ITER(NT - 1, 0, BBUF, 2 * BBUF);
#undef B_ITER
#undef B_QK
#undef B_DMA
    if (next_unit >= 0) {
        const int qbn = next_unit & 31, hdn = (next_unit >> 5) & 3, rotn = (qbn * 2) & 63; const size_t rowbn = (size_t)(next_unit >> 7) * SEQ;
        const bf16* kgn = KB + (rowbn + lane) * 512 + hdn * 128 + wid * 8;
        const bf16* vgn = VB + (rowbn + (wid & 3) * 16 + (lane >> 2)) * 512 + hdn * 128 + (wid >> 2) * 32 + (lane & 3) * 8;
#pragma unroll
        for (int tt = 0; tt < 2; ++tt) { const size_t go = (size_t)((tt + rotn) & 63) * 64 * 512; const unsigned bo = tt * BBUF;
            GLDS16(kgn + go, kd + bo); GLDS16(kgn + go + 64, kd + BK_IMG + bo); GLDS16(vgn + go, vd0 + bo); GLDS16(vgn + go + 64, vd0 + 2 * BV_DB + bo); }
    }
    l += xhalf(l);
    const float rl = 1.0f / l;
    LAS float* ex = (LAS float*)(lds + 2 * BBUF) + w * 4096 + lane;
    if (c == 1) {
#pragma unroll
        for (int db = 0; db < 4; ++db)
#pragma unroll
            for (int i = 0; i < 16; ++i) ex[(db * 16 + i) * 64] = o[db][i] * rl;
    }
    __syncthreads();
    if (c == 0) {
        float ss = 0.f;
#pragma unroll
        for (int db = 0; db < 4; ++db)
#pragma unroll
            for (int i = 0; i < 16; ++i) { const float v = o[db][i] * rl - lam * ex[(db * 16 + i) * 64]; o[db][i] = v; ss += v * v; }
        ss += xhalf(ss);
        const float rs = 0.8f / sqrtf(ss * (1.0f / 128.0f) + 1e-5f);
        bf16* op = OB + qrow * 1024 + 512 + hd * 128 + 8 * h;
#pragma unroll
        for (int db = 0; db < 4; ++db)
#pragma unroll
            for (int gp = 0; gp < 2; ++gp) {
                const f32x4 ga = *(const f32x4*)(subln_g + 32 * db + 16 * gp + 4 * h), gb = *(const f32x4*)(subln_g + 32 * db + 16 * gp + 8 + 4 * h);
                unsigned a0 = pk2(o[db][8 * gp] * rs * ga[0], o[db][8 * gp + 1] * rs * ga[1]), a1 = pk2(o[db][8 * gp + 2] * rs * ga[2], o[db][8 * gp + 3] * rs * ga[3]);
                unsigned b0 = pk2(o[db][8 * gp + 4] * rs * gb[0], o[db][8 * gp + 5] * rs * gb[1]), b1 = pk2(o[db][8 * gp + 6] * rs * gb[2], o[db][8 * gp + 7] * rs * gb[3]);
                const auto s0 = __builtin_amdgcn_permlane32_swap(a0, b0, false, false); const auto s1 = __builtin_amdgcn_permlane32_swap(a1, b1, false, false);
                u32x4 wv; wv.x = s0[0]; wv.y = s1[0]; wv.z = s0[1]; wv.w = s1[1];
                *(u32x4*)(op + 32 * db + 16 * gp) = wv; }
    }
    __syncthreads();
}

#define XB_TMO      128
#define XB_XCNT(j)  (256  + 64 * (j))
#define XB_XSUB(j)  (1280 + 64 * (j))
#define XB_XGEN(j)  (2304 + 64 * (j))
#define XB_TOP      3328
#define XB_TOPGEN   3392
#define XCD_BAR_WORDS 3456
#define XB_SPIN_CAP (1u << 18)

__device__ __forceinline__ unsigned xb_ld(unsigned* p)              { return __hip_atomic_load(p, __ATOMIC_RELAXED, __HIP_MEMORY_SCOPE_AGENT); }
__device__ __forceinline__ unsigned xb_add(unsigned* p, unsigned v) { return __hip_atomic_fetch_add(p, v, __ATOMIC_RELAXED, __HIP_MEMORY_SCOPE_AGENT); }
__device__ __forceinline__ unsigned xb_xcc_id() { return (unsigned)__builtin_amdgcn_s_getreg((3 << 11) | 20) & 0xFu; }
#define XB_SPIN(cond, bar) do { unsigned _sp = 0; while (cond) { __builtin_amdgcn_s_sleep(1); \
    if ((++_sp & 255u) == 0u) { if (xb_ld(&(bar)[XB_TMO])) break; if (_sp > XB_SPIN_CAP) { atomicAdd(&(bar)[XB_TMO], 1u); break; } } } } while (0)

struct XcdBarrier {
    unsigned* bar; unsigned x;
    volatile LAS unsigned* st;
};

__device__ __forceinline__ XcdBarrier xcd_barrier_post(unsigned* bar, volatile LAS unsigned* st) {
    XcdBarrier b; b.bar = bar; b.x = xb_xcc_id(); b.st = st;
    if (threadIdx.x == 0) (void)xb_add(&bar[XB_XCNT(b.x)], 1u);
    return b;
}
__device__ __forceinline__ void xcd_barrier_complete(unsigned* bar, unsigned x, unsigned& nloc, unsigned& nx) {
    const unsigned G = gridDim.x * gridDim.y * gridDim.z;
    unsigned sum, cnt, mine, sp = 0u;
    for (;;) {
        sum = 0u; cnt = 0u; mine = 0u;
#pragma unroll
        for (unsigned j = 0; j < 16; ++j) { const unsigned c = xb_ld(&bar[XB_XCNT(j)]); sum += c; cnt += (c > 0u) ? 1u : 0u; mine = (j == x) ? c : mine; }
        if (sum == G) break;
        __builtin_amdgcn_s_sleep(1);
        if ((++sp & 255u) == 0u) { if (xb_ld(&bar[XB_TMO])) break; if (sp > XB_SPIN_CAP) { atomicAdd(&bar[XB_TMO], 1u); break; } }
    }
    nloc = mine > 0u ? mine : 1u; nx = cnt > 0u ? cnt : 1u;
}

__device__ __forceinline__ void xcd_barrier(const XcdBarrier& b) {
    asm volatile("s_waitcnt vmcnt(0)" ::: "memory");
    __syncthreads();
    if (threadIdx.x == 0) {
        unsigned* bar = b.bar;
        __builtin_amdgcn_s_waitcnt(0);
        unsigned nloc = b.st[0], nx = b.st[1];
        if (nloc == 0u) { xcd_barrier_complete(bar, b.x, nloc, nx); b.st[0] = nloc; b.st[1] = nx; }
        const unsigned old = xb_add(&bar[XB_XSUB(b.x)], 1u);
        const unsigned gen = old / nloc;
        if (old + 1u == (gen + 1u) * nloc) {
            __builtin_amdgcn_fence(__ATOMIC_RELEASE, "agent");
            asm volatile("s_waitcnt vmcnt(0)" ::: "memory");
            const unsigned og = xb_add(&bar[XB_TOP], 1u);
            const unsigned tg = og / nx;
            if (og + 1u == (tg + 1u) * nx) xb_add(&bar[XB_TOPGEN], 1u);
            else XB_SPIN(xb_ld(&bar[XB_TOPGEN]) == tg, bar);
            __builtin_amdgcn_fence(__ATOMIC_ACQUIRE, "agent");
            xb_add(&bar[XB_XGEN(b.x)], 1u);
            asm volatile("s_waitcnt vmcnt(0)" ::: "memory");
        } else {
            XB_SPIN(xb_ld(&bar[XB_XGEN(b.x)]) == gen, bar);
            __builtin_amdgcn_fence(__ATOMIC_ACQUIRE, "agent");
            asm volatile("s_waitcnt vmcnt(0)" ::: "memory");
        }
    }
    __syncthreads();
}


__global__ void __launch_bounds__(512, 2) fwd_kernel(Args A) {
    extern __shared__ __attribute__((aligned(16))) unsigned char lds_raw[];
    LAS unsigned char* lds = (LAS unsigned char*)lds_raw;
    const int G = gridDim.x, bx = blockIdx.x, tid = threadIdx.x;
    const int vcu = (G % 8 == 0) ? (bx % 8) * (G / 8) + bx / 8 : bx;
    unsigned char* ws = A.ws;
    const int lo = A.ph_lo, hi = A.ph_hi;
    volatile LAS unsigned* MISC = (volatile LAS unsigned*)(lds + 151552);
    if (tid < 16) MISC[tid] = 0u;
    __syncthreads();
    if (lo == -12345) cg::this_grid().sync();
    XcdBarrier bar = xcd_barrier_post((unsigned*)(ws + WS_CTL), MISC + 8);
#define IN(k) (lo <= (k) && (k) < hi)
#define SEAM(k) do { if (IN(k) && IN((k) + 1)) xcd_barrier(bar); } while (0)
    if (IN(0)) p0_prologue(A, lds, vcu, G);
    SEAM(0);
    if (IN(1)) {
        pg8::Gemm g{(const bf16*)(ws + WS_XN), (const bf16*)(ws + WS_WIN), M, INW, 1024}; pg8::StaticOrder S; S.init(M, INW, G, bx, 4);
        EpiIn E{ws};
        pg8::gemm_phase<EpiIn, pg8::StaticOrder, true, true>(lds, g, S, E);
    }
    SEAM(1);
    if (IN(2)) attnA_phase(lds, ws, vcu, G);
    SEAM(2);
    if (IN(3)) {
        attnA_combine(ws, vcu, G);
        float d1 = 0.f, d2 = 0.f;
        for (int i = 0; i < 64; ++i) { d1 += A.lq1[i] * A.lk1[i]; d2 += A.lq2[i] * A.lk2[i]; }
        const float lam = expf(d1) - expf(d2) + 0.2f;
        if (tid >= 256) __builtin_amdgcn_s_setprio(1);
        for (int u = vcu; u < BATCH * 4 * 32; u += G) attnB_unit(lds, ws, u, lam, A.subln_g, u != vcu, (u + G < BATCH * 4 * 32) ? u + G : -1);
        __builtin_amdgcn_s_setprio(0);
    }
    SEAM(3);
    if (IN(4)) {
        pg8::Gemm g{(const bf16*)(ws + WS_ATTA), (const bf16*)(ws + WS_WA), M, 1024, 1024}; pg8::StaticOrder S; S.init(M, 1024, G, bx);
        EpiGate2 E{(const unsigned char*)(ws + WS_SGA), (const unsigned char*)(ws + WS_SGB), (bf16*)(ws + WS_MERGED)};
        pg8::gemm_phase<EpiGate2, pg8::StaticOrder, true, true>(lds, g, S, E);
    }
    SEAM(4);
    if (IN(5)) {
        pg8::Gemm g{(const bf16*)(ws + WS_MERGED), (const bf16*)(ws + WS_WOUT), M, 1024, 1024}; pg8::StaticOrder S; S.init(M, 1024, G, bx);
        EpiRes1 E{A.x, (bf16*)(ws + WS_X1B), (float*)(ws + WS_SSQ1)};
        pg8::gemm_phase<EpiRes1, pg8::StaticOrder, true, true>(lds, g, S, E);
    }
    SEAM(5);
    if (IN(6)) {
        pg8::Gemm g{(const bf16*)(ws + WS_X1B), (const bf16*)(ws + WS_W1), M, DFF, 1024}; pg8::StaticOrder S; S.init(M, DFF, G, bx);
        EpiFF1 E{(bf16*)(ws + WS_H)};
        pg8::gemm_phase<EpiFF1, pg8::StaticOrder, true, true>(lds, g, S, E);
    }
    SEAM(6);
    if (IN(7)) {
        pg8::Gemm g{(const bf16*)(ws + WS_H), (const bf16*)(ws + WS_W2), M, 1024, DFF}; pg8::StaticOrder S; S.init(M, 1024, G, bx);
        EpiFinal E{(const bf16*)(ws + WS_X1B), (const float*)(ws + WS_SSQ1), A.out, A.g_final, (float*)(ws + WS_SSQ2), (unsigned*)(ws + WS_CTL + 65536), lds + 131072};
        pg8::gemm_phase<EpiFinal, pg8::StaticOrder, true, true>(lds, g, S, E);
    }
#undef IN
#undef SEAM
}

#ifndef MK_PER_PHASE
#define MK_PER_PHASE 0
#endif
extern "C" void kernel_launch(void* const* d_in, const int* in_sizes, int n_in, void* d_out, int out_size, void* d_ws, size_t ws_size, hipStream_t stream) {
    static int grid = 0;
    if (grid == 0) {
        if (n_in != 15 || in_sizes[0] != M * DM || out_size != M * DM || ws_size < WS_END) { fprintf(stderr, "kernel_launch: unexpected shapes / workspace (%d inputs, ws %zu)\n", n_in, ws_size); grid = -1; return; }
        int dev = 0, cus = 0, per_cu = 0;
        (void)hipGetDevice(&dev); (void)hipDeviceGetAttribute(&cus, hipDeviceAttributeMultiprocessorCount, dev);
        (void)hipFuncSetAttribute((const void*)fwd_kernel, hipFuncAttributeMaxDynamicSharedMemorySize, LDS_BYTES);
        (void)hipOccupancyMaxActiveBlocksPerMultiprocessor(&per_cu, (const void*)fwd_kernel, 512, LDS_BYTES);
        if (per_cu < 1) per_cu = 1;
        grid = cus * per_cu;
        fprintf(stderr, "kernel_launch: %d CUs x %d = grid %d\n", cus, per_cu, grid);
    }
    if (grid < 0) return;
    (void)hipMemsetAsync((unsigned char*)d_ws + WS_CTL, 0, 131072, stream);
    Args a{};
    a.x = (const float*)d_in[0]; a.w_in = (const float*)d_in[1]; a.w_a = (const float*)d_in[2]; a.w_b = (const float*)d_in[3]; a.w_out = (const float*)d_in[4];
    a.lq1 = (const float*)d_in[5]; a.lk1 = (const float*)d_in[6]; a.lq2 = (const float*)d_in[7]; a.lk2 = (const float*)d_in[8]; a.subln_g = (const float*)d_in[9];
    a.g_mix = (const float*)d_in[10]; a.g_mlp = (const float*)d_in[11]; a.w_ff1 = (const float*)d_in[12]; a.w_ff2 = (const float*)d_in[13]; a.g_final = (const float*)d_in[14];
    a.out = (float*)d_out; a.ws = (unsigned char*)d_ws;
#if MK_PER_PHASE
    for (int ph = 0; ph < NPHASE - 1; ++ph) { a.ph_lo = ph; a.ph_hi = ph + 1; hipLaunchKernelGGL(fwd_kernel, dim3(grid), dim3(512), LDS_BYTES, stream, a); }
#else
    a.ph_lo = 0; a.ph_hi = NPHASE;
    void* args[] = {&a};
    hipError_t e = hipLaunchCooperativeKernel((const void*)fwd_kernel, dim3(grid), dim3(512), args, LDS_BYTES, stream);
    if (e != hipSuccess) fprintf(stderr, "cooperative launch failed: %s (grid %d)\n", hipGetErrorString(e), grid);
#endif
}
```

```cpp
#include <hip/hip_runtime.h>
#include <hip/hip_cooperative_groups.h>
#include <cstdio>
#include <cstdint>
namespace cg = cooperative_groups;
namespace pg8 {
#define PG8_LAS __attribute__((address_space(3)))
typedef unsigned short bf16_t;
typedef short bf16x8 __attribute__((ext_vector_type(8)));
typedef float f32x4 __attribute__((ext_vector_type(4)));
typedef unsigned u32x4 __attribute__((ext_vector_type(4)));
constexpr int BM = 256, BK = 64, HALF = 128, HTB = HALF * BK * 2  , STAGE_BYTES = 8 * HTB, NXCD = 8, WGM = 8;

__host__ __device__ __forceinline__ int lds_byte(int r, int c) { const int st = (r >> 4) * 2 + (c >> 5), rr = r & 15, cc = c & 31, ob = rr * 64 + cc * 2; return st * 1024 + (ob ^ (((ob >> 9) & 1) << 5)); }
__host__ __device__ __forceinline__ void stage_rc(int b, int& R, int& C) { const int st = b / 1024, sb = b % 1024, swz = sb ^ (((sb >> 9) & 1) << 5); R = (st >> 1) * 16 + swz / 64; C = (st & 1) * 32 + (swz % 64) / 2; }
__host__ __device__ __forceinline__ int perm32(int rho) { const int n = rho >> 4, i = rho & 15; return 8 * (i >> 2) + 4 * n + (i & 3); }

struct Unit { int pm, pn; };
struct Gemm { const bf16_t* A; const bf16_t* Bt; int M, N, K; };

struct StaticOrder {
    int nM, nN, nwg, G, c, wgm;
    __host__ __device__ void init(int M, int N, int G_, int c_, int wgm_ = WGM) { nM = M / BM; nN = N / BM; nwg = nM * nN; G = G_; c = c_; wgm = wgm_; }
    __host__ __device__ bool next(int i, Unit& u) const {
        const long L = (long)i * G + c; if (L >= nwg) return false;
        int wgid = (int)L; { const int q = nwg / NXCD, r = nwg % NXCD, xcd = wgid % NXCD, off = wgid / NXCD; wgid = (xcd < r ? xcd * (q + 1) : r * (q + 1) + (xcd - r) * q) + off; }
        const int nig = wgm * nN, gid = wgid / nig, fm = gid * wgm, gsz = (nM - fm) < wgm ? (nM - fm) : wgm;
        u.pm = fm + ((wgid % nig) % gsz); u.pn = (wgid % nig) / gsz; return true;
    }
    __device__ __forceinline__ void a_ready(const Unit&) const {}
    __device__ __forceinline__ void done(const Unit&) const {}
};

__device__ __forceinline__ unsigned cvt_pk_bf16(float lo, float hi) { unsigned r; asm volatile("v_cvt_pk_bf16_f32 %0, %1, %2" : "=v"(r) : "v"(lo), "v"(hi)); return r; }
template <class Epi, class Sched, bool ALIGN_EPI = false, bool SP2 = false>
__device__ __forceinline__ void gemm_phase(PG8_LAS unsigned char* lds, const Gemm g, const Sched& S, const Epi& E) {
    const int tid = threadIdx.x, wid = __builtin_amdgcn_readfirstlane(tid >> 6), lane = tid & 63, wr = wid >> 2, wc = wid & 3, fr = lane & 15, fq = lane >> 4;
    const int K = g.K, nt = K / BK;
    unsigned voffA[2], voffB[2];
#pragma unroll
    for (int i = 0; i < 2; ++i) { int R, C; stage_rc(tid * 16 + i * 8192, R, C); const int Rb = Epi::PERM ? ((R & ~31) + perm32(R & 31)) : R;
        voffA[i] = (unsigned)(R * K + C) * 2u; voffB[i] = (unsigned)(Rb * K + C) * 2u; }
    const size_t kstep = (size_t)(BK * 2);
    const size_t hstep = (size_t)HALF * K * 2;
    const size_t tstep = 2 * hstep;
    const unsigned ldsw = (unsigned)wid * 1024u;
    const int aoff = lds_byte(wr * 64 + fr, fq * 8), boff = lds_byte(wc * 32 + fr, fq * 8);
#define PG8_SA(b, h) (((b) * 2 + (h)) * HTB)
#define PG8_SB(b, h) ((4 + (b) * 2 + (h)) * HTB)
#define PG8_STAGE(bufoff, gbase, voff) do { _Pragma("unroll") for (int _i = 0; _i < 2; ++_i) \
        __builtin_amdgcn_global_load_lds((const unsigned*)((const char*)(gbase) + (voff)[_i]), (PG8_LAS unsigned*)(lds + (bufoff) + ldsw + _i * 8192), 16, 0, 0); } while (0)
#define PG8_LDA(dst, b, h) do { _Pragma("unroll") for (int m = 0; m < 4; ++m) _Pragma("unroll") for (int k = 0; k < 2; ++k) dst[m][k] = *(const PG8_LAS bf16x8*)(lds + PG8_SA(b, h) + aoff + m * 2048 + k * 1024); } while (0)
#define PG8_LDB(dst, b, h) do { _Pragma("unroll") for (int n = 0; n < 2; ++n) _Pragma("unroll") for (int k = 0; k < 2; ++k) dst[n][k] = *(const PG8_LAS bf16x8*)(lds + PG8_SB(b, h) + boff + n * 2048 + k * 1024); } while (0)
#define PG8_MMA(ai, bj, At, Bt) do { __builtin_amdgcn_s_setprio(1); _Pragma("unroll") for (int m = 0; m < 4; ++m) _Pragma("unroll") for (int n = 0; n < 2; ++n) _Pragma("unroll") for (int k = 0; k < 2; ++k) \
        acc[ai][bj][m][n] = __builtin_amdgcn_mfma_f32_16x16x32_bf16(Bt[n][k], At[m][k], acc[ai][bj][m][n], 0, 0, 0); __builtin_amdgcn_s_setprio(0); } while (0)
#define PG8_WAIT_V(n) asm volatile("s_waitcnt vmcnt(" #n ")" ::: "memory")
#define PG8_WAIT_L(n) asm volatile("s_waitcnt lgkmcnt(" #n ")" ::: "memory")
#define PG8_BAR __builtin_amdgcn_s_barrier()
#define PG8_SCHED __builtin_amdgcn_sched_barrier(0)
    Unit cur, nxt; int ui = 0;
    if (!S.next(0, cur)) return;
    f32x4 acc[2][2][4][2];
#pragma unroll
    for (int a = 0; a < 2; ++a)
#pragma unroll
        for (int b = 0; b < 2; ++b)
#pragma unroll
            for (int m = 0; m < 4; ++m)
#pragma unroll
                for (int n = 0; n < 2; ++n) acc[a][b][m][n] = (f32x4){0.f, 0.f, 0.f, 0.f};
    bf16x8 At[4][2], B0[2][2], B1[2][2];
    const char* cA = (const char*)g.A + (size_t)cur.pm * tstep; const char* cB = (const char*)g.Bt + (size_t)cur.pn * tstep;
    S.a_ready(cur);
    if constexpr (SP2) {
        PG8_STAGE(PG8_SB(0, 0), cB, voffB); PG8_STAGE(PG8_SB(0, 1), cB + hstep, voffB); PG8_STAGE(PG8_SA(0, 0), cA, voffA); PG8_STAGE(PG8_SA(0, 1), cA + hstep, voffA);
        if (wr == 1) PG8_BAR;
        PG8_WAIT_V(2); PG8_BAR;
        PG8_STAGE(PG8_SB(1, 0), cB + kstep, voffB); PG8_STAGE(PG8_SA(1, 0), cA + kstep, voffA); PG8_STAGE(PG8_SB(1, 1), cB + hstep + kstep, voffB);
        PG8_WAIT_V(6); PG8_BAR;
    } else {
        PG8_STAGE(PG8_SB(0, 0), cB, voffB); PG8_STAGE(PG8_SA(0, 0), cA, voffA); PG8_STAGE(PG8_SB(0, 1), cB + hstep, voffB); PG8_STAGE(PG8_SA(0, 1), cA + hstep, voffA);
        if (wr == 1) PG8_BAR;
        PG8_WAIT_V(4); PG8_BAR;
        PG8_STAGE(PG8_SB(1, 0), cB + kstep, voffB); PG8_STAGE(PG8_SA(1, 0), cA + kstep, voffA); PG8_STAGE(PG8_SB(1, 1), cB + hstep + kstep, voffB);
        PG8_WAIT_V(6); PG8_BAR;
    }
    for (;;) {
        const bool has_next = S.next(ui + 1, nxt);
        const char* nA = has_next ? (const char*)g.A + (size_t)nxt.pm * tstep : cA; const char* nB = has_next ? (const char*)g.Bt + (size_t)nxt.pn * tstep : cB;
        int t_first = 0;
        if constexpr (SP2 && Epi::RELAX) { if (ui > 0) {
            size_t ks_ = kstep; asm volatile("" : "+s"(ks_));
            PG8_LDB(B0, 0, 0); PG8_LDB(B1, 0, 1); PG8_SCHED; PG8_LDA(At, 0, 0); PG8_STAGE(PG8_SA(1, 1), cA + ks_ + hstep, voffA);
            PG8_WAIT_V(24); PG8_WAIT_L(0); PG8_BAR; PG8_MMA(0, 0, At, B0); PG8_MMA(0, 1, At, B1); PG8_BAR; PG8_SCHED;
            PG8_LDA(At, 0, 1); PG8_STAGE(PG8_SB(0, 0), cB + 2 * ks_, voffB); PG8_STAGE(PG8_SB(0, 1), cB + 2 * ks_ + hstep, voffB); PG8_STAGE(PG8_SA(0, 0), cA + 2 * ks_, voffA);
            PG8_WAIT_V(24); PG8_WAIT_L(0); PG8_BAR; PG8_MMA(1, 0, At, B0); PG8_MMA(1, 1, At, B1); PG8_BAR; PG8_SCHED;
            PG8_LDB(B0, 1, 0); PG8_LDB(B1, 1, 1); PG8_SCHED; PG8_LDA(At, 1, 0); PG8_STAGE(PG8_SA(0, 1), cA + 2 * ks_ + hstep, voffA);
            PG8_WAIT_V(8); PG8_WAIT_L(0); PG8_BAR; PG8_MMA(0, 0, At, B0); PG8_MMA(0, 1, At, B1); PG8_BAR; PG8_SCHED;
            PG8_LDA(At, 1, 1); PG8_STAGE(PG8_SB(1, 0), cB + 3 * ks_, voffB); PG8_STAGE(PG8_SB(1, 1), cB + 3 * ks_ + hstep, voffB); PG8_STAGE(PG8_SA(1, 0), cA + 3 * ks_, voffA);
            PG8_WAIT_V(8); PG8_WAIT_L(0); PG8_BAR; PG8_MMA(1, 0, At, B0); PG8_MMA(1, 1, At, B1); PG8_BAR; PG8_SCHED;
            t_first = 2; } }
        for (int t = t_first; t < nt; t += 2) {
            if constexpr (Epi::MIDK) { if (t == (nt >> 1)) E.mid(acc, cur, wr, wc, fr, fq); }
            const bool last = (t == nt - 2);
            const char* a1 = cA + (size_t)(t + 1) * kstep;
            const char* a2 = last ? nA : cA + (size_t)(t + 2) * kstep; const char* b2 = last ? nB : cB + (size_t)(t + 2) * kstep;
            const char* a3 = a2 + kstep; const char* b3 = b2 + kstep;
            if (last && has_next) S.a_ready(nxt);
            if constexpr (SP2) {
            PG8_LDB(B0, 0, 0); PG8_LDB(B1, 0, 1); PG8_SCHED; PG8_LDA(At, 0, 0); PG8_STAGE(PG8_SA(1, 1), a1 + hstep, voffA);
            PG8_WAIT_V(8); PG8_WAIT_L(0); PG8_BAR; PG8_MMA(0, 0, At, B0); PG8_MMA(0, 1, At, B1); PG8_BAR; PG8_SCHED;
            PG8_LDA(At, 0, 1); PG8_STAGE(PG8_SB(0, 0), b2, voffB); PG8_STAGE(PG8_SB(0, 1), b2 + hstep, voffB); PG8_STAGE(PG8_SA(0, 0), a2, voffA);
            PG8_WAIT_V(8); PG8_WAIT_L(0); PG8_BAR; PG8_MMA(1, 0, At, B0); PG8_MMA(1, 1, At, B1); PG8_BAR; PG8_SCHED;
            PG8_LDB(B0, 1, 0); PG8_LDB(B1, 1, 1); PG8_SCHED; PG8_LDA(At, 1, 0); PG8_STAGE(PG8_SA(0, 1), a2 + hstep, voffA);
            PG8_WAIT_V(8); PG8_WAIT_L(0); PG8_BAR; PG8_MMA(0, 0, At, B0); PG8_MMA(0, 1, At, B1); PG8_BAR; PG8_SCHED;
            PG8_LDA(At, 1, 1); PG8_STAGE(PG8_SB(1, 0), b3, voffB); PG8_STAGE(PG8_SB(1, 1), b3 + hstep, voffB); PG8_STAGE(PG8_SA(1, 0), a3, voffA);
            PG8_WAIT_V(8); PG8_WAIT_L(0); PG8_BAR; PG8_MMA(1, 0, At, B0); PG8_MMA(1, 1, At, B1); PG8_BAR; PG8_SCHED;
            } else {
            PG8_LDB(B0, 0, 0); PG8_SCHED; PG8_LDA(At, 0, 0); PG8_STAGE(PG8_SA(1, 1), a1 + hstep, voffA);
            PG8_WAIT_L(8); PG8_BAR; PG8_WAIT_L(0); PG8_MMA(0, 0, At, B0); PG8_BAR; PG8_SCHED;
            PG8_LDB(B1, 0, 1); PG8_STAGE(PG8_SB(0, 0), b2, voffB);
            PG8_BAR; PG8_WAIT_L(0); PG8_MMA(0, 1, At, B1); PG8_BAR;
            PG8_LDA(At, 0, 1); PG8_STAGE(PG8_SA(0, 0), a2, voffA);
            PG8_BAR; PG8_WAIT_L(0); PG8_MMA(1, 0, At, B0); PG8_BAR; PG8_SCHED;
            PG8_STAGE(PG8_SB(0, 1), b2 + hstep, voffB);
            PG8_WAIT_V(6); PG8_BAR; PG8_MMA(1, 1, At, B1); PG8_BAR;
            PG8_LDB(B0, 1, 0); PG8_SCHED; PG8_LDA(At, 1, 0); PG8_STAGE(PG8_SA(0, 1), a2 + hstep, voffA);
            PG8_WAIT_L(8); PG8_BAR; PG8_WAIT_L(0); PG8_MMA(0, 0, At, B0); PG8_BAR; PG8_SCHED;
            PG8_LDB(B1, 1, 1); PG8_STAGE(PG8_SB(1, 0), b3, voffB);
            PG8_BAR; PG8_WAIT_L(0); PG8_MMA(0, 1, At, B1); PG8_BAR;
            PG8_LDA(At, 1, 1); PG8_STAGE(PG8_SA(1, 0), a3, voffA);
            PG8_BAR; PG8_WAIT_L(0); PG8_MMA(1, 0, At, B0); PG8_BAR; PG8_SCHED;
            PG8_STAGE(PG8_SB(1, 1), b3 + hstep, voffB);
            PG8_WAIT_V(6); PG8_BAR; PG8_MMA(1, 1, At, B1); PG8_BAR;
            }
        }
        if constexpr (ALIGN_EPI) { if (wr == 0) PG8_BAR; }
        if constexpr (!Epi::AFTER_DRAIN) { E(acc, cur, wr, wc, fr, fq); S.done(cur); }
        if (!has_next) break;
#pragma unroll
        for (int a = 0; a < 2; ++a)
#pragma unroll
            for (int b = 0; b < 2; ++b)
#pragma unroll
                for (int m = 0; m < 4; ++m)
#pragma unroll
                    for (int n = 0; n < 2; ++n) acc[a][b][m][n] = (f32x4){0.f, 0.f, 0.f, 0.f};
        cur = nxt; cA = nA; cB = nB; ++ui;
        if constexpr (ALIGN_EPI) { if (wr == 1) PG8_BAR; }
    }
    PG8_WAIT_V(0);
    if constexpr (!ALIGN_EPI) { if (wr == 0) PG8_BAR; }
    PG8_BAR;
    if constexpr (Epi::AFTER_DRAIN) { E.fused(acc, cur, wr, wc, fr, fq, lds, wid, lane); S.done(cur); }
#undef PG8_SA
#undef PG8_SB
#undef PG8_STAGE
#undef PG8_LDA
#undef PG8_LDB
#undef PG8_MMA
#undef PG8_WAIT_V
#undef PG8_WAIT_L
#undef PG8_BAR
#undef PG8_SCHED
}
}

#define LAS __attribute__((address_space(3)))
typedef unsigned short bf16;
typedef short bf16x8 __attribute__((ext_vector_type(8)));
typedef short s16x4 __attribute__((ext_vector_type(4)));
typedef float f32x4 __attribute__((ext_vector_type(4)));
typedef float f32x2 __attribute__((ext_vector_type(2)));
typedef float f32x16 __attribute__((ext_vector_type(16)));
typedef unsigned u32x4 __attribute__((ext_vector_type(4)));
typedef unsigned u32x2 __attribute__((ext_vector_type(2)));

constexpr int BATCH = 16, SEQ = 4096, DM = 1024, M = BATCH * SEQ, INW = 5120, DFF = 4096;
constexpr float QSCALE = 0.125f * 1.4426950408889634f;
constexpr size_t MiB = 1u << 20;
constexpr size_t WS_XN = 0, WS_QA = 128 * MiB, WS_KA = 192 * MiB, WS_VA = 256 * MiB, WS_QB = 320 * MiB, WS_KB = 384 * MiB, WS_VB = 448 * MiB;
constexpr size_t WS_SGA = 512 * MiB, WS_SGB = 640 * MiB, WS_AO2 = 768 * MiB, WS_ATTA = 832 * MiB, WS_ATTB = 896 * MiB;
constexpr size_t WS_WIN = 960 * MiB, WS_WA = 970 * MiB, WS_WB = 971 * MiB, WS_WOUT = 972 * MiB, WS_W1 = 974 * MiB, WS_W2 = 982 * MiB;
constexpr size_t WS_LSE = 990 * MiB, WS_SSQ1 = 996 * MiB, WS_SSQ2 = 1000 * MiB, WS_ROPE = 1004 * MiB, WS_CTL = 1005 * MiB, WS_END = 1006 * MiB;
constexpr size_t WS_AO0 = 0, WS_AO1 = 64 * MiB, WS_MERGED = 0, WS_X1B = WS_SGA, WS_H = 0;
constexpr int LDS_BYTES = 152576;
constexpr int NPHASE = 10;

#define MFMA32(a, b, c) __builtin_amdgcn_mfma_f32_32x32x16_bf16((a), (b), (c), 0, 0, 0)
__device__ __forceinline__ int crow(int r, int hi) { return (r & 3) + 8 * (r >> 2) + 4 * hi; }
typedef __bf16 bf16x2_t __attribute__((ext_vector_type(2)));
__device__ __forceinline__ unsigned pk2(float lo, float hi) { f32x2 v = {lo, hi}; bf16x2_t b = __builtin_convertvector(v, bf16x2_t); return __builtin_bit_cast(unsigned, b); }
__device__ __forceinline__ float bflo(unsigned w) { return __uint_as_float(w << 16); }
__device__ __forceinline__ float bfhi(unsigned w) { return __uint_as_float(w & 0xffff0000u); }
__device__ __forceinline__ float wave_sum(float v) {
#pragma unroll
    for (int o = 1; o < 64; o <<= 1) v += __shfl_xor(v, o);
    return v;
}
__device__ __forceinline__ s16x4 vtr(const LAS unsigned char* p) {
    typedef short v4i16_t __attribute__((ext_vector_type(4)));
    return __builtin_bit_cast(s16x4, __builtin_amdgcn_ds_read_tr16_b64_v4i16((LAS v4i16_t*)p));
}
__device__ __forceinline__ bf16x8 cat8(s16x4 lo, s16x4 hi) { return (bf16x8){lo[0], lo[1], lo[2], lo[3], hi[0], hi[1], hi[2], hi[3]}; }
__device__ __forceinline__ bf16x8 pack8(const f32x16& x, int s) {
    u32x4 p; p.x = pk2(x[8 * s], x[8 * s + 1]); p.y = pk2(x[8 * s + 2], x[8 * s + 3]); p.z = pk2(x[8 * s + 4], x[8 * s + 5]); p.w = pk2(x[8 * s + 6], x[8 * s + 7]);
    return __builtin_bit_cast(bf16x8, p);
}
__device__ __forceinline__ float xhalf(float v) { return __shfl_xor(v, 32); }

struct Args {
    const float* x; const float* w_in; const float* w_a; const float* w_b; const float* w_out;
    const float* lq1; const float* lk1; const float* lq2; const float* lk2; const float* subln_g;
    const float* g_mix; const float* g_mlp; const float* w_ff1; const float* w_ff2; const float* g_final;
    float* out; unsigned char* ws; int ph_lo, ph_hi;
};

__device__ __forceinline__ void p0_transpose_item(const float* W, int K, int N, bf16* WT, const float* g, bool perm, LAS float* scr, int item, int lane, int pitch = 0) {
    if (pitch == 0) pitch = K;
    const int nblk = N / 32, kb = item / nblk, nb = item % nblk, k0 = 64 * kb, n0 = 32 * nb, l = lane & 31;
    int sc = n0 + l;
    if (perm) sc = (n0 & ~255) + 64 * ((n0 >> 5) & 3) + 32 * ((n0 >> 7) & 1) + l;
#pragma unroll 8
    for (int i = 0; i < 32; ++i) { const int kk = 2 * i + (lane >> 5); float v = W[(size_t)(k0 + kk) * N + sc]; if (g) v *= g[k0 + kk]; scr[kk * 33 + l] = v; }
    asm volatile("s_waitcnt lgkmcnt(0)" ::: "memory");
    const int c = lane & 7;
#pragma unroll
    for (int j = 0; j < 4; ++j) { const int n = (lane >> 3) + 8 * j; const LAS float* s = scr + (8 * c) * 33 + n;
        u32x4 o; o.x = pk2(s[0 * 33], s[1 * 33]); o.y = pk2(s[2 * 33], s[3 * 33]); o.z = pk2(s[4 * 33], s[5 * 33]); o.w = pk2(s[6 * 33], s[7 * 33]);
        *(u32x4*)(WT + (size_t)(n0 + n) * pitch + k0 + 8 * c) = o; }
    asm volatile("s_waitcnt lgkmcnt(0)" ::: "memory");
}
__device__ __forceinline__ void p0_prologue(const Args& A, LAS unsigned char* lds, int vcu, int G) {
    const int tid = threadIdx.x, lane = tid & 63, wave = tid >> 6;
    unsigned char* ws = A.ws;
    LAS float* scr = (LAS float*)(lds + wave * 8704);
    const int gw = vcu * 8 + wave, NGW = G * 8;
    constexpr int I_IN = 16 * 160, I_A = 8 * 32, I_B = 8 * 32, I_O = 16 * 32, I_1 = 16 * 128, I_2 = 64 * 32, NITEMS = I_IN + I_A + I_B + I_O + I_1 + I_2;
    for (int it = gw; it < NITEMS; it += NGW) {
        int r = it;
        if (r < I_IN) { const int n0 = 32 * (r % 160); const bool perm = (n0 < 1024) || (n0 >= 1536 && n0 < 2560);
            p0_transpose_item(A.w_in, 1024, INW, (bf16*)(ws + WS_WIN), nullptr, perm, scr, r, lane); continue; } r -= I_IN;
        if (r < I_A) { p0_transpose_item(A.w_a, 512, 1024, (bf16*)(ws + WS_WA), nullptr, false, scr, r, lane, 1024); continue; } r -= I_A;
        if (r < I_B) { p0_transpose_item(A.w_b, 512, 1024, (bf16*)(ws + WS_WA) + 512, nullptr, false, scr, r, lane, 1024); continue; } r -= I_B;
        if (r < I_O) { p0_transpose_item(A.w_out, 1024, 1024, (bf16*)(ws + WS_WOUT), nullptr, false, scr, r, lane); continue; } r -= I_O;
        if (r < I_1) { p0_transpose_item(A.w_ff1, 1024, DFF, (bf16*)(ws + WS_W1), A.g_mlp, false, scr, r, lane); continue; } r -= I_1;
        p0_transpose_item(A.w_ff2, DFF, 1024, (bf16*)(ws + WS_W2), nullptr, false, scr, r, lane);
    }
    for (int idx = (vcu * 512 + tid); idx < SEQ * 32; idx += G * 512) {
        const int pos = idx >> 5, i = idx & 31;
        const float inv = powf(10000.0f, -(float)(2 * i) / 64.0f);
        const float ang = (float)pos * inv;
        const double a = (double)ang;
        const double kq = rint(a * 0.63661977236758134308);
        const double r = fma(-kq, 1.57079632679489661923, a);
        const double r2 = r * r;
        double sp = 1.0 / 6227020800.0; sp = sp * r2 - 1.0 / 39916800.0; sp = sp * r2 + 1.0 / 362880.0; sp = sp * r2 - 1.0 / 5040.0; sp = sp * r2 + 1.0 / 120.0; sp = sp * r2 - 1.0 / 6.0; sp = sp * r2 + 1.0; sp *= r;
        double cp = 1.0 / 479001600.0; cp = cp * r2 - 1.0 / 3628800.0; cp = cp * r2 + 1.0 / 40320.0; cp = cp * r2 - 1.0 / 720.0; cp = cp * r2 + 1.0 / 24.0; cp = cp * r2 - 0.5; cp = cp * r2 + 1.0;
        const int q = ((int)kq) & 3;
        const double sv = (q == 0) ? sp : (q == 1) ? cp : (q == 2) ? -sp : -cp;
        const double cv = (q == 0) ? cp : (q == 1) ? -sp : (q == 2) ? -cp : sp;
        ((f32x2*)(ws + WS_ROPE))[idx] = (f32x2){(float)cv, (float)sv};
    }
    bf16* XN = (bf16*)(ws + WS_XN);
    f32x4 gv[4];
#pragma unroll
    for (int j = 0; j < 4; ++j) gv[j] = ((const f32x4*)A.g_mix)[lane + 64 * j];
    for (int m = gw; m < M; m += NGW) {
        const f32x4* xr = (const f32x4*)(A.x + (size_t)m * DM) + lane;
        f32x4 v[4]; float s = 0.f;
#pragma unroll
        for (int j = 0; j < 4; ++j) { v[j] = __builtin_nontemporal_load(xr + 64 * j); s += (v[j].x * v[j].x + v[j].y * v[j].y) + (v[j].z * v[j].z + v[j].w * v[j].w); }
        const float rstd = 1.0f / sqrtf(wave_sum(s) * (1.0f / DM) + 1e-6f);
        u32x2* o8 = (u32x2*)(XN + (size_t)m * DM) + lane;
#pragma unroll
        for (int j = 0; j < 4; ++j) { u32x2 w; w.x = pk2(v[j].x * rstd * gv[j].x, v[j].y * rstd * gv[j].y); w.y = pk2(v[j].z * rstd * gv[j].z, v[j].w * rstd * gv[j].w); o8[64 * j] = w; }
    }
}

struct EpiIn {
    static constexpr bool PERM = true, AFTER_DRAIN = false, MIDK = false, RELAX = true;
    unsigned char* ws;
    __device__ __forceinline__ void operator()(const f32x4 (&acc)[2][2][4][2], const pg8::Unit& u, int wr, int wc, int fr, int fq) const {
        const int pn = u.pn, row0 = u.pm * 256 + wr * 64 + fr;
        if (pn >= 12) {
            unsigned char* dst = (unsigned char*)(ws + (pn >= 16 ? WS_SGB : WS_SGA)); const int colt = ((pn - 12) & 3) * 256 + wc * 32 + 8 * fq;
#pragma unroll
            for (int ai = 0; ai < 2; ++ai)
#pragma unroll
                for (int m = 0; m < 4; ++m) { unsigned char* rp = dst + (size_t)(row0 + ai * 128 + m * 16) * 1024 + colt;
#pragma unroll
                    for (int bj = 0; bj < 2; ++bj) { float sg[8];
#pragma unroll
                        for (int j = 0; j < 8; ++j) sg[j] = fmaxf(255.0f * __builtin_amdgcn_rcpf(1.0f + __builtin_amdgcn_exp2f(-1.4426950408889634f * acc[ai][bj][m][j >> 2][j & 3])), 1.0f);
                        u32x2 w; w.x = 0u; w.y = 0u;
                        w.x = __builtin_amdgcn_cvt_pk_u8_f32(sg[0], 0, w.x); w.x = __builtin_amdgcn_cvt_pk_u8_f32(sg[1], 1, w.x); w.x = __builtin_amdgcn_cvt_pk_u8_f32(sg[2], 2, w.x); w.x = __builtin_amdgcn_cvt_pk_u8_f32(sg[3], 3, w.x);
                        w.y = __builtin_amdgcn_cvt_pk_u8_f32(sg[4], 0, w.y); w.y = __builtin_amdgcn_cvt_pk_u8_f32(sg[5], 1, w.y); w.y = __builtin_amdgcn_cvt_pk_u8_f32(sg[6], 2, w.y); w.y = __builtin_amdgcn_cvt_pk_u8_f32(sg[7], 3, w.y);
                        *(u32x2*)(rp + bj * 128) = w; } }
        } else {
            const int reg = pn >> 1;
            bf16* dst = (bf16*)(ws + WS_QA + (size_t)reg * 64 * MiB);
            if (reg == 2 || reg == 5) {
                const int colt = (pn & 1) * 256 + wc * 32 + 8 * fq;
#pragma unroll
                for (int ai = 0; ai < 2; ++ai)
#pragma unroll
                    for (int m = 0; m < 4; ++m) { bf16* rp = dst + (size_t)(row0 + ai * 128 + m * 16) * 512 + colt;
#pragma unroll
                        for (int bj = 0; bj < 2; ++bj) { const f32x4 v0 = acc[ai][bj][m][0], v1 = acc[ai][bj][m][1];
                            u32x4 w; w.x = pk2(v0[0], v0[1]); w.y = pk2(v0[2], v0[3]); w.z = pk2(v1[0], v1[1]); w.w = pk2(v1[2], v1[3]); *(u32x4*)(rp + bj * 128) = w; } }
            } else {
                const float sc = (reg == 0 || reg == 3) ? QSCALE : 1.0f;
                const f32x4* rope = (const f32x4*)(ws + WS_ROPE);
                const int head = 4 * (pn & 1) + wc;
#pragma unroll
                for (int ai = 0; ai < 2; ++ai)
#pragma unroll
                    for (int m = 0; m < 4; ++m) { const int row = row0 + ai * 128 + m * 16, pos = row & (SEQ - 1);
                        const f32x4* tp = rope + ((pos * 32 + 8 * fq) >> 1);
                        const f32x4 t0 = tp[0], t1 = tp[1], t2 = tp[2], t3 = tp[3];
                        const float cs[8] = {t0[0], t0[2], t1[0], t1[2], t2[0], t2[2], t3[0], t3[2]}, sn[8] = {t0[1], t0[3], t1[1], t1[3], t2[1], t2[3], t3[1], t3[3]};
                        float o1[8], o2[8];
#pragma unroll
                        for (int j = 0; j < 8; ++j) { const float x1 = acc[ai][0][m][j >> 2][j & 3], x2 = acc[ai][1][m][j >> 2][j & 3];
                            o1[j] = (x1 * cs[j] - x2 * sn[j]) * sc; o2[j] = (x2 * cs[j] + x1 * sn[j]) * sc; }
                        bf16* rp = dst + (size_t)row * 512 + head * 64 + 8 * fq;
                        u32x4 w1, w2; w1.x = pk2(o1[0], o1[1]); w1.y = pk2(o1[2], o1[3]); w1.z = pk2(o1[4], o1[5]); w1.w = pk2(o1[6], o1[7]);
                        w2.x = pk2(o2[0], o2[1]); w2.y = pk2(o2[2], o2[3]); w2.z = pk2(o2[4], o2[5]); w2.w = pk2(o2[6], o2[7]);
                        *(u32x4*)rp = w1; *(u32x4*)(rp + 32) = w2; }
            }
        }
    }
};
__device__ __forceinline__ void unpack8(const u32x4 g, float (&f)[8]) { f[0] = bflo(g.x); f[1] = bfhi(g.x); f[2] = bflo(g.y); f[3] = bfhi(g.y); f[4] = bflo(g.z); f[5] = bfhi(g.z); f[6] = bflo(g.w); f[7] = bfhi(g.w); }
template <int PASS> struct EpiGate {
    static constexpr bool PERM = true, AFTER_DRAIN = false, MIDK = false, RELAX = false;
    const bf16* SG; bf16* MG;
    __device__ __forceinline__ void operator()(const f32x4 (&acc)[2][2][4][2], const pg8::Unit& u, int wr, int wc, int fr, int fq) const {
        const int row0 = u.pm * 256 + wr * 64 + fr, col0 = u.pn * 256 + wc * 32 + 8 * fq;
#pragma unroll
        for (int ai = 0; ai < 2; ++ai)
#pragma unroll
            for (int m = 0; m < 4; ++m) { const size_t off = (size_t)(row0 + ai * 128 + m * 16) * 1024 + col0;
#pragma unroll
                for (int bj = 0; bj < 2; ++bj) { const size_t o = off + bj * 128; const f32x4 v0 = acc[ai][bj][m][0], v1 = acc[ai][bj][m][1];
                    float g[8]; unpack8(*(const u32x4*)(SG + o), g);
                    float r[8] = {v0[0] * g[0], v0[1] * g[1], v0[2] * g[2], v0[3] * g[3], v1[0] * g[4], v1[1] * g[5], v1[2] * g[6], v1[3] * g[7]};
                    if (PASS == 1) { float p[8]; unpack8(*(const u32x4*)(MG + o), p);
#pragma unroll
                        for (int j = 0; j < 8; ++j) r[j] += p[j]; }
                    u32x4 w; w.x = pk2(r[0], r[1]); w.y = pk2(r[2], r[3]); w.z = pk2(r[4], r[5]); w.w = pk2(r[6], r[7]); *(u32x4*)(MG + o) = w; } }
    }
};
__device__ __forceinline__ void unpack8u(const u32x2 g, float (&f)[8]) {
    f[0] = (float)(g.x & 0xffu); f[1] = (float)((g.x >> 8) & 0xffu); f[2] = (float)((g.x >> 16) & 0xffu); f[3] = (float)(g.x >> 24);
    f[4] = (float)(g.y & 0xffu); f[5] = (float)((g.y >> 8) & 0xffu); f[6] = (float)((g.y >> 16) & 0xffu); f[7] = (float)(g.y >> 24);
}
struct EpiGate2 {
    static constexpr bool PERM = true, AFTER_DRAIN = false, MIDK = true, RELAX = true;
    const unsigned char* SGA_; const unsigned char* SGB_; bf16* MG;
    __device__ __forceinline__ void mid(f32x4 (&acc)[2][2][4][2], const pg8::Unit& u, int wr, int wc, int fr, int fq) const {
        int row0 = u.pm * 256 + wr * 64 + fr, col0 = u.pn * 256 + wc * 32 + 8 * fq;
        asm volatile("" : "+v"(row0), "+v"(col0));
#pragma unroll
        for (int ai = 0; ai < 2; ++ai)
#pragma unroll
            for (int m = 0; m < 4; ++m) { const size_t off = (size_t)(row0 + ai * 128 + m * 16) * 1024 + col0;
#pragma unroll
                for (int bj = 0; bj < 2; ++bj) { const size_t o = off + bj * 128; float ga[8], gb[8]; unpack8u(*(const u32x2*)(SGA_ + o), ga); unpack8u(*(const u32x2*)(SGB_ + o), gb);
#pragma unroll
                    for (int j = 0; j < 8; ++j) acc[ai][bj][m][j >> 2][j & 3] *= ga[j] * __builtin_amdgcn_rcpf(gb[j]);
                    asm volatile("" ::: "memory"); } }
    }
    __device__ __forceinline__ void operator()(const f32x4 (&acc)[2][2][4][2], const pg8::Unit& u, int wr, int wc, int fr, int fq) const {
        const int row0 = u.pm * 256 + wr * 64 + fr, col0 = u.pn * 256 + wc * 32 + 8 * fq;
#pragma unroll
        for (int ai = 0; ai < 2; ++ai)
#pragma unroll
            for (int m = 0; m < 4; ++m) { const size_t off = (size_t)(row0 + ai * 128 + m * 16) * 1024 + col0;
#pragma unroll
                for (int bj = 0; bj < 2; ++bj) { const size_t o = off + bj * 128; const f32x4 v0 = acc[ai][bj][m][0] * (1.0f / 255.0f), v1 = acc[ai][bj][m][1] * (1.0f / 255.0f);
                    float g[8]; unpack8u(*(const u32x2*)(SGB_ + o), g);
                    u32x4 w; w.x = pk2(v0[0] * g[0], v0[1] * g[1]); w.y = pk2(v0[2] * g[2], v0[3] * g[3]); w.z = pk2(v1[0] * g[4], v1[1] * g[5]); w.w = pk2(v1[2] * g[6], v1[3] * g[7]); *(u32x4*)(MG + o) = w; } }
    }
};
struct EpiRes1 {
    static constexpr bool PERM = true, AFTER_DRAIN = false, MIDK = false, RELAX = true;
    const float* xi; bf16* xb; float* ssq;
    __device__ __forceinline__ void operator()(const f32x4 (&acc)[2][2][4][2], const pg8::Unit& u, int wr, int wc, int fr, int fq) const {
        const int row0 = u.pm * 256 + wr * 64 + fr, col0 = u.pn * 256 + wc * 32 + 8 * fq;
#pragma unroll
        for (int ai = 0; ai < 2; ++ai)
#pragma unroll
            for (int m = 0; m < 4; ++m) { const int row = row0 + ai * 128 + m * 16; const size_t off = (size_t)row * 1024 + col0; float ss = 0.f;
#pragma unroll
                for (int bj = 0; bj < 2; ++bj) { const size_t o = off + bj * 128;
                    const f32x4 v0 = *(const f32x4*)(xi + o) + acc[ai][bj][m][0], v1 = *(const f32x4*)(xi + o + 4) + acc[ai][bj][m][1];
                    ss += (v0[0] * v0[0] + v0[1] * v0[1]) + (v0[2] * v0[2] + v0[3] * v0[3]) + (v1[0] * v1[0] + v1[1] * v1[1]) + (v1[2] * v1[2] + v1[3] * v1[3]);
                    u32x4 w; w.x = pk2(v0[0], v0[1]); w.y = pk2(v0[2], v0[3]); w.z = pk2(v1[0], v1[1]); w.w = pk2(v1[2], v1[3]); *(u32x4*)(xb + o) = w; }
                ss += __shfl_xor(ss, 16); ss += __shfl_xor(ss, 32);
                if (fq == 0) ssq[(size_t)row * 16 + u.pn * 4 + wc] = ss; }
    }
};
struct EpiFF1 {
    static constexpr bool PERM = true, AFTER_DRAIN = false, MIDK = false, RELAX = true;
    bf16* H;
    __device__ __forceinline__ void operator()(const f32x4 (&acc)[2][2][4][2], const pg8::Unit& u, int wr, int wc, int fr, int fq) const {
        const int row0 = u.pm * 256 + wr * 64 + fr, col0 = u.pn * 256 + wc * 32 + 8 * fq;
#pragma unroll
        for (int ai = 0; ai < 2; ++ai)
#pragma unroll
            for (int m = 0; m < 4; ++m) { bf16* rp = H + (size_t)(row0 + ai * 128 + m * 16) * DFF + col0;
#pragma unroll
                for (int bj = 0; bj < 2; ++bj) { f32x4 v0 = acc[ai][bj][m][0], v1 = acc[ai][bj][m][1];
#pragma unroll
                    for (int j = 0; j < 4; ++j) { const float t0 = fmaxf(v0[j], 0.f), t1 = fmaxf(v1[j], 0.f); v0[j] = t0 * t0; v1[j] = t1 * t1; }
                    u32x4 w; w.x = pk2(v0[0], v0[1]); w.y = pk2(v0[2], v0[3]); w.z = pk2(v1[0], v1[1]); w.w = pk2(v1[2], v1[3]); *(u32x4*)(rp + bj * 128) = w; } }
    }
};
struct EpiRes2 {
    static constexpr bool PERM = true, AFTER_DRAIN = false, MIDK = false, RELAX = false;
    const bf16* xb; const float* ssq1; float* xo; float* ssq2;
    __device__ __forceinline__ void operator()(const f32x4 (&acc)[2][2][4][2], const pg8::Unit& u, int wr, int wc, int fr, int fq) const {
        const int row0 = u.pm * 256 + wr * 64 + fr, col0 = u.pn * 256 + wc * 32 + 8 * fq;
#pragma unroll
        for (int ai = 0; ai < 2; ++ai)
#pragma unroll
            for (int m = 0; m < 4; ++m) { const int row = row0 + ai * 128 + m * 16; const size_t off = (size_t)row * 1024 + col0;
                const f32x4 pt = *(const f32x4*)(ssq1 + (size_t)row * 16 + 4 * fq); float s = (pt[0] + pt[1]) + (pt[2] + pt[3]);
                s += __shfl_xor(s, 16); s += __shfl_xor(s, 32);
                const float r2 = 1.0f / (s * (1.0f / DM) + 1e-6f);
                float ss = 0.f;
#pragma unroll
                for (int bj = 0; bj < 2; ++bj) { const size_t o = off + bj * 128; float x1[8]; unpack8(*(const u32x4*)(xb + o), x1);
                    const f32x4 a0 = acc[ai][bj][m][0], a1 = acc[ai][bj][m][1];
                    const f32x4 v0 = {x1[0] + r2 * a0[0], x1[1] + r2 * a0[1], x1[2] + r2 * a0[2], x1[3] + r2 * a0[3]}, v1 = {x1[4] + r2 * a1[0], x1[5] + r2 * a1[1], x1[6] + r2 * a1[2], x1[7] + r2 * a1[3]};
                    ss += (v0[0] * v0[0] + v0[1] * v0[1]) + (v0[2] * v0[2] + v0[3] * v0[3]) + (v1[0] * v1[0] + v1[1] * v1[1]) + (v1[2] * v1[2] + v1[3] * v1[3]);
                    *(f32x4*)(xo + o) = v0; *(f32x4*)(xo + o + 4) = v1; }
                ss += __shfl_xor(ss, 16); ss += __shfl_xor(ss, 32);
                if (fq == 0) ssq2[(size_t)row * 16 + u.pn * 4 + wc] = ss; }
    }
};

struct EpiFinal {
    static constexpr bool PERM = true, AFTER_DRAIN = false, MIDK = false, RELAX = false;
    const bf16* xb; const float* ssq1; float* out; const float* gfin; float* slot; unsigned* cnt; LAS unsigned char* xl;
    __device__ __forceinline__ void operator()(const f32x4 (&acc_)[2][2][4][2], const pg8::Unit& u, int wr, int wc, int fr, int fq) const {
        f32x4 (&acc)[2][2][4][2] = const_cast<f32x4 (&)[2][2][4][2]>(acc_);
        const int tid = threadIdx.x, lane = tid & 63, wid = tid >> 6;
        const int row0 = u.pm * 256 + wr * 64 + fr, col0 = u.pn * 256 + wc * 32 + 8 * fq;
        LAS float* P = (LAS float*)xl; LAS float* S = (LAS float*)(xl + 4096); LAS unsigned* flag = (LAS unsigned*)(xl + 5120);
#pragma unroll
        for (int ai = 0; ai < 2; ++ai)
#pragma unroll
            for (int m = 0; m < 4; ++m) { const int rl = ai * 128 + wr * 64 + m * 16 + fr, row = u.pm * 256 + rl;
                const f32x4 pt = *(const f32x4*)(ssq1 + (size_t)row * 16 + 4 * fq); float s = (pt[0] + pt[1]) + (pt[2] + pt[3]);
                s += __shfl_xor(s, 16); s += __shfl_xor(s, 32);
                const float r2 = 1.0f / (s * (1.0f / DM) + 1e-6f);
                float ss = 0.f;
#pragma unroll
                for (int bj = 0; bj < 2; ++bj) { float x1[8]; unpack8(*(const u32x4*)(xb + (size_t)row * 1024 + col0 + bj * 128), x1);
#pragma unroll
                    for (int j = 0; j < 8; ++j) { const float v = x1[j] + r2 * acc[ai][bj][m][j >> 2][j & 3]; acc[ai][bj][m][j >> 2][j & 3] = v; ss += v * v; } }
                ss += __shfl_xor(ss, 16); ss += __shfl_xor(ss, 32);
                if (fq == 0) P[rl * 4 + wc] = ss; }
        asm volatile("s_waitcnt lgkmcnt(0)" ::: "memory"); __builtin_amdgcn_s_barrier(); asm volatile("" ::: "memory");
        const int prow = wid * 32 + (lane & 31);
        if (lane < 32) { const float t = (P[prow * 4 + 0] + P[prow * 4 + 1]) + (P[prow * 4 + 2] + P[prow * 4 + 3]);
            __hip_atomic_store(slot + ((size_t)(u.pm * 256 + prow) * 4 + u.pn), t, __ATOMIC_RELAXED, __HIP_MEMORY_SCOPE_AGENT); }
        asm volatile("s_waitcnt vmcnt(0)" ::: "memory");
        if (lane == 0) __hip_atomic_fetch_add(cnt + 64 * u.pm, 1u, __ATOMIC_RELAXED, __HIP_MEMORY_SCOPE_AGENT);
        if (wid == 0) { unsigned sp = 0;
            while ((unsigned)__builtin_amdgcn_readfirstlane(__hip_atomic_load(cnt + 64 * u.pm, __ATOMIC_RELAXED, __HIP_MEMORY_SCOPE_AGENT)) < 32u) { __builtin_amdgcn_s_sleep(2); if (++sp > (1u << 12)) break; }
            __builtin_amdgcn_fence(__ATOMIC_ACQUIRE, "agent");
            if (lane == 0) flag[0] = 1u; }
        asm volatile("s_waitcnt vmcnt(0) lgkmcnt(0)" ::: "memory"); __builtin_amdgcn_s_barrier(); asm volatile("" ::: "memory");
        if (lane < 32) { const float* sl = slot + (size_t)(u.pm * 256 + prow) * 4; float t = 0.f;
#pragma unroll
            for (int k = 0; k < 4; ++k) t += __hip_atomic_load(sl + k, __ATOMIC_RELAXED, __HIP_MEMORY_SCOPE_AGENT);
            S[prow] = 1.0f / sqrtf(t * (1.0f / DM) + 1e-6f); }
        asm volatile("s_waitcnt vmcnt(0) lgkmcnt(0)" ::: "memory"); __builtin_amdgcn_s_barrier(); asm volatile("" ::: "memory");
#pragma unroll
        for (int bj = 0; bj < 2; ++bj) { const f32x4 g0 = *(const f32x4*)(gfin + col0 + bj * 128), g1 = *(const f32x4*)(gfin + col0 + bj * 128 + 4);
#pragma unroll
            for (int ai = 0; ai < 2; ++ai)
#pragma unroll
                for (int m = 0; m < 4; ++m) { const int rl = ai * 128 + wr * 64 + m * 16 + fr; const float rs = S[rl];
                    float* o = out + (size_t)(u.pm * 256 + rl) * 1024 + col0 + bj * 128;
                    *(f32x4*)o = acc[ai][bj][m][0] * rs * g0; *(f32x4*)(o + 4) = acc[ai][bj][m][1] * rs * g1; } }
        asm volatile("s_waitcnt lgkmcnt(0)" ::: "memory"); __builtin_amdgcn_s_barrier(); asm volatile("" ::: "memory");
    }
};

constexpr int AK_CH = 384 * 16 + 16, AV_DB = 384 * 64 + 64, AV_OFF = 8 * AK_CH, AV_BUF = 2 * AV_DB;
#define GLDS16(gsrc, ldst) do { unsigned keep_; asm volatile("s_mov_b32 %0, m0\n\ts_mov_b32 m0, %2\n\ts_nop 0\n\tglobal_load_lds_dwordx4 %1, off\n\ts_mov_b32 m0, %0" : "=&s"(keep_) : "v"(gsrc), "s"((unsigned)__builtin_amdgcn_readfirstlane(ldst)) : "memory"); } while (0)
struct AUnit { int p, sh, ls, ph, t0, head; size_t rowb; };
__device__ __forceinline__ AUnit attnA_decode(int unit) {
    AUnit a; const int u16 = unit & 15; a.p = (unit >> 4) % 3; a.head = (unit / 48) & 7; a.rowb = (size_t)(unit / 384) * SEQ;
    a.sh = 2 * a.p; a.ls = SEQ >> a.sh; a.ph = u16 & ((1 << a.sh) - 1); a.t0 = 256 * (u16 >> a.sh); return a;
}
__device__ __forceinline__ void attnA_dma(LAS unsigned char* lds, const unsigned char* ws, int unit, int vbuf, int wid, int lane) {
    const AUnit a = attnA_decode(unit);
    const bf16* KA = (const bf16*)(ws + WS_KA); const bf16* VA = (const bf16*)(ws + WS_VA);
    const unsigned ldsb = (unsigned)(unsigned long)lds;
#pragma unroll
    for (int k = 0; k < 6; ++k) { const int idx = wid * 6 + k, lr = 8 * idx + (lane >> 3); int t = a.t0 - 64 + lr; t = t < 0 ? 0 : (t > a.ls - 1 ? a.ls - 1 : t);
        const bf16* g = KA + (a.rowb + ((size_t)t << a.sh) + a.ph) * 512 + a.head * 64 + (((lane & 7) ^ ((lr >> 1) & 7)) * 8); GLDS16(g, ldsb + idx * 1024); }
#pragma unroll
    for (int k = 0; k < 6; ++k) { const int idx = wid * 6 + k, dblk = idx / 24, rg = idx % 24; int t = a.t0 - 64 + rg * 16 + (lane >> 2); t = t < 0 ? 0 : (t > a.ls - 1 ? a.ls - 1 : t);
        const bf16* g = VA + (a.rowb + ((size_t)t << a.sh) + a.ph) * 512 + a.head * 64 + dblk * 32 + (lane & 3) * 8; GLDS16(g, ldsb + vbuf + dblk * AV_DB + rg * 1024); }
}
__device__ __forceinline__ void attnA_phase(LAS unsigned char* lds, const unsigned char* ws, int vcu, int G) {
    const int tid = threadIdx.x, lane = tid & 63, w = __builtin_amdgcn_readfirstlane(tid >> 6), r = lane & 31, h = lane >> 5;
    constexpr int NU = BATCH * 8 * 3 * 16;
    const bf16* QA = (const bf16*)(ws + WS_QA);
    if (vcu < NU) attnA_dma(lds, ws, vcu, AV_OFF, w, lane);
    int it = 0;
    bf16x8 qn[4];
    if (vcu < NU) { const AUnit a = attnA_decode(vcu); const size_t qr = a.rowb + ((size_t)(a.t0 + 32 * w + r) << a.sh) + a.ph;
#pragma unroll
        for (int ks = 0; ks < 4; ++ks) qn[ks] = *(const bf16x8*)(QA + qr * 512 + a.head * 64 + 16 * ks + 8 * h); }
    for (int unit = vcu; unit < NU; unit += G, ++it) {
        const AUnit a = attnA_decode(unit);
        const int vbuf = AV_OFF + (it & 1) * AV_BUF;
        bf16* AO = (bf16*)(ws + (a.p == 0 ? WS_AO0 : a.p == 1 ? WS_AO1 : WS_AO2)); float* LSE = (float*)(ws + WS_LSE) + (size_t)a.p * M * 8;
        const int tq = a.t0 + 32 * w + r; const size_t qrow = a.rowb + ((size_t)tq << a.sh) + a.ph;
        bf16x8 qf[4];
#pragma unroll
        for (int ks = 0; ks < 4; ++ks) qf[ks] = qn[ks];
        asm volatile("s_waitcnt vmcnt(0)" ::: "memory");
        __syncthreads();
        f32x16 s[5];
        {
            bf16x8 kf[2][4];
            const LAS unsigned char* kp = lds + (32 * w + r) * 128;
            int kx[4];
#pragma unroll
            for (int ks = 0; ks < 4; ++ks) kx[ks] = ((2 * ks + h) ^ ((r >> 1) & 7)) * 16;
#pragma unroll
            for (int ks = 0; ks < 4; ++ks) kf[0][ks] = *(const LAS bf16x8*)(kp + kx[ks]);
#pragma unroll
            for (int j = 0; j < 5; ++j) {
                if (j + 1 < 5) {
#pragma unroll
                    for (int ks = 0; ks < 4; ++ks) kf[(j + 1) & 1][ks] = *(const LAS bf16x8*)(kp + kx[ks] + (j + 1) * 4096); }
                __builtin_amdgcn_sched_barrier(0);
                f32x16 acc = {};
#pragma unroll
                for (int ks = 0; ks < 4; ++ks) acc = MFMA32(kf[j & 1][ks], qf[ks], acc);
                s[j] = acc;
                __builtin_amdgcn_sched_barrier(0);
            }
        }
        __syncthreads();
        if (unit + G < NU) { attnA_dma(lds, ws, unit + G, AV_OFF + ((it + 1) & 1) * AV_BUF, w, lane);
            const AUnit an = attnA_decode(unit + G); const size_t qr = an.rowb + ((size_t)(an.t0 + 32 * w + r) << an.sh) + an.ph;
#pragma unroll
            for (int ks = 0; ks < 4; ++ks) qn[ks] = *(const bf16x8*)(QA + qr * 512 + an.head * 64 + 16 * ks + 8 * h); }
        float mx = -INFINITY;
        if ((a.t0 - 64 + 32 * w >= 0) && (a.t0 + 32 * w + 96 <= a.ls)) {
#pragma unroll
            for (int i = 0; i < 16; ++i) { const int cr = crow(i, h);
                s[0][i] = (cr >= r) ? s[0][i] : -INFINITY; s[4][i] = (cr <= r) ? s[4][i] : -INFINITY; }
#pragma unroll
            for (int j = 0; j < 5; ++j)
#pragma unroll
                for (int i = 0; i < 16; ++i) mx = fmaxf(mx, s[j][i]);
        } else {
#pragma unroll
            for (int j = 0; j < 5; ++j)
#pragma unroll
                for (int i = 0; i < 16; ++i) { const int cr = crow(i, h), rel = 32 * j + cr - 64 - r, tk = a.t0 - 64 + 32 * w + 32 * j + cr;
                    const bool valid = (rel >= -64) && (rel <= 64) && (tk >= 0) && (tk < a.ls);
                    const float v = valid ? s[j][i] : -INFINITY; s[j][i] = v; mx = fmaxf(mx, v); }
        }
        mx = fmaxf(mx, xhalf(mx));
        float l = 0.f;
#pragma unroll
        for (int j = 0; j < 5; ++j)
#pragma unroll
            for (int i = 0; i < 16; ++i) { const float e = __builtin_amdgcn_exp2f(s[j][i] - mx); s[j][i] = e; l += e; }
        l += xhalf(l);
        f32x16 o[2] = {};
        const int i16 = lane & 15, qd = i16 >> 2, pp = i16 & 3, blk = (lane >> 4) & 1;
        const LAS unsigned char* vb = lds + vbuf + (32 * w + 4 * h + qd) * 64 + blk * 32 + pp * 8;
#pragma unroll
        for (int j = 0; j < 5; ++j)
#pragma unroll
            for (int sp = 0; sp < 2; ++sp) { const bf16x8 pf = pack8(s[j], sp);
#pragma unroll
                for (int db = 0; db < 2; ++db) { const LAS unsigned char* av = vb + db * AV_DB + (32 * j + 16 * sp) * 64;
                    const bf16x8 vf = cat8(vtr(av), vtr(av + 512)); o[db] = MFMA32(vf, pf, o[db]); } }
        const float rl = 1.0f / l;
        bf16* op = AO + qrow * 512 + a.head * 64 + 8 * h;
#pragma unroll
        for (int db = 0; db < 2; ++db)
#pragma unroll
            for (int gp = 0; gp < 2; ++gp) {
                unsigned a0 = pk2(o[db][8 * gp] * rl, o[db][8 * gp + 1] * rl), a1 = pk2(o[db][8 * gp + 2] * rl, o[db][8 * gp + 3] * rl);
                unsigned b0 = pk2(o[db][8 * gp + 4] * rl, o[db][8 * gp + 5] * rl), b1 = pk2(o[db][8 * gp + 6] * rl, o[db][8 * gp + 7] * rl);
                const auto s0 = __builtin_amdgcn_permlane32_swap(a0, b0, false, false); const auto s1 = __builtin_amdgcn_permlane32_swap(a1, b1, false, false);
                u32x4 wv; wv.x = s0[0]; wv.y = s1[0]; wv.z = s0[1]; wv.w = s1[1];
                *(u32x4*)(op + 32 * db + 16 * gp) = wv; }
        if (h == 0) LSE[qrow * 8 + a.head] = mx + __builtin_amdgcn_logf(l);
    }
    __syncthreads();
}

__device__ __forceinline__ void attnA_combine(const unsigned char* ws, int vcu, int G) {
    const bf16* A0 = (const bf16*)(ws + WS_AO0); const bf16* A1 = (const bf16*)(ws + WS_AO1); const bf16* A2 = (const bf16*)(ws + WS_AO2);
    const float* LSE = (const float*)(ws + WS_LSE); bf16* O = (bf16*)(ws + WS_ATTA);
    for (size_t it = (size_t)vcu * 512 + threadIdx.x; it < (size_t)M * 64; it += (size_t)G * 512) {
        const size_t rh = it >> 3;
        const float l0 = LSE[rh], l1 = LSE[(size_t)M * 8 + rh], l2 = LSE[(size_t)2 * M * 8 + rh];
        const float mx = fmaxf(l0, fmaxf(l1, l2));
        float w0 = __builtin_amdgcn_exp2f(l0 - mx), w1 = __builtin_amdgcn_exp2f(l1 - mx), w2 = __builtin_amdgcn_exp2f(l2 - mx);
        const float inv = 1.0f / (w0 + w1 + w2); w0 *= inv; w1 *= inv; w2 *= inv;
        const u32x4 a = *(const u32x4*)(A0 + it * 8), bq = *(const u32x4*)(A1 + it * 8), c = *(const u32x4*)(A2 + it * 8);
        u32x4 o;
#pragma unroll
        for (int k = 0; k < 4; ++k) o[k] = pk2(w0 * bflo(a[k]) + w1 * bflo(bq[k]) + w2 * bflo(c[k]), w0 * bfhi(a[k]) + w1 * bfhi(bq[k]) + w2 * bfhi(c[k]));
        *(u32x4*)(O + (it >> 6) * 1024 + (it & 63) * 8) = o;
    }
}

constexpr int BK_CH = 64 * 16 + 16, BK_IMG = 8 * BK_CH, BV_DB = 64 * 64 + 64, BV_IMG = 4 * BV_DB, BBUF = 2 * BK_IMG + BV_IMG;
__device__ __forceinline__ void attnB_unit(LAS unsigned char* lds, const unsigned char* ws, int unit, float lam, const float* subln_g, bool prefetched, int next_unit) {
    const int tid = threadIdx.x, lane = tid & 63, wid = __builtin_amdgcn_readfirstlane(tid >> 6), w = wid & 3, c = wid >> 2, r = lane & 31, h = lane >> 5;
    const int qb = unit & 31, hd = (unit >> 5) & 3, b = unit >> 7, q0 = qb * 128;
    const bf16* QB = (const bf16*)(ws + WS_QB); const bf16* KB = (const bf16*)(ws + WS_KB); const bf16* VB = (const bf16*)(ws + WS_VB); bf16* OB = (bf16*)(ws + WS_ATTA);
    const size_t rowb = (size_t)b * SEQ;
    const size_t qrow = rowb + q0 + 32 * w + r;
    bf16x8 qf[4];
#pragma unroll
    for (int ks = 0; ks < 4; ++ks) qf[ks] = *(const bf16x8*)(QB + qrow * 512 + hd * 128 + c * 64 + 16 * ks + 8 * h);
    const int rot = (qb * 2) & 63;
    const bf16* kg = KB + (rowb + lane) * 512 + hd * 128 + wid * 8;
    const bf16* vg0 = VB + (rowb + (wid & 3) * 16 + (lane >> 2)) * 512 + hd * 128 + (wid >> 2) * 32 + (lane & 3) * 8;
    const unsigned ldsb = (unsigned)(unsigned long)lds;
    const unsigned kd = ldsb + wid * BK_CH, vd0 = ldsb + 2 * BK_IMG + (wid >> 2) * BV_DB + (wid & 3) * 1024;
#define B_DMA(t, boff) do { const size_t go = (size_t)(((t) + rot) & 63) * 64 * 512; \
        GLDS16(kg + go, kd + (boff)); GLDS16(kg + go + 64, kd + BK_IMG + (boff)); GLDS16(vg0 + go, vd0 + (boff)); GLDS16(vg0 + go + 64, vd0 + 2 * BV_DB + (boff)); } while (0)
#define B_WAITBAR() do { asm volatile("s_waitcnt vmcnt(0)" ::: "memory"); __syncthreads(); } while (0)
#define B_QK(boff, S0, S1) do { const LAS unsigned char* kb_ = lds + (boff) + koff; _Pragma("unroll") for (int ks = 0; ks < 4; ++ks) { \
        const bf16x8 a0 = *(const LAS bf16x8*)(kb_ + 2 * ks * BK_CH), a1 = *(const LAS bf16x8*)(kb_ + 2 * ks * BK_CH + 512); \
        S0 = MFMA32(a0, qf[ks], S0); S1 = MFMA32(a1, qf[ks], S1); } } while (0)
    const int i16 = lane & 15, qd = i16 >> 2, pp = i16 & 3, blk = (lane >> 4) & 1;
    const int voff = 2 * BK_IMG + (4 * h + qd) * 64 + blk * 32 + pp * 8, koff = c * BK_IMG + h * BK_CH + r * 16;
    constexpr int NT = SEQ / 64;
    if (!prefetched) { B_DMA(0, 0); B_DMA(1, BBUF); }
    B_WAITBAR();
    f32x16 n0 = {}, n1 = {};
    B_QK(0, n0, n1);
    float mrow = fmaxf(n0[0], n1[0]);
#pragma unroll
    for (int i = 1; i < 16; ++i) mrow = fmaxf(mrow, fmaxf(n0[i], n1[i]));
    mrow = fmaxf(mrow, xhalf(mrow));
    f32x16 negm;
#pragma unroll
    for (int i = 0; i < 16; ++i) { negm[i] = -mrow; n0[i] -= mrow; n1[i] -= mrow; }
    f32x16 o[4] = {}; float l = 0.f;
#define SB() __builtin_amdgcn_sched_barrier(0)
#define B_ITER(t, bcur, bnext, bnn) do { \
        if ((t) + 2 < NT) B_DMA((t) + 2, bnn); \
        f32x16 s0 = n0, s1 = n1; bf16x8 kf[8]; \
        if ((t) + 1 < NT) { const LAS unsigned char* kb_ = lds + (bnext) + koff; \
            _Pragma("unroll") for (int ks = 0; ks < 4; ++ks) { kf[2 * ks] = *(const LAS bf16x8*)(kb_ + 2 * ks * BK_CH); kf[2 * ks + 1] = *(const LAS bf16x8*)(kb_ + 2 * ks * BK_CH + 512); } } \
        SB(); \
        float lsum = 0.f; bf16x8 pf[4]; \
        _Pragma("unroll") for (int i = 0; i < 16; ++i) { s0[i] = __builtin_amdgcn_exp2f(s0[i]); lsum += s0[i]; } \
        pf[0] = pack8(s0, 0); pf[1] = pack8(s0, 1); \
        SB(); \
        if ((t) + 1 < NT) { n0 = negm; n1 = negm; \
            _Pragma("unroll") for (int ks = 0; ks < 4; ++ks) { n0 = MFMA32(kf[2 * ks], qf[ks], n0); n1 = MFMA32(kf[2 * ks + 1], qf[ks], n1); } } \
        _Pragma("unroll") for (int i = 0; i < 16; ++i) { s1[i] = __builtin_amdgcn_exp2f(s1[i]); lsum += s1[i]; } \
        pf[2] = pack8(s1, 0); pf[3] = pack8(s1, 1); \
        l += lsum; \
        const LAS unsigned char* vb_ = lds + (bcur) + voff; \
        _Pragma("unroll") for (int kk = 0; kk < 4; ++kk) \
        _Pragma("unroll") for (int db = 0; db < 4; ++db) { const LAS unsigned char* a = vb_ + db * BV_DB + kk * 1024; \
                const bf16x8 vf = cat8(vtr(a), vtr(a + 512)); o[db] = MFMA32(vf, pf[kk], o[db]); } \
        if (__any(lsum > 0x1p40f)) { float ls2 = lsum + xhalf(lsum); const float d = ls2 > 0x1p40f ? floorf(__builtin_amdgcn_logf(ls2)) : 0.f, f = __builtin_amdgcn_exp2f(-d); l *= f; \
            _Pragma("unroll") for (int i = 0; i < 16; ++i) { negm[i] -= d; n0[i] -= d; n1[i] -= d; } \
            _Pragma("unroll") for (int db = 0; db < 4; ++db) _Pragma("unroll") for (int i = 0; i < 16; ++i) o[db][i] *= f; } \
        B_WAITBAR(); } while (0)
    for (int t3 = 0; t3 < NT - 1; t3 += 3) {
        B_ITER(t3, 0, BBUF, 2 * BBUF);
        B_ITER(t3 + 1, BBUF, 2 * BBUF, 0);
        B_ITER(t3 + 2, 2 * BBUF, 0, BBUF);
    }
    B_ITER(NT - 1, 0, BBUF, 2 * BBUF);
#undef B_ITER
#undef B_QK
#undef B_DMA
    if (next_unit >= 0) {
        const int qbn = next_unit & 31, hdn = (next_unit >> 5) & 3, rotn = (qbn * 2) & 63; const size_t rowbn = (size_t)(next_unit >> 7) * SEQ;
        const bf16* kgn = KB + (rowbn + lane) * 512 + hdn * 128 + wid * 8;
        const bf16* vgn = VB + (rowbn + (wid & 3) * 16 + (lane >> 2)) * 512 + hdn * 128 + (wid >> 2) * 32 + (lane & 3) * 8;
#pragma unroll
        for (int tt = 0; tt < 2; ++tt) { const size_t go = (size_t)((tt + rotn) & 63) * 64 * 512; const unsigned bo = tt * BBUF;
            GLDS16(kgn + go, kd + bo); GLDS16(kgn + go + 64, kd + BK_IMG + bo); GLDS16(vgn + go, vd0 + bo); GLDS16(vgn + go + 64, vd0 + 2 * BV_DB + bo); }
    }
    l += xhalf(l);
    const float rl = 1.0f / l;
    LAS float* ex = (LAS float*)(lds + 2 * BBUF) + w * 4096 + lane;
    if (c == 1) {
#pragma unroll
        for (int db = 0; db < 4; ++db)
#pragma unroll
            for (int i = 0; i < 16; ++i) ex[(db * 16 + i) * 64] = o[db][i] * rl;
    }
    __syncthreads();
    if (c == 0) {
        float ss = 0.f;
#pragma unroll
        for (int db = 0; db < 4; ++db)
#pragma unroll
            for (int i = 0; i < 16; ++i) { const float v = o[db][i] * rl - lam * ex[(db * 16 + i) * 64]; o[db][i] = v; ss += v * v; }
        ss += xhalf(ss);
        const float rs = 0.8f / sqrtf(ss * (1.0f / 128.0f) + 1e-5f);
        bf16* op = OB + qrow * 1024 + 512 + hd * 128 + 8 * h;
#pragma unroll
        for (int db = 0; db < 4; ++db)
#pragma unroll
            for (int gp = 0; gp < 2; ++gp) {
                const f32x4 ga = *(const f32x4*)(subln_g + 32 * db + 16 * gp + 4 * h), gb = *(const f32x4*)(subln_g + 32 * db + 16 * gp + 8 + 4 * h);
                unsigned a0 = pk2(o[db][8 * gp] * rs * ga[0], o[db][8 * gp + 1] * rs * ga[1]), a1 = pk2(o[db][8 * gp + 2] * rs * ga[2], o[db][8 * gp + 3] * rs * ga[3]);
                unsigned b0 = pk2(o[db][8 * gp + 4] * rs * gb[0], o[db][8 * gp + 5] * rs * gb[1]), b1 = pk2(o[db][8 * gp + 6] * rs * gb[2], o[db][8 * gp + 7] * rs * gb[3]);
                const auto s0 = __builtin_amdgcn_permlane32_swap(a0, b0, false, false); const auto s1 = __builtin_amdgcn_permlane32_swap(a1, b1, false, false);
                u32x4 wv; wv.x = s0[0]; wv.y = s1[0]; wv.z = s0[1]; wv.w = s1[1];
                *(u32x4*)(op + 32 * db + 16 * gp) = wv; }
    }
    __syncthreads();
}

#define XB_TMO      128
#define XB_XCNT(j)  (256  + 64 * (j))
#define XB_XSUB(j)  (1280 + 64 * (j))
#define XB_XGEN(j)  (2304 + 64 * (j))
#define XB_TOP      3328
#define XB_TOPGEN   3392
#define XCD_BAR_WORDS 3456
#define XB_SPIN_CAP (1u << 18)

__device__ __forceinline__ unsigned xb_ld(unsigned* p)              { return __hip_atomic_load(p, __ATOMIC_RELAXED, __HIP_MEMORY_SCOPE_AGENT); }
__device__ __forceinline__ unsigned xb_add(unsigned* p, unsigned v) { return __hip_atomic_fetch_add(p, v, __ATOMIC_RELAXED, __HIP_MEMORY_SCOPE_AGENT); }
__device__ __forceinline__ unsigned xb_xcc_id() { return (unsigned)__builtin_amdgcn_s_getreg((3 << 11) | 20) & 0xFu; }
#define XB_SPIN(cond, bar) do { unsigned _sp = 0; while (cond) { __builtin_amdgcn_s_sleep(1); \
    if ((++_sp & 255u) == 0u) { if (xb_ld(&(bar)[XB_TMO])) break; if (_sp > XB_SPIN_CAP) { atomicAdd(&(bar)[XB_TMO], 1u); break; } } } } while (0)

struct XcdBarrier {
    unsigned* bar; unsigned x;
    volatile LAS unsigned* st;
};

__device__ __forceinline__ XcdBarrier xcd_barrier_post(unsigned* bar, volatile LAS unsigned* st) {
    XcdBarrier b; b.bar = bar; b.x = xb_xcc_id(); b.st = st;
    if (threadIdx.x == 0) (void)xb_add(&bar[XB_XCNT(b.x)], 1u);
    return b;
}
__device__ __forceinline__ void xcd_barrier_complete(unsigned* bar, unsigned x, unsigned& nloc, unsigned& nx) {
    const unsigned G = gridDim.x * gridDim.y * gridDim.z;
    unsigned sum, cnt, mine, sp = 0u;
    for (;;) {
        sum = 0u; cnt = 0u; mine = 0u;
#pragma unroll
        for (unsigned j = 0; j < 16; ++j) { const unsigned c = xb_ld(&bar[XB_XCNT(j)]); sum += c; cnt += (c > 0u) ? 1u : 0u; mine = (j == x) ? c : mine; }
        if (sum == G) break;
        __builtin_amdgcn_s_sleep(1);
        if ((++sp & 255u) == 0u) { if (xb_ld(&bar[XB_TMO])) break; if (sp > XB_SPIN_CAP) { atomicAdd(&bar[XB_TMO], 1u); break; } }
    }
    nloc = mine > 0u ? mine : 1u; nx = cnt > 0u ? cnt : 1u;
}

__device__ __forceinline__ void xcd_barrier(const XcdBarrier& b) {
    asm volatile("s_waitcnt vmcnt(0)" ::: "memory");
    __syncthreads();
    if (threadIdx.x == 0) {
        unsigned* bar = b.bar;
        __builtin_amdgcn_s_waitcnt(0);
        unsigned nloc = b.st[0], nx = b.st[1];
        if (nloc == 0u) { xcd_barrier_complete(bar, b.x, nloc, nx); b.st[0] = nloc; b.st[1] = nx; }
        const unsigned old = xb_add(&bar[XB_XSUB(b.x)], 1u);
        const unsigned gen = old / nloc;
        if (old + 1u == (gen + 1u) * nloc) {
            __builtin_amdgcn_fence(__ATOMIC_RELEASE, "agent");
            asm volatile("s_waitcnt vmcnt(0)" ::: "memory");
            const unsigned og = xb_add(&bar[XB_TOP], 1u);
            const unsigned tg = og / nx;
            if (og + 1u == (tg + 1u) * nx) xb_add(&bar[XB_TOPGEN], 1u);
            else XB_SPIN(xb_ld(&bar[XB_TOPGEN]) == tg, bar);
            __builtin_amdgcn_fence(__ATOMIC_ACQUIRE, "agent");
            xb_add(&bar[XB_XGEN(b.x)], 1u);
            asm volatile("s_waitcnt vmcnt(0)" ::: "memory");
        } else {
            XB_SPIN(xb_ld(&bar[XB_XGEN(b.x)]) == gen, bar);
            __builtin_amdgcn_fence(__ATOMIC_ACQUIRE, "agent");
            asm volatile("s_waitcnt vmcnt(0)" ::: "memory");
        }
    }
    __syncthreads();
}


__global__ void __launch_bounds__(512, 2) fwd_kernel(Args A) {
    extern __shared__ __attribute__((aligned(16))) unsigned char lds_raw[];
    LAS unsigned char* lds = (LAS unsigned char*)lds_raw;
    const int G = gridDim.x, bx = blockIdx.x, tid = threadIdx.x;
    const int vcu = (G % 8 == 0) ? (bx % 8) * (G / 8) + bx / 8 : bx;
    unsigned char* ws = A.ws;
    const int lo = A.ph_lo, hi = A.ph_hi;
    volatile LAS unsigned* MISC = (volatile LAS unsigned*)(lds + 151552);
    if (tid < 16) MISC[tid] = 0u;
    __syncthreads();
    if (lo == -12345) cg::this_grid().sync();
    XcdBarrier bar = xcd_barrier_post((unsigned*)(ws + WS_CTL), MISC + 8);
#define IN(k) (lo <= (k) && (k) < hi)
#define SEAM(k) do { if (IN(k) && IN((k) + 1)) xcd_barrier(bar); } while (0)
    if (IN(0)) p0_prologue(A, lds, vcu, G);
    SEAM(0);
    if (IN(1)) {
        pg8::Gemm g{(const bf16*)(ws + WS_XN), (const bf16*)(ws + WS_WIN), M, INW, 1024}; pg8::StaticOrder S; S.init(M, INW, G, bx, 4);
        EpiIn E{ws};
        pg8::gemm_phase<EpiIn, pg8::StaticOrder, true, true>(lds, g, S, E);
    }
    SEAM(1);
    if (IN(2)) attnA_phase(lds, ws, vcu, G);
    SEAM(2);
    if (IN(3)) {
        attnA_combine(ws, vcu, G);
        float d1 = 0.f, d2 = 0.f;
        for (int i = 0; i < 64; ++i) { d1 += A.lq1[i] * A.lk1[i]; d2 += A.lq2[i] * A.lk2[i]; }
        const float lam = expf(d1) - expf(d2) + 0.2f;
        if (tid >= 256) __builtin_amdgcn_s_setprio(1);
        for (int u = vcu; u < BATCH * 4 * 32; u += G) attnB_unit(lds, ws, u, lam, A.subln_g, u != vcu, (u + G < BATCH * 4 * 32) ? u + G : -1);
        __builtin_amdgcn_s_setprio(0);
    }
    SEAM(3);
    if (IN(4)) {
        pg8::Gemm g{(const bf16*)(ws + WS_ATTA), (const bf16*)(ws + WS_WA), M, 1024, 1024}; pg8::StaticOrder S; S.init(M, 1024, G, bx);
        EpiGate2 E{(const unsigned char*)(ws + WS_SGA), (const unsigned char*)(ws + WS_SGB), (bf16*)(ws + WS_MERGED)};
        pg8::gemm_phase<EpiGate2, pg8::StaticOrder, true, true>(lds, g, S, E);
    }
    SEAM(4);
    if (IN(5)) {
        pg8::Gemm g{(const bf16*)(ws + WS_MERGED), (const bf16*)(ws + WS_WOUT), M, 1024, 1024}; pg8::StaticOrder S; S.init(M, 1024, G, bx);
        EpiRes1 E{A.x, (bf16*)(ws + WS_X1B), (float*)(ws + WS_SSQ1)};
        pg8::gemm_phase<EpiRes1, pg8::StaticOrder, true, true>(lds, g, S, E);
    }
    SEAM(5);
    if (IN(6)) {
        pg8::Gemm g{(const bf16*)(ws + WS_X1B), (const bf16*)(ws + WS_W1), M, DFF, 1024}; pg8::StaticOrder S; S.init(M, DFF, G, bx);
        EpiFF1 E{(bf16*)(ws + WS_H)};
        pg8::gemm_phase<EpiFF1, pg8::StaticOrder, true, true>(lds, g, S, E);
    }
    SEAM(6);
    if (IN(7)) {
        pg8::Gemm g{(const bf16*)(ws + WS_H), (const bf16*)(ws + WS_W2), M, 1024, DFF}; pg8::StaticOrder S; S.init(M, 1024, G, bx);
        EpiFinal E{(const bf16*)(ws + WS_X1B), (const float*)(ws + WS_SSQ1), A.out, A.g_final, (float*)(ws + WS_SSQ2), (unsigned*)(ws + WS_CTL + 65536), lds + 131072};
        pg8::gemm_phase<EpiFinal, pg8::StaticOrder, true, true>(lds, g, S, E);
    }
#undef IN
#undef SEAM
}

#ifndef MK_PER_PHASE
#define MK_PER_PHASE 0
#endif
extern "C" void kernel_launch(void* const* d_in, const int* in_sizes, int n_in, void* d_out, int out_size, void* d_ws, size_t ws_size, hipStream_t stream) {
    static int grid = 0;
    if (grid == 0) {
        if (n_in != 15 || in_sizes[0] != M * DM || out_size != M * DM || ws_size < WS_END) { fprintf(stderr, "kernel_launch: unexpected shapes / workspace (%d inputs, ws %zu)\n", n_in, ws_size); grid = -1; return; }
        int dev = 0, cus = 0, per_cu = 0;
        (void)hipGetDevice(&dev); (void)hipDeviceGetAttribute(&cus, hipDeviceAttributeMultiprocessorCount, dev);
        (void)hipFuncSetAttribute((const void*)fwd_kernel, hipFuncAttributeMaxDynamicSharedMemorySize, LDS_BYTES);
        (void)hipOccupancyMaxActiveBlocksPerMultiprocessor(&per_cu, (const void*)fwd_kernel, 512, LDS_BYTES);
        if (per_cu < 1) per_cu = 1;
        grid = cus * per_cu;
        fprintf(stderr, "kernel_launch: %d CUs x %d = grid %d\n", cus, per_cu, grid);
    }
    if (grid < 0) return;
    (void)hipMemsetAsync((unsigned char*)d_ws + WS_CTL, 0, 131072, stream);
    Args a{};
    a.x = (const float*)d_in[0]; a.w_in = (const float*)d_in[1]; a.w_a = (const float*)d_in[2]; a.w_b = (const float*)d_in[3]; a.w_out = (const float*)d_in[4];
    a.lq1 = (const float*)d_in[5]; a.lk1 = (const float*)d_in[6]; a.lq2 = (const float*)d_in[7]; a.lk2 = (const float*)d_in[8]; a.subln_g = (const float*)d_in[9];
    a.g_mix = (const float*)d_in[10]; a.g_mlp = (const float*)d_in[11]; a.w_ff1 = (const float*)d_in[12]; a.w_ff2 = (const float*)d_in[13]; a.g_final = (const float*)d_in[14];
    a.out = (float*)d_out; a.ws = (unsigned char*)d_ws;
#if MK_PER_PHASE
    for (int ph = 0; ph < NPHASE - 1; ++ph) { a.ph_lo = ph; a.ph_hi = ph + 1; hipLaunchKernelGGL(fwd_kernel, dim3(grid), dim3(512), LDS_BYTES, stream, a); }
#else
    a.ph_lo = 0; a.ph_hi = NPHASE;
    void* args[] = {&a};
    hipError_t e = hipLaunchCooperativeKernel((const void*)fwd_kernel, dim3(grid), dim3(512), args, LDS_BYTES, stream);
    if (e != hipSuccess) fprintf(stderr, "cooperative launch failed: %s (grid %d)\n", hipGetErrorString(e), grid);
#endif
}
```
